# Optimizing an MI355X kernel written in HIP

```python
import jax, jax.numpy as jnp
from jax import lax
import numpy as np

D_MODEL = 1024
BATCH = 8
SEQ = 2048
DEPTH = 2

HEAD_DIM = 64
FOX_HEADS = 6
SB_HEADS = 4
ML_HEADS = 6
D_FOX = FOX_HEADS * HEAD_DIM
D_SB = SB_HEADS * HEAD_DIM
D_ML = ML_HEADS * HEAD_DIM
D_MIX = D_FOX + D_SB + D_ML
N_IN = 3 * D_FOX + FOX_HEADS + 3 * D_SB + 4 * D_ML + 2 * ML_HEADS
BLOCK_Q = 128
ML_CHUNK = 128
CONV_WIDTH = 4
MEM_LEN = 256
X_HEADS = 4
X_HEAD_DIM = 128
D_X = X_HEADS * X_HEAD_DIM
D_FF = -(-8 * D_MODEL // (3 * 256)) * 256
RMS_EPS = 1e-6

kernel_name = "hybrid_fox_stickbreak_mlstm_block"


def rms_norm(x, w):
    xf = x.astype(jnp.float32)
    y = xf * lax.rsqrt(jnp.mean(xf * xf, axis=-1, keepdims=True) + RMS_EPS)
    return (y * w.astype(jnp.float32)).astype(x.dtype)


def split_columns(u, sizes):
    idx, acc = [], 0
    for s in sizes[:-1]:
        acc += s
        idx.append(acc)
    return jnp.split(u, idx, axis=-1)


def heads(t, n_heads):
    return t.reshape(t.shape[0], t.shape[1], n_heads, HEAD_DIM)


def query_blocks(t):
    b, s = t.shape[:2]
    return jnp.moveaxis(t.reshape((b, s // BLOCK_Q, BLOCK_Q) + t.shape[2:]), 1, 0)


def unblock(o):
    o = jnp.moveaxis(o, 0, 1)
    return o.reshape((o.shape[0], o.shape[1] * o.shape[2]) + o.shape[3:])


def fox_attention(q, k, v, log_f):
    s_len = q.shape[1]
    c = lax.cumsum(log_f, axis=1)
    c_k = jnp.transpose(c, (0, 2, 1))
    kpos = jnp.arange(s_len)
    scale = HEAD_DIM ** -0.5

    def block(args):
        qb, cb, start = args
        qpos = start + jnp.arange(BLOCK_Q)
        logits = jnp.einsum('bqhd,bkhd->bhqk', qb, k).astype(jnp.float32) * scale
        logits = logits + jnp.transpose(cb, (0, 2, 1))[..., None] - c_k[:, :, None, :]
        logits = jnp.where(kpos[None, :] <= qpos[:, None], logits, -jnp.inf)
        p = jax.nn.softmax(logits, axis=-1).astype(v.dtype)
        return jnp.einsum('bhqk,bkhd->bqhd', p, v)

    starts = jnp.arange(s_len // BLOCK_Q, dtype=jnp.int32) * BLOCK_Q
    return unblock(lax.map(block, (query_blocks(q), query_blocks(c), starts)))


def stick_breaking_attention(q, k, v):
    s_len = q.shape[1]
    kpos = jnp.arange(s_len)
    scale = HEAD_DIM ** -0.5

    def block(args):
        qb, start = args
        qpos = start + jnp.arange(BLOCK_Q)
        z = jnp.einsum('bqhd,bkhd->bhqk', qb, k).astype(jnp.float32) * scale
        valid = kpos[None, :] < qpos[:, None]
        log_keep = jnp.where(valid, jax.nn.log_sigmoid(-z), 0.0)
        suffix = lax.cumsum(log_keep, axis=3, reverse=True) - log_keep
        a = jnp.where(valid, jnp.exp(jax.nn.log_sigmoid(z) + suffix), 0.0).astype(v.dtype)
        return jnp.einsum('bhqk,bkhd->bqhd', a, v)

    starts = jnp.arange(s_len // BLOCK_Q, dtype=jnp.int32) * BLOCK_Q
    return unblock(lax.map(block, (query_blocks(q), starts)))


def mlstm_chunkwise(q, k, v, i_pre, f_pre):
    b_sz, s_len, n_h, dh = q.shape
    nc = s_len // ML_CHUNK

    def to_chunks(t):
        t = t.astype(jnp.float32).reshape((b_sz, nc, ML_CHUNK, n_h) + t.shape[3:])
        return jnp.moveaxis(jnp.moveaxis(t, 3, 2), 1, 0)

    qc = to_chunks(q)
    kc = to_chunks(k) * (dh ** -0.5)
    vc = to_chunks(v)
    ic = to_chunks(i_pre)
    lfc = jax.nn.log_sigmoid(to_chunks(f_pre))
    tri = jnp.arange(ML_CHUNK)[:, None] >= jnp.arange(ML_CHUNK)[None, :]

    def body(carry, inp):
        c_st, n_st, m_st = carry
        qx, kx, vx, ix, lfx = inp
        b = lax.cumsum(lfx, axis=2)
        g = b[..., -1]
        dlog = jnp.where(tri, b[..., :, None] - b[..., None, :] + ix[..., None, :], -jnp.inf)
        inter = b + m_st[..., None]
        m_t = jnp.maximum(inter, jnp.max(dlog, axis=-1))
        d = jnp.exp(dlog - m_t[..., None])
        sc = jnp.einsum('bhtd,bhsd->bhts', qx, kx) * d
        w_inter = jnp.exp(inter - m_t)
        num = jnp.einsum('bhts,bhsd->bhtd', sc, vx) + w_inter[..., None] * jnp.einsum('bhtk,bhkv->bhtv', qx, c_st)
        den = jnp.sum(sc, axis=-1) + w_inter * jnp.einsum('bhtk,bhk->bht', qx, n_st)
        h = num / jnp.maximum(jnp.abs(den), jnp.exp(-m_t))[..., None]
        src = g[..., None] - b + ix
        m_new = jnp.maximum(g + m_st, jnp.max(src, axis=-1))
        decay = jnp.exp(g + m_st - m_new)
        w = jnp.exp(src - m_new[..., None])
        c_new = decay[..., None, None] * c_st + jnp.einsum('bhs,bhsk,bhsv->bhkv', w, kx, vx)
        n_new = decay[..., None] * n_st + jnp.einsum('bhs,bhsk->bhk', w, kx)
        return (c_new, n_new, m_new), h

    init = (jnp.zeros((b_sz, n_h, dh, dh), jnp.float32),
            jnp.zeros((b_sz, n_h, dh), jnp.float32),
            jnp.zeros((b_sz, n_h), jnp.float32))
    _, h = lax.scan(body, init, (qc, kc, vc, ic, lfc))
    h = jnp.moveaxis(jnp.moveaxis(h, 0, 1), 2, 3)
    return h.reshape(b_sz, s_len, n_h, dh)


def causal_depthwise_conv(x, w):
    return lax.conv_general_dilated(
        x, w.astype(x.dtype)[:, None, :], window_strides=(1,), padding=[(CONV_WIDTH - 1, 0)],
        dimension_numbers=('NWC', 'WIO', 'NWC'), feature_group_count=x.shape[-1])


def hybrid_mixer(xn, w_in, fox_f_b, ml_conv_w, ml_i_b, ml_f_b, ml_norm_w, w_out):
    b_sz, s_len, _ = xn.shape
    u = xn @ w_in
    (fox_q, fox_k, fox_v, fox_f, sb_q, sb_k, sb_v,
     ml_qk, ml_v, ml_o, ml_i, ml_f) = split_columns(
        u, [D_FOX, D_FOX, D_FOX, FOX_HEADS, D_SB, D_SB, D_SB, 2 * D_ML, D_ML, D_ML, ML_HEADS, ML_HEADS])

    fox_log_f = jax.nn.log_sigmoid((fox_f + fox_f_b).astype(jnp.float32))
    y_fox = fox_attention(heads(fox_q, FOX_HEADS), heads(fox_k, FOX_HEADS), heads(fox_v, FOX_HEADS), fox_log_f)

    y_sb = stick_breaking_attention(heads(sb_q, SB_HEADS), heads(sb_k, SB_HEADS), heads(sb_v, SB_HEADS))

    qk = jax.nn.silu(causal_depthwise_conv(ml_qk, ml_conv_w))
    ml_q, ml_k = jnp.split(qk, 2, axis=-1)
    h_ml = mlstm_chunkwise(heads(ml_q, ML_HEADS), heads(ml_k, ML_HEADS), heads(ml_v, ML_HEADS),
                           ml_i + ml_i_b, ml_f + ml_f_b)
    h_ml = h_ml * lax.rsqrt(jnp.mean(h_ml * h_ml, axis=-1, keepdims=True) + RMS_EPS)
    h_ml = h_ml * ml_norm_w.astype(jnp.float32).reshape(ML_HEADS, HEAD_DIM)
    y_ml = (jax.nn.sigmoid(ml_o.astype(jnp.float32)).reshape(b_sz, s_len, ML_HEADS, HEAD_DIM) * h_ml).astype(xn.dtype)

    y = jnp.concatenate([y_fox.reshape(b_sz, s_len, D_FOX),
                         y_sb.reshape(b_sz, s_len, D_SB),
                         y_ml.reshape(b_sz, s_len, D_ML)], axis=-1)
    return y @ w_out


def memory_cross_attention(hn, mem_n, wx_q, wx_kv, wx_o):
    b_sz, s_len, _ = hn.shape
    q = (hn @ wx_q).reshape(b_sz, s_len, X_HEADS, X_HEAD_DIM)
    k, v = jnp.split(mem_n @ wx_kv, 2, axis=-1)
    k = k.reshape(b_sz, -1, X_HEADS, X_HEAD_DIM)
    v = v.reshape(b_sz, -1, X_HEADS, X_HEAD_DIM)
    logits = jnp.einsum('bshd,bmhd->bhsm', q, k).astype(jnp.float32) * (X_HEAD_DIM ** -0.5)
    p = jax.nn.softmax(logits, axis=-1).astype(v.dtype)
    o = jnp.einsum('bhsm,bmhd->bshd', p, v).reshape(b_sz, s_len, D_X)
    return o @ wx_o


def swiglu_ffn(hn, w_gate, w_up, w_down):
    return (jax.nn.silu(hn @ w_gate) * (hn @ w_up)) @ w_down


def setup_inputs(seed: int = 0) -> dict:
    key = jax.random.key(seed)
    ks = jax.random.split(key, 24)

    def normal(k, shape, scale):
        return jax.random.normal(k, shape, jnp.float32) * scale

    def gain(k, shape):
        return 1.0 + 0.02 * jax.random.normal(k, shape, jnp.float32)

    fox_f_b = jnp.linspace(1.0, 4.0, FOX_HEADS, dtype=jnp.float32)[None, :] + normal(ks[3], (DEPTH, FOX_HEADS), 0.1)
    ml_f_b = jnp.linspace(3.0, 6.0, ML_HEADS, dtype=jnp.float32)[None, :] + normal(ks[6], (DEPTH, ML_HEADS), 0.1)
    return {
        "x": normal(ks[0], (BATCH, SEQ, D_MODEL), 1.0),
        "mem": normal(ks[1], (BATCH, MEM_LEN, D_MODEL), 1.0),
        "norm_mix_w": gain(ks[2], (DEPTH, D_MODEL)),
        "w_in": normal(ks[4], (DEPTH, D_MODEL, N_IN), D_MODEL ** -0.5),
        "fox_f_b": fox_f_b,
        "ml_conv_w": normal(ks[5], (DEPTH, CONV_WIDTH, 2 * D_ML), CONV_WIDTH ** -0.5),
        "ml_i_b": normal(ks[7], (DEPTH, ML_HEADS), 0.1),
        "ml_f_b": ml_f_b,
        "ml_norm_w": gain(ks[8], (DEPTH, D_ML)),
        "w_out": normal(ks[9], (DEPTH, D_MIX, D_MODEL), D_MIX ** -0.5),
        "norm_x_w": gain(ks[10], (DEPTH, D_MODEL)),
        "mem_norm_w": gain(ks[11], (DEPTH, D_MODEL)),
        "wx_q": normal(ks[12], (DEPTH, D_MODEL, D_X), D_MODEL ** -0.5),
        "wx_kv": normal(ks[13], (DEPTH, D_MODEL, 2 * D_X), D_MODEL ** -0.5),
        "wx_o": normal(ks[14], (DEPTH, D_X, D_MODEL), D_X ** -0.5),
        "norm_ffn_w": gain(ks[15], (DEPTH, D_MODEL)),
        "w_gate": normal(ks[16], (DEPTH, D_MODEL, D_FF), D_MODEL ** -0.5),
        "w_up": normal(ks[17], (DEPTH, D_MODEL, D_FF), D_MODEL ** -0.5),
        "w_down": normal(ks[18], (DEPTH, D_FF, D_MODEL), D_FF ** -0.5),
        "final_norm_w": gain(ks[19], (D_MODEL,)),
    }


def reference(x, mem, norm_mix_w, w_in, fox_f_b, ml_conv_w, ml_i_b, ml_f_b, ml_norm_w, w_out,
              norm_x_w, mem_norm_w, wx_q, wx_kv, wx_o, norm_ffn_w, w_gate, w_up, w_down, final_norm_w):
    h = x
    for l in range(DEPTH):
        xn = rms_norm(h, norm_mix_w[l])
        h = h + hybrid_mixer(xn, w_in[l], fox_f_b[l], ml_conv_w[l], ml_i_b[l], ml_f_b[l], ml_norm_w[l], w_out[l])
        hn = rms_norm(h, norm_x_w[l])
        mn = rms_norm(mem, mem_norm_w[l])
        h = h + memory_cross_attention(hn, mn, wx_q[l], wx_kv[l], wx_o[l])
        hn = rms_norm(h, norm_ffn_w[l])
        h = h + swiglu_ffn(hn, w_gate[l], w_up[l], w_down[l])
    return rms_norm(h, final_norm_w)
```

```cpp
#include <hip/hip_runtime.h>
#include <hip/hip_cooperative_groups.h>
#include <cstdio>
#include <cstdint>
#include <cmath>
namespace cg = cooperative_groups;
namespace pg8 {
#define PG8_LAS __attribute__((address_space(3)))
typedef unsigned short bf16_t;
typedef short bf16x8 __attribute__((ext_vector_type(8)));
typedef float f32x4 __attribute__((ext_vector_type(4)));
typedef unsigned u32x4 __attribute__((ext_vector_type(4)));
constexpr int BM = 256, BK = 64, HALF = 128, HTB = HALF * BK * 2  , STAGE_BYTES = 8 * HTB, NXCD = 8, WGM = 4;

__host__ __device__ __forceinline__ int lds_byte(int r, int c) { const int st = (r >> 4) * 2 + (c >> 5), rr = r & 15, cc = c & 31, ob = rr * 64 + cc * 2; return st * 1024 + (ob ^ (((ob >> 9) & 1) << 5)); }
__host__ __device__ __forceinline__ void stage_rc(int b, int& R, int& C) { const int st = b / 1024, sb = b % 1024, swz = sb ^ (((sb >> 9) & 1) << 5); R = (st >> 1) * 16 + swz / 64; C = (st & 1) * 32 + (swz % 64) / 2; }
__host__ __device__ __forceinline__ int perm32(int rho) { const int n = rho >> 4, i = rho & 15; return 8 * (i >> 2) + 4 * n + (i & 3); }

struct Unit { int pm, pn; };
struct Gemm { const bf16_t* A; const bf16_t* Bt; int M, N, K; };

struct StaticOrder {
    int nM, nN, nwg, G, c;
    __host__ __device__ void init(int M, int N, int G_, int c_) { nM = M / BM; nN = N / BM; nwg = nM * nN; G = G_; c = c_; }
    __host__ __device__ bool next(int i, Unit& u) const {
        const long L = (long)i * G + c; if (L >= nwg) return false;
        int wgid = (int)L; { const int q = nwg / NXCD, r = nwg % NXCD, xcd = wgid % NXCD, off = wgid / NXCD; wgid = (xcd < r ? xcd * (q + 1) : r * (q + 1) + (xcd - r) * q) + off; }
        const int nig = WGM * nN, gid = wgid / nig, fm = gid * WGM, gsz = (nM - fm) < WGM ? (nM - fm) : WGM;
        u.pm = fm + ((wgid % nig) % gsz); u.pn = (wgid % nig) / gsz; return true;
    }
    __device__ __forceinline__ void a_ready(const Unit&) const {}
    __device__ __forceinline__ void done(const Unit&) const {}
};

__device__ __forceinline__ unsigned cvt_pk_bf16(float lo, float hi) { unsigned r; asm volatile("v_cvt_pk_bf16_f32 %0, %1, %2" : "=v"(r) : "v"(lo), "v"(hi)); return r; }
typedef float f32x2 __attribute__((ext_vector_type(2)));
struct OffsetOrder {
    StaticOrder b;
    __device__ void init(int M, int N, int G, int c, int off) { b.init(M, N, G, (c + G - (off % G)) % G); }
    __device__ bool next(int i, Unit& u) const { return b.next(i, u); }
    __device__ __forceinline__ void a_ready(const Unit&) const {}
    __device__ __forceinline__ void done(const Unit&) const {}
};
struct EpiScaleBf16 {
    static constexpr bool PERM = true, AFTER_DRAIN = false;
    bf16_t* O; int ldc; const float* ssq;
    __device__ __forceinline__ void operator()(const f32x4 (&acc)[2][2][4][2], const Unit& u, int wr, int wc, int fr, int fq) const {
        const int row0 = u.pm * BM + wr * 64 + fr, col0 = u.pn * BM + wc * 32 + 8 * fq;
#pragma unroll
        for (int ai = 0; ai < 2; ++ai)
#pragma unroll
            for (int m = 0; m < 4; ++m) { const int row = row0 + ai * HALF + m * 16; const f32x4 q0 = *(const f32x4*)(ssq + (size_t)row * 16), q1 = *(const f32x4*)(ssq + (size_t)row * 16 + 4), q2 = *(const f32x4*)(ssq + (size_t)row * 16 + 8), q3 = *(const f32x4*)(ssq + (size_t)row * 16 + 12);
                const float rs = rsqrtf(((((q0[0] + q0[1]) + (q0[2] + q0[3])) + ((q1[0] + q1[1]) + (q1[2] + q1[3]))) + (((q2[0] + q2[1]) + (q2[2] + q2[3])) + ((q3[0] + q3[1]) + (q3[2] + q3[3])))) * (1.0f / 1024.0f) + 1e-6f);
                bf16_t* rowp = O + (size_t)row * ldc + col0;
#pragma unroll
                for (int bj = 0; bj < 2; ++bj) { const f32x4 v0 = acc[ai][bj][m][0] * rs, v1 = acc[ai][bj][m][1] * rs;
                    u32x4 w; w.x = cvt_pk_bf16(v0[0], v0[1]); w.y = cvt_pk_bf16(v0[2], v0[3]); w.z = cvt_pk_bf16(v1[0], v1[1]); w.w = cvt_pk_bf16(v1[2], v1[3]);
                    *(u32x4*)(rowp + bj * HALF) = w; } }
    }
};
struct EpiResid {
    static constexpr bool PERM = true, AFTER_DRAIN = false;
    bf16_t* hb; float* ssq;
    __device__ __forceinline__ void operator()(const f32x4 (&acc)[2][2][4][2], const Unit& u, int wr, int wc, int fr, int fq) const {
        const int row0 = u.pm * BM + wr * 64 + fr, col0 = u.pn * BM + wc * 32 + 8 * fq;
#pragma unroll
        for (int ai = 0; ai < 2; ++ai)
#pragma unroll
            for (int m = 0; m < 4; ++m) { const int row = row0 + ai * HALF + m * 16; const size_t off = (size_t)row * 1024 + col0; float part = 0.f;
#pragma unroll
                for (int bj = 0; bj < 2; ++bj) { const u32x4 b = *(const u32x4*)(hb + off + bj * HALF);
                    f32x4 v0 = acc[ai][bj][m][0], v1 = acc[ai][bj][m][1];
                    v0[0] += __uint_as_float(b.x << 16); v0[1] += __uint_as_float(b.x & 0xffff0000u); v0[2] += __uint_as_float(b.y << 16); v0[3] += __uint_as_float(b.y & 0xffff0000u);
                    v1[0] += __uint_as_float(b.z << 16); v1[1] += __uint_as_float(b.z & 0xffff0000u); v1[2] += __uint_as_float(b.w << 16); v1[3] += __uint_as_float(b.w & 0xffff0000u);
                    u32x4 w; w.x = cvt_pk_bf16(v0[0], v0[1]); w.y = cvt_pk_bf16(v0[2], v0[3]); w.z = cvt_pk_bf16(v1[0], v1[1]); w.w = cvt_pk_bf16(v1[2], v1[3]);
                    *(u32x4*)(hb + off + bj * HALF) = w;
                    part += (v0[0] * v0[0] + v0[1] * v0[1]) + (v0[2] * v0[2] + v0[3] * v0[3]) + (v1[0] * v1[0] + v1[1] * v1[1]) + (v1[2] * v1[2] + v1[3] * v1[3]); }
                part += __shfl_xor(part, 16); part += __shfl_xor(part, 32);
                if (fq == 0) ssq[(size_t)row * 16 + u.pn * 4 + wc] = part; }
    }
};
struct EpiSwiglu {
    static constexpr bool PERM = true, AFTER_DRAIN = false;
    bf16_t* O; int ldc; const float* ssq;
    __device__ __forceinline__ void operator()(const f32x4 (&acc)[2][2][4][2], const Unit& u, int wr, int wc, int fr, int fq) const {
        const int row0 = u.pm * BM + wr * 64 + fr, col0 = u.pn * HALF + wc * 32 + 8 * fq;
#pragma unroll
        for (int ai = 0; ai < 2; ++ai)
#pragma unroll
            for (int m = 0; m < 4; ++m) { const int row = row0 + ai * HALF + m * 16; const f32x4 q0 = *(const f32x4*)(ssq + (size_t)row * 16), q1 = *(const f32x4*)(ssq + (size_t)row * 16 + 4), q2 = *(const f32x4*)(ssq + (size_t)row * 16 + 8), q3 = *(const f32x4*)(ssq + (size_t)row * 16 + 12);
                const float rs = rsqrtf(((((q0[0] + q0[1]) + (q0[2] + q0[3])) + ((q1[0] + q1[1]) + (q1[2] + q1[3]))) + (((q2[0] + q2[1]) + (q2[2] + q2[3])) + ((q3[0] + q3[1]) + (q3[2] + q3[3])))) * (1.0f / 1024.0f) + 1e-6f);
                float a[8];
#pragma unroll
                for (int n = 0; n < 2; ++n)
#pragma unroll
                    for (int j = 0; j < 4; ++j) { const float g = acc[ai][0][m][n][j] * rs, up = acc[ai][1][m][n][j] * rs; a[4 * n + j] = g * up * __builtin_amdgcn_rcpf(1.0f + __expf(-g)); }
                u32x4 w; w.x = cvt_pk_bf16(a[0], a[1]); w.y = cvt_pk_bf16(a[2], a[3]); w.z = cvt_pk_bf16(a[4], a[5]); w.w = cvt_pk_bf16(a[6], a[7]);
                *(u32x4*)(O + (size_t)row * ldc + col0) = w; }
    }
};
template <class Epi, class Sched, bool ALIGN_EPI = false, bool SP2 = false>
__device__ __forceinline__ void gemm_phase(PG8_LAS unsigned char* lds, const Gemm g, const Sched& S, const Epi& E) {
    int tid_l = threadIdx.x; asm volatile("" : "+v"(tid_l));
    const int tid = tid_l, wid = __builtin_amdgcn_readfirstlane(tid >> 6), lane = tid & 63, wr = wid >> 2, wc = wid & 3, fr = lane & 15, fq = lane >> 4;
    const int K = g.K, nt = K / BK;
    unsigned voffA[2], voffB[2];
#pragma unroll
    for (int i = 0; i < 2; ++i) { int R, C; stage_rc(tid * 16 + i * 8192, R, C); const int Rb = Epi::PERM ? ((R & ~31) + perm32(R & 31)) : R;
        voffA[i] = (unsigned)(R * K + C) * 2u; voffB[i] = (unsigned)(Rb * K + C) * 2u; }
    const size_t kstep = (size_t)(BK * 2);
    const size_t hstep = (size_t)HALF * K * 2;
    const size_t tstep = 2 * hstep;
    const unsigned ldsw = (unsigned)wid * 1024u;
    const int aoff = lds_byte(wr * 64 + fr, fq * 8), boff = lds_byte(wc * 32 + fr, fq * 8);
#define PG8_SA(b, h) (((b) * 2 + (h)) * HTB)
#define PG8_SB(b, h) ((4 + (b) * 2 + (h)) * HTB)
#define PG8_STAGE(bufoff, gbase, voff) do { _Pragma("unroll") for (int _i = 0; _i < 2; ++_i) \
        __builtin_amdgcn_global_load_lds((const unsigned*)((const char*)(gbase) + (voff)[_i]), (PG8_LAS unsigned*)(lds + (bufoff) + ldsw + _i * 8192), 16, 0, 0); } while (0)
#define PG8_LDA(dst, b, h) do { _Pragma("unroll") for (int m = 0; m < 4; ++m) _Pragma("unroll") for (int k = 0; k < 2; ++k) dst[m][k] = *(const PG8_LAS bf16x8*)(lds + PG8_SA(b, h) + aoff + m * 2048 + k * 1024); } while (0)
#define PG8_LDB(dst, b, h) do { _Pragma("unroll") for (int n = 0; n < 2; ++n) _Pragma("unroll") for (int k = 0; k < 2; ++k) dst[n][k] = *(const PG8_LAS bf16x8*)(lds + PG8_SB(b, h) + boff + n * 2048 + k * 1024); } while (0)
#define PG8_MMA(ai, bj, At, Bt) do { __builtin_amdgcn_s_setprio(1); _Pragma("unroll") for (int m = 0; m < 4; ++m) _Pragma("unroll") for (int n = 0; n < 2; ++n) _Pragma("unroll") for (int k = 0; k < 2; ++k) \
        acc[ai][bj][m][n] = __builtin_amdgcn_mfma_f32_16x16x32_bf16(Bt[n][k], At[m][k], acc[ai][bj][m][n], 0, 0, 0); __builtin_amdgcn_s_setprio(0); } while (0)
#define PG8_WAIT_V(n) asm volatile("s_waitcnt vmcnt(" #n ")" ::: "memory")
#define PG8_WAIT_L(n) asm volatile("s_waitcnt lgkmcnt(" #n ")" ::: "memory")
#define PG8_BAR __builtin_amdgcn_s_barrier()
#define PG8_SCHED __builtin_amdgcn_sched_barrier(0)
    Unit cur, nxt; int ui = 0;
    if (!S.next(0, cur)) return;
    f32x4 acc[2][2][4][2];
#pragma unroll
    for (int a = 0; a < 2; ++a)
#pragma unroll
        for (int b = 0; b < 2; ++b)
#pragma unroll
            for (int m = 0; m < 4; ++m)
#pragma unroll
                for (int n = 0; n < 2; ++n) acc[a][b][m][n] = (f32x4){0.f, 0.f, 0.f, 0.f};
    bf16x8 At[4][2], B0[2][2], B1[2][2];
    const char* cA = (const char*)g.A + (size_t)cur.pm * tstep; const char* cB = (const char*)g.Bt + (size_t)cur.pn * tstep;
    S.a_ready(cur);
    if constexpr (SP2) {
        PG8_STAGE(PG8_SB(0, 0), cB, voffB); PG8_STAGE(PG8_SB(0, 1), cB + hstep, voffB); PG8_STAGE(PG8_SA(0, 0), cA, voffA); PG8_STAGE(PG8_SA(0, 1), cA + hstep, voffA);
        if (wr == 1) PG8_BAR;
        PG8_WAIT_V(2); PG8_BAR;
        PG8_STAGE(PG8_SB(1, 0), cB + kstep, voffB); PG8_STAGE(PG8_SA(1, 0), cA + kstep, voffA); PG8_STAGE(PG8_SB(1, 1), cB + hstep + kstep, voffB);
        PG8_WAIT_V(6); PG8_BAR;
    } else {
        PG8_STAGE(PG8_SB(0, 0), cB, voffB); PG8_STAGE(PG8_SA(0, 0), cA, voffA); PG8_STAGE(PG8_SB(0, 1), cB + hstep, voffB); PG8_STAGE(PG8_SA(0, 1), cA + hstep, voffA);
        if (wr == 1) PG8_BAR;
        PG8_WAIT_V(4); PG8_BAR;
        PG8_STAGE(PG8_SB(1, 0), cB + kstep, voffB); PG8_STAGE(PG8_SA(1, 0), cA + kstep, voffA); PG8_STAGE(PG8_SB(1, 1), cB + hstep + kstep, voffB);
        PG8_WAIT_V(6); PG8_BAR;
    }
    for (;;) {
        const bool has_next = S.next(ui + 1, nxt);
        const char* nA = has_next ? (const char*)g.A + (size_t)nxt.pm * tstep : cA; const char* nB = has_next ? (const char*)g.Bt + (size_t)nxt.pn * tstep : cB;
        for (int t = 0; t < nt; t += 2) {
            const bool last = (t == nt - 2);
            const char* a1 = cA + (size_t)(t + 1) * kstep;
            const char* a2 = last ? nA : cA + (size_t)(t + 2) * kstep; const char* b2 = last ? nB : cB + (size_t)(t + 2) * kstep;
            const char* a3 = a2 + kstep; const char* b3 = b2 + kstep;
            if (last && has_next) S.a_ready(nxt);
            if constexpr (SP2) {
            PG8_LDB(B0, 0, 0); PG8_LDB(B1, 0, 1); PG8_SCHED; PG8_LDA(At, 0, 0); PG8_STAGE(PG8_SA(1, 1), a1 + hstep, voffA);
            PG8_WAIT_V(8); PG8_WAIT_L(0); PG8_BAR; PG8_MMA(0, 0, At, B0); PG8_MMA(0, 1, At, B1); PG8_BAR; PG8_SCHED;
            PG8_LDA(At, 0, 1); PG8_STAGE(PG8_SB(0, 0), b2, voffB); PG8_STAGE(PG8_SB(0, 1), b2 + hstep, voffB); PG8_STAGE(PG8_SA(0, 0), a2, voffA);
            PG8_WAIT_V(8); PG8_WAIT_L(0); PG8_BAR; PG8_MMA(1, 0, At, B0); PG8_MMA(1, 1, At, B1); PG8_BAR; PG8_SCHED;
            PG8_LDB(B0, 1, 0); PG8_LDB(B1, 1, 1); PG8_SCHED; PG8_LDA(At, 1, 0); PG8_STAGE(PG8_SA(0, 1), a2 + hstep, voffA);
            PG8_WAIT_V(8); PG8_WAIT_L(0); PG8_BAR; PG8_MMA(0, 0, At, B0); PG8_MMA(0, 1, At, B1); PG8_BAR; PG8_SCHED;
            PG8_LDA(At, 1, 1); PG8_STAGE(PG8_SB(1, 0), b3, voffB); PG8_STAGE(PG8_SB(1, 1), b3 + hstep, voffB); PG8_STAGE(PG8_SA(1, 0), a3, voffA);
            PG8_WAIT_V(8); PG8_WAIT_L(0); PG8_BAR; PG8_MMA(1, 0, At, B0); PG8_MMA(1, 1, At, B1); PG8_BAR; PG8_SCHED;
            } else {
            PG8_LDB(B0, 0, 0); PG8_SCHED; PG8_LDA(At, 0, 0); PG8_STAGE(PG8_SA(1, 1), a1 + hstep, voffA);
            PG8_WAIT_L(8); PG8_BAR; PG8_WAIT_L(0); PG8_MMA(0, 0, At, B0); PG8_BAR; PG8_SCHED;
            PG8_LDB(B1, 0, 1); PG8_STAGE(PG8_SB(0, 0), b2, voffB);
            PG8_BAR; PG8_WAIT_L(0); PG8_MMA(0, 1, At, B1); PG8_BAR;
            PG8_LDA(At, 0, 1); PG8_STAGE(PG8_SA(0, 0), a2, voffA);
            PG8_BAR; PG8_WAIT_L(0); PG8_MMA(1, 0, At, B0); PG8_BAR; PG8_SCHED;
            PG8_STAGE(PG8_SB(0, 1), b2 + hstep, voffB);
            PG8_WAIT_V(6); PG8_BAR; PG8_MMA(1, 1, At, B1); PG8_BAR;
            PG8_LDB(B0, 1, 0); PG8_SCHED; PG8_LDA(At, 1, 0); PG8_STAGE(PG8_SA(0, 1), a2 + hstep, voffA);
            PG8_WAIT_L(8); PG8_BAR; PG8_WAIT_L(0); PG8_MMA(0, 0, At, B0); PG8_BAR; PG8_SCHED;
            PG8_LDB(B1, 1, 1); PG8_STAGE(PG8_SB(1, 0), b3, voffB);
            PG8_BAR; PG8_WAIT_L(0); PG8_MMA(0, 1, At, B1); PG8_BAR;
            PG8_LDA(At, 1, 1); PG8_STAGE(PG8_SA(1, 0), a3, voffA);
            PG8_BAR; PG8_WAIT_L(0); PG8_MMA(1, 0, At, B0); PG8_BAR; PG8_SCHED;
            PG8_STAGE(PG8_SB(1, 1), b3 + hstep, voffB);
            PG8_WAIT_V(6); PG8_BAR; PG8_MMA(1, 1, At, B1); PG8_BAR;
            }
        }
        if constexpr (ALIGN_EPI) { if (wr == 0) PG8_BAR; }
        if constexpr (!Epi::AFTER_DRAIN) { E(acc, cur, wr, wc, fr, fq); S.done(cur); }
        if (!has_next) break;
#pragma unroll
        for (int a = 0; a < 2; ++a)
#pragma unroll
            for (int b = 0; b < 2; ++b)
#pragma unroll
                for (int m = 0; m < 4; ++m)
#pragma unroll
                    for (int n = 0; n < 2; ++n) acc[a][b][m][n] = (f32x4){0.f, 0.f, 0.f, 0.f};
        cur = nxt; cA = nA; cB = nB; ++ui;
        if constexpr (ALIGN_EPI) { if (wr == 1) PG8_BAR; }
    }
    PG8_WAIT_V(0);
    if constexpr (!ALIGN_EPI) { if (wr == 0) PG8_BAR; }
    PG8_BAR;
    if constexpr (Epi::AFTER_DRAIN) { E.fused(acc, cur, wr, wc, fr, fq, lds, wid, lane); S.done(cur); }
#undef PG8_SA
#undef PG8_SB
#undef PG8_STAGE
#undef PG8_LDA
#undef PG8_LDB
#undef PG8_MMA
#undef PG8_WAIT_V
#undef PG8_WAIT_L
#undef PG8_BAR
#undef PG8_SCHED
}
}
#define LAS __attribute__((address_space(3)))
typedef unsigned short bf16;
typedef unsigned v4u __attribute__((ext_vector_type(4)));
typedef float f32x4 __attribute__((ext_vector_type(4)));

constexpr int NB = 8, S = 2048, D = 1024, M = NB * S, NU = 3584, DFF = 2816, MEML = 256, MROWS = NB * MEML, DX = 512;
constexpr size_t MiB = 1u << 20;
constexpr size_t WS_SSQ = 0;
constexpr size_t WS_SSQM = 512 * 1024;
constexpr size_t WS_BAR = 768 * 1024, BAR_BYTES = 16384;
constexpr int LDS_BARST = 147392;
constexpr size_t WS_PRM = 800 * 1024;
constexpr size_t WS_W = 1 * MiB, W_LAYER = 29 * MiB + MiB / 2;
constexpr size_t OW_IN = 0, OW_OUT = 7 * MiB, OW_XQ = 9 * MiB, OW_XKV = 10 * MiB, OW_XO = 12 * MiB, OW_GU = 13 * MiB, OW_DN = 24 * MiB;
constexpr size_t WS_U = 60 * MiB;
constexpr size_t WS_Y = 172 * MiB;
constexpr size_t WS_QX = 172 * MiB, WS_OX = 188 * MiB;
constexpr size_t WS_HB = 204 * MiB;
constexpr size_t WS_MEMB = 236 * MiB;
constexpr size_t WS_KV = 240 * MiB;
constexpr size_t WS_SSQP = 248 * MiB;
constexpr size_t WS_END = 256 * MiB;
constexpr int LDS_BYTES = 147456;

__device__ __forceinline__ unsigned f2bf(float f) { unsigned u = __builtin_bit_cast(unsigned, f); return (u + 0x7fffu + ((u >> 16) & 1u)) >> 16; }
__device__ __forceinline__ unsigned pk2(float lo, float hi) { return f2bf(lo) | (f2bf(hi) << 16); }
__device__ __forceinline__ float bf2f(unsigned short v) { return __uint_as_float(((unsigned)v) << 16); }
__device__ __forceinline__ float lo_f(unsigned w) { return __uint_as_float(w << 16); }
__device__ __forceinline__ float hi_f(unsigned w) { return __uint_as_float(w & 0xffff0000u); }
__device__ __forceinline__ float log_sigmoid_f(float x) { return fminf(x, 0.f) - __logf(1.0f + __expf(-fabsf(x))); }
__device__ __forceinline__ float sigmoid_f(float x) { return __builtin_amdgcn_rcpf(1.0f + __expf(-x)); }
__device__ __forceinline__ float wave_sum(float v) {
#pragma unroll
    for (int o = 1; o < 64; o <<= 1) v += __shfl_xor(v, o);
    return v;
}

#define XB_TMO      128
#define XB_XCNT(j)  (256  + 64 * (j))
#define XB_XSUB(j)  (1280 + 64 * (j))
#define XB_XGEN(j)  (2304 + 64 * (j))
#define XB_TOP      3328
#define XB_TOPGEN   3392
#define XCD_BAR_WORDS 3456
#define XB_SPIN_CAP (1u << 18)

__device__ __forceinline__ unsigned xb_ld(unsigned* p)              { return __hip_atomic_load(p, __ATOMIC_RELAXED, __HIP_MEMORY_SCOPE_AGENT); }
__device__ __forceinline__ unsigned xb_add(unsigned* p, unsigned v) { return __hip_atomic_fetch_add(p, v, __ATOMIC_RELAXED, __HIP_MEMORY_SCOPE_AGENT); }
__device__ __forceinline__ unsigned xb_xcc_id() { return (unsigned)__builtin_amdgcn_s_getreg((3 << 11) | 20) & 0xFu; }
#define XB_SPIN(cond, bar) do { unsigned _sp = 0; while (cond) { __builtin_amdgcn_s_sleep(1); \
    if ((++_sp & 255u) == 0u) { if (xb_ld(&(bar)[XB_TMO])) break; if (_sp > XB_SPIN_CAP) { atomicAdd(&(bar)[XB_TMO], 1u); break; } } } } while (0)

struct XcdBarrier {
    unsigned* bar; unsigned x;
    volatile LAS unsigned* st;
};

__device__ __forceinline__ XcdBarrier xcd_barrier_post(unsigned* bar, volatile LAS unsigned* st) {
    XcdBarrier b; b.bar = bar; b.x = xb_xcc_id(); b.st = st;
    if (threadIdx.x == 0) (void)xb_add(&bar[XB_XCNT(b.x)], 1u);
    return b;
}
__device__ __forceinline__ void xcd_barrier_complete(unsigned* bar, unsigned x, unsigned& nloc, unsigned& nx) {
    const unsigned G = gridDim.x * gridDim.y * gridDim.z;
    unsigned sum, cnt, mine, sp = 0u;
    for (;;) {
        sum = 0u; cnt = 0u; mine = 0u;
#pragma unroll
        for (unsigned j = 0; j < 16; ++j) { const unsigned c = xb_ld(&bar[XB_XCNT(j)]); sum += c; cnt += (c > 0u) ? 1u : 0u; mine = (j == x) ? c : mine; }
        if (sum == G) break;
        __builtin_amdgcn_s_sleep(1);
        if ((++sp & 255u) == 0u) { if (xb_ld(&bar[XB_TMO])) break; if (sp > XB_SPIN_CAP) { atomicAdd(&bar[XB_TMO], 1u); break; } }
    }
    nloc = mine > 0u ? mine : 1u; nx = cnt > 0u ? cnt : 1u;
}

__device__ __forceinline__ void xcd_barrier(const XcdBarrier& b) {
    asm volatile("s_waitcnt vmcnt(0)" ::: "memory");
    __syncthreads();
    if (threadIdx.x == 0) {
        unsigned* bar = b.bar;
        __builtin_amdgcn_s_waitcnt(0);
        unsigned nloc = b.st[0], nx = b.st[1];
        if (nloc == 0u) { xcd_barrier_complete(bar, b.x, nloc, nx); b.st[0] = nloc; b.st[1] = nx; }
        const unsigned old = xb_add(&bar[XB_XSUB(b.x)], 1u);
        const unsigned gen = old / nloc;
        if (old + 1u == (gen + 1u) * nloc) {
            __builtin_amdgcn_fence(__ATOMIC_RELEASE, "agent");
            asm volatile("s_waitcnt vmcnt(0)" ::: "memory");
            const unsigned og = xb_add(&bar[XB_TOP], 1u);
            const unsigned tg = og / nx;
            if (og + 1u == (tg + 1u) * nx) xb_add(&bar[XB_TOPGEN], 1u);
            else XB_SPIN(xb_ld(&bar[XB_TOPGEN]) == tg, bar);
            __builtin_amdgcn_fence(__ATOMIC_ACQUIRE, "agent");
            xb_add(&bar[XB_XGEN(b.x)], 1u);
            asm volatile("s_waitcnt vmcnt(0)" ::: "memory");
        } else {
            XB_SPIN(xb_ld(&bar[XB_XGEN(b.x)]) == gen, bar);
            __builtin_amdgcn_fence(__ATOMIC_ACQUIRE, "agent");
            asm volatile("s_waitcnt vmcnt(0)" ::: "memory");
        }
    }
    __syncthreads();
}

__device__ __forceinline__ void conv_item(const float* W0, const float* W1, int pitch, int K, int mode, const float* rowscale, bf16* WT, LAS float* scr, int item, int nblk, int lane) {
    const int kb = item / nblk, nb = item % nblk, k0 = 64 * kb, n0 = 32 * nb;
    const int n = n0 + (lane & 31);
    const float* src = nullptr;
    if (mode == 0) src = W0 + n;
    else if (mode == 1) { if (n < 1152) src = W0 + n; else if (n < 3456) src = W0 + n + 6; else if (n < 3462) src = W0 + 1152 + (n - 3456); else if (n < 3474) src = W0 + n; }
    else { const int t = n >> 8, j = n & 255; src = (j < 128) ? (W0 + 128 * t + j) : (W1 + 128 * t + (j - 128)); }
#pragma unroll
    for (int i = 0; i < 32; ++i) { const int kk = 2 * i + (lane >> 5); float v = src ? src[(size_t)(k0 + kk) * pitch] : 0.f; if (rowscale) v *= rowscale[k0 + kk]; scr[kk * 33 + (lane & 31)] = v; }
    asm volatile("s_waitcnt lgkmcnt(0)" ::: "memory");
    const int c = lane & 7;
#pragma unroll
    for (int j = 0; j < 4; ++j) { const int nn = (lane >> 3) + 8 * j; const LAS float* s = scr + (8 * c) * 33 + nn;
        v4u o; o.x = pk2(s[0 * 33], s[1 * 33]); o.y = pk2(s[2 * 33], s[3 * 33]); o.z = pk2(s[4 * 33], s[5 * 33]); o.w = pk2(s[6 * 33], s[7 * 33]);
        *(v4u*)(WT + (size_t)(n0 + nn) * K + k0 + 8 * c) = o; }
    asm volatile("s_waitcnt lgkmcnt(0)" ::: "memory");
}
__device__ __forceinline__ void conv_block_item(const float* W0, const float* W1, int pitch, int K, int mode, const float* rowscale, bf16* WT, LAS float* tile, int kb, int nb, int tid) {
    const int k0 = 64 * kb, n0 = 256 * nb, c4 = (tid & 63) * 4;
#pragma unroll
    for (int i = 0; i < 8; ++i) { const int row = 8 * i + (tid >> 6); f32x4 v = {0.f, 0.f, 0.f, 0.f};
        const float* rp = W0 + (size_t)(k0 + row) * pitch;
        if (mode == 0) v = *(const f32x4*)(rp + n0 + c4);
        else if (mode == 2) { const float* rq = (c4 < 128 ? rp : W1 + (size_t)(k0 + row) * pitch) + 128 * nb + (c4 & 127); v = *(const f32x4*)rq; }
        else {
#pragma unroll
            for (int j = 0; j < 4; ++j) { const int n = n0 + c4 + j; int sc = -1;
                if (n < 1152) sc = n; else if (n < 3456) sc = n + 6; else if (n < 3462) sc = 1152 + (n - 3456); else if (n < 3474) sc = n;
                v[j] = sc >= 0 ? rp[sc] : 0.f; } }
        if (rowscale) v = v * rowscale[k0 + row];
        LAS float* d = tile + row * 257 + c4; d[0] = v[0]; d[1] = v[1]; d[2] = v[2]; d[3] = v[3]; }
    __syncthreads();
    const int q = tid & 7;
#pragma unroll
    for (int pass = 0; pass < 4; ++pass) { const int nl = (tid >> 3) + 64 * pass; const LAS float* sp = tile + (8 * q) * 257 + nl;
        v4u o; o.x = pk2(sp[0], sp[257]); o.y = pk2(sp[2 * 257], sp[3 * 257]); o.z = pk2(sp[4 * 257], sp[5 * 257]); o.w = pk2(sp[6 * 257], sp[7 * 257]);
        *(v4u*)(WT + (size_t)(n0 + nl) * K + k0 + 8 * q) = o; }
    __syncthreads();
}
__device__ __forceinline__ void row_to_bf16_ssq(const float* xrow, bf16* orow, float* ssq_out, int lane) {
    const f32x4* xr = (const f32x4*)xrow + lane; f32x4 v[4]; float s2 = 0.f;
#pragma unroll
    for (int j = 0; j < 4; ++j) { v[j] = xr[64 * j]; s2 += (v[j].x * v[j].x + v[j].y * v[j].y) + (v[j].z * v[j].z + v[j].w * v[j].w); }
    s2 = wave_sum(s2);
    unsigned long long* o8 = (unsigned long long*)orow + lane;
#pragma unroll
    for (int j = 0; j < 4; ++j) o8[64 * j] = (unsigned long long)pk2(v[j].x, v[j].y) | ((unsigned long long)pk2(v[j].z, v[j].w) << 32);
    if (lane < 16) ssq_out[lane] = lane == 0 ? s2 : 0.f;
}

typedef short s16x8 __attribute__((ext_vector_type(8)));
typedef short s16x4 __attribute__((ext_vector_type(4)));
typedef float f32x16 __attribute__((ext_vector_type(16)));
__device__ __forceinline__ s16x4 tr_read(LAS const unsigned char* p) { return __builtin_bit_cast(s16x4, __builtin_amdgcn_ds_read_tr16_b64_v4i16((LAS s16x4*)p)); }
__device__ __forceinline__ s16x8 cat8(s16x4 a, s16x4 b) { return (s16x8){a[0], a[1], a[2], a[3], b[0], b[1], b[2], b[3]}; }
__device__ __forceinline__ unsigned cvtpk(float lo, float hi) { return pg8::cvt_pk_bf16(lo, hi); }
__device__ __forceinline__ s16x8 pack8(float a0, float a1, float a2, float a3, float a4, float a5, float a6, float a7) {
    v4u w; w.x = cvtpk(a0, a1); w.y = cvtpk(a2, a3); w.z = cvtpk(a4, a5); w.w = cvtpk(a6, a7); return __builtin_bit_cast(s16x8, w); }
#define MFMA32(a, b, c) __builtin_amdgcn_mfma_f32_32x32x16_bf16(a, b, c, 0, 0, 0)
__device__ __forceinline__ float xh_sum(float x) { auto rr = __builtin_amdgcn_permlane32_swap(__float_as_uint(x), __float_as_uint(x), false, false); return __uint_as_float(rr[0]) + __uint_as_float(rr[1]); }
__device__ __forceinline__ float xh_max(float x) { auto rr = __builtin_amdgcn_permlane32_swap(__float_as_uint(x), __float_as_uint(x), false, false); return fmaxf(__uint_as_float(rr[0]), __uint_as_float(rr[1])); }
__device__ __forceinline__ float xh_prod(float x) { auto rr = __builtin_amdgcn_permlane32_swap(__float_as_uint(x), __float_as_uint(x), false, false); return __uint_as_float(rr[0]) * __uint_as_float(rr[1]); }
__device__ __forceinline__ float xh_other(float x) { auto rr = __builtin_amdgcn_permlane32_swap(__float_as_uint(x), __float_as_uint(x), false, false); return __uint_as_float(rr[0] == __float_as_uint(x) ? rr[1] : rr[0]); }
__device__ __forceinline__ void st_wt64(float* p, float a, float b) { __hip_atomic_store((unsigned long long*)p, ((unsigned long long)__float_as_uint(b) << 32) | (unsigned long long)__float_as_uint(a), __ATOMIC_RELAXED, __HIP_MEMORY_SCOPE_AGENT); }
__device__ __forceinline__ void st_wt32(float* p, float a) { __hip_atomic_store((unsigned*)p, __float_as_uint(a), __ATOMIC_RELAXED, __HIP_MEMORY_SCOPE_AGENT); }
__device__ __forceinline__ void fox_cumsum_item(const bf16* u, const float* foxb, float* cl, float* tot, int item, int lane) {
    const int bhf = item >> 3, seg = item & 7, b = bhf / 6, h = bhf % 6;
    const float fb = foxb[h];
    const bf16* p = u + ((size_t)b * S + seg * 256 + 4 * lane) * NU + 3456 + h;
    const float L2E = 1.4426950408889634f;
    float l0 = L2E * log_sigmoid_f(bf2f(p[0]) + fb), l1 = L2E * log_sigmoid_f(bf2f(p[NU]) + fb), l2 = L2E * log_sigmoid_f(bf2f(p[2 * NU]) + fb), l3 = L2E * log_sigmoid_f(bf2f(p[3 * NU]) + fb);
    l1 += l0; l2 += l1; l3 += l2;
    float inc = l3;
#pragma unroll
    for (int o = 1; o < 64; o <<= 1) { const float v = __shfl_up(inc, o, 64); if (lane >= o) inc += v; }
    const float ex = inc - l3;
    { float* d = cl + (size_t)bhf * S + seg * 256 + 4 * lane; st_wt64(d, ex + l0, ex + l1); st_wt64(d + 2, ex + l2, ex + l3); }
    if (lane == 63) st_wt32(tot + bhf * 8 + seg, inc);
}
constexpr int PV64 = 144;
__device__ __forceinline__ void attn_mfma_item(const bf16* u, bf16* y, const float* cl, const float* tot, LAS unsigned char* wl, int item, int lane) {
    const int bh = item % 80, qb = 63 - item / 80;
    const bool fox = bh < 48;
    int b, h, qoff, koff, voff, yoff;
    if (fox) { b = bh / 6; h = bh % 6; qoff = h * 64; koff = 384 + h * 64; voff = 768 + h * 64; yoff = h * 64; }
    else { const int rr = bh - 48; b = rr / 4; h = rr % 4; qoff = 1152 + h * 64; koff = 1408 + h * 64; voff = 1664 + h * 64; yoff = 384 + h * 64; }
    const int r = lane & 31, hi = lane >> 5;
    const char* ubc = (const char*)(u + (size_t)b * S * NU);
    const int t = qb * 32 + r;
    const float* clh = cl + (size_t)(fox ? bh : 0) * S;
    s16x8 Qf[4];
    { const unsigned qo = (unsigned)(t * NU + qoff + 8 * hi) * 2u;
#pragma unroll
      for (int d0 = 0; d0 < 4; ++d0) Qf[d0] = *(const s16x8*)(ubc + qo + 32 * d0); }
    f32x16 O0, O1;
#pragma unroll
    for (int i = 0; i < 16; ++i) { O0[i] = 0.f; O1[i] = 0.f; }
    float mrun = -1e30f, lsum = 0.f, Rsb = 1.f, Doff = 0.f;
    const float clt = fox ? clh[t] : 0.f;
    LAS float* gl = (LAS float*)(wl + 4608);
    const int trbase = (4 * hi + ((lane >> 2) & 3)) * PV64 + (16 * ((lane >> 4) & 1) + 4 * (lane & 3)) * 2;
    const unsigned lane_off = (unsigned)((lane >> 3) * NU + 8 * (lane & 7)) * 2u;
    v4u kn[4], vn[4]; float gn = 0.f;
    { const char* tb = ubc + (size_t)(qb * 32) * NU * 2;
#pragma unroll
      for (int i = 0; i < 4; ++i) { kn[i] = *(const v4u*)(tb + (size_t)(8 * i * NU + koff) * 2 + lane_off); vn[i] = *(const v4u*)(tb + (size_t)(8 * i * NU + voff) * 2 + lane_off); }
      if (fox) gn = clh[qb * 32 + r]; }
    LAS unsigned char* kl = wl + 4736;
    const int kfoff = r * PV64 + 16 * hi;
    const float SC2 = 0.125f * 1.4426950408889634f;
    { LAS unsigned char* z = wl + 9344 + (lane >> 3) * PV64 + 16 * (lane & 7);
#pragma unroll
      for (int i = 0; i < 4; ++i) *(LAS v4u*)(z + 8 * i * PV64) = (v4u){0u, 0u, 0u, 0u}; }
    s16x8 Pp0 = {0, 0, 0, 0, 0, 0, 0, 0}, Pp1 = {0, 0, 0, 0, 0, 0, 0, 0};
    for (int jt = qb; jt >= 0; --jt) {
        const bool diag = (jt == qb);
        const int vcur = ((qb - jt) & 1) ? 9344 : 0, vprev = 9344 - vcur;
        { LAS unsigned char* dk = kl + (lane >> 3) * PV64 + 16 * (lane & 7); LAS unsigned char* dv = wl + vcur + (lane >> 3) * PV64 + 16 * (lane & 7);
#pragma unroll
          for (int i = 0; i < 4; ++i) { *(LAS v4u*)(dk + 8 * i * PV64) = kn[i]; *(LAS v4u*)(dv + 8 * i * PV64) = vn[i]; } }
        if (fox) gl[r] = -gn;
        if (jt > 0) { const char* tb = ubc + (size_t)((jt - 1) * 32) * NU * 2;
#pragma unroll
          for (int i = 0; i < 4; ++i) { kn[i] = *(const v4u*)(tb + (size_t)(8 * i * NU + koff) * 2 + lane_off); vn[i] = *(const v4u*)(tb + (size_t)(8 * i * NU + voff) * 2 + lane_off); }
          if (fox) gn = clh[(jt - 1) * 32 + r]; }
        s16x8 Kf[4];
#pragma unroll
        for (int d0 = 0; d0 < 4; ++d0) Kf[d0] = *(LAS const s16x8*)(kl + kfoff + 32 * d0);
        LAS const unsigned char* vb = wl + vprev + trbase;
        const s16x8 V00 = cat8(tr_read(vb), tr_read(vb + 8 * PV64)), V01 = cat8(tr_read(vb + 16 * PV64), tr_read(vb + 24 * PV64));
        const s16x8 V10 = cat8(tr_read(vb + 64), tr_read(vb + 8 * PV64 + 64)), V11 = cat8(tr_read(vb + 16 * PV64 + 64), tr_read(vb + 24 * PV64 + 64));
        f32x16 Sx;
#pragma unroll
        for (int i = 0; i < 16; ++i) Sx[i] = 0.f;
        Sx = MFMA32(Kf[0], Qf[0], Sx); O0 = MFMA32(V00, Pp0, O0);
        Sx = MFMA32(Kf[1], Qf[1], Sx); O1 = MFMA32(V10, Pp0, O1);
        Sx = MFMA32(Kf[2], Qf[2], Sx); O0 = MFMA32(V01, Pp1, O0);
        Sx = MFMA32(Kf[3], Qf[3], Sx); O1 = MFMA32(V11, Pp1, O1);
        float P[16];
        if (fox) {
            const float off = clt + Doff;
            float tmax = -1e30f;
#pragma unroll
            for (int g = 0; g < 4; ++g) { const f32x4 ncs = *(LAS const f32x4*)(gl + 8 * g + 4 * hi);
#pragma unroll
                for (int e = 0; e < 4; ++e) P[4 * g + e] = fmaf(SC2, Sx[4 * g + e], ncs[e]); }
            if (diag) {
#pragma unroll
                for (int i = 0; i < 16; ++i) { const int sl = 8 * (i >> 2) + 4 * hi + (i & 3); if (sl > r) P[i] = -1e30f; } }
#pragma unroll
            for (int i = 0; i < 16; ++i) tmax = fmaxf(tmax, P[i]);
            tmax = xh_max(tmax) + off;
            if (__any(tmax > mrun)) {
                const float mnew = fmaxf(mrun, tmax), alpha = __builtin_amdgcn_exp2f(mrun - mnew); lsum *= alpha; mrun = mnew;
#pragma unroll
                for (int i = 0; i < 16; ++i) { O0[i] *= alpha; O1[i] *= alpha; } }
            const float msh = mrun - off; float ps = 0.f;
#pragma unroll
            for (int i = 0; i < 16; ++i) { P[i] = __builtin_amdgcn_exp2f(P[i] - msh); ps += P[i]; }
            lsum += ps;
            if (jt > 0 && ((jt - 1) >> 3) != (jt >> 3)) Doff += tot[bh * 8 + ((jt - 1) >> 3)];
        } else {
            float kp[16], gs[4], go[4]; float T = 1.f;
#pragma unroll
            for (int i = 0; i < 16; ++i) { const float ee = __builtin_amdgcn_exp2f(-SC2 * Sx[i]); const float sig = __builtin_amdgcn_rcpf(1.0f + ee); P[i] = sig; kp[i] = 1.0f - sig; }
            if (diag) {
#pragma unroll
                for (int i = 0; i < 16; ++i) { const int sl = 8 * (i >> 2) + 4 * hi + (i & 3); if (sl >= r) { P[i] = 0.f; kp[i] = 1.f; } } }
#pragma unroll
            for (int g = 0; g < 4; ++g) { gs[g] = (kp[4 * g] * kp[4 * g + 1]) * (kp[4 * g + 2] * kp[4 * g + 3]); T *= gs[g]; }
#pragma unroll
            for (int g = 0; g < 4; ++g) go[g] = xh_other(gs[g]);
            float above = Rsb;
#pragma unroll
            for (int g = 3; g >= 0; --g) {
                float suf = hi == 0 ? above * go[g] : above;
#pragma unroll
                for (int e = 3; e >= 0; --e) { const float a = P[4 * g + e] * suf; suf *= kp[4 * g + e]; P[4 * g + e] = a; }
                above *= gs[g] * go[g];
            }
            Rsb *= xh_prod(T);
        }
        Pp0 = pack8(P[0], P[1], P[2], P[3], P[4], P[5], P[6], P[7]); Pp1 = pack8(P[8], P[9], P[10], P[11], P[12], P[13], P[14], P[15]);
    }
    { LAS const unsigned char* vb = wl + ((qb & 1) ? 9344 : 0) + trbase;
      const s16x8 V00 = cat8(tr_read(vb), tr_read(vb + 8 * PV64)), V01 = cat8(tr_read(vb + 16 * PV64), tr_read(vb + 24 * PV64));
      const s16x8 V10 = cat8(tr_read(vb + 64), tr_read(vb + 8 * PV64 + 64)), V11 = cat8(tr_read(vb + 16 * PV64 + 64), tr_read(vb + 24 * PV64 + 64));
      O0 = MFMA32(V00, Pp0, O0); O1 = MFMA32(V10, Pp0, O1); O0 = MFMA32(V01, Pp1, O0); O1 = MFMA32(V11, Pp1, O1); }
    float inv = 1.0f;
    if (fox) { lsum = xh_sum(lsum); inv = __builtin_amdgcn_rcpf(lsum); }
    char* yb0 = (char*)(y + (size_t)b * S * D); const unsigned yo = (unsigned)(t * D + yoff + 4 * hi) * 2u;
#pragma unroll
    for (int g = 0; g < 4; ++g) {
        unsigned long long w0 = (unsigned long long)cvtpk(O0[4 * g] * inv, O0[4 * g + 1] * inv) | ((unsigned long long)cvtpk(O0[4 * g + 2] * inv, O0[4 * g + 3] * inv) << 32);
        unsigned long long w1 = (unsigned long long)cvtpk(O1[4 * g] * inv, O1[4 * g + 1] * inv) | ((unsigned long long)cvtpk(O1[4 * g + 2] * inv, O1[4 * g + 3] * inv) << 32);
        *(unsigned long long*)(yb0 + yo + 16 * g) = w0; *(unsigned long long*)(yb0 + yo + 64 + 16 * g) = w1; }
}
constexpr int PV128 = 272;
__device__ __forceinline__ void xattn_mfma_item(const bf16* qx, const bf16* kv, bf16* ox, LAS unsigned char* wl, int item, int lane) {
    const int head = item & 3, qblk = item >> 2;
    const int r = lane & 31, hi = lane >> 5;
    const int token = qblk * 32 + r, b = (qblk * 32) / S;
    s16x8 Qf[8];
    { const char* qb_ = (const char*)qx; const unsigned qo = (unsigned)(token * DX + head * 128 + 8 * hi) * 2u;
#pragma unroll
      for (int d0 = 0; d0 < 8; ++d0) Qf[d0] = *(const s16x8*)(qb_ + qo + 32 * d0); }
    f32x16 O[4];
#pragma unroll
    for (int k = 0; k < 4; ++k)
#pragma unroll
        for (int i = 0; i < 16; ++i) O[k][i] = 0.f;
    float mrun = -1e30f, lsum = 0.f;
    const int trbase = (4 * hi + ((lane >> 2) & 3)) * PV128 + (16 * ((lane >> 4) & 1) + 4 * (lane & 3)) * 2;
    const char* kvc = (const char*)(kv + (size_t)b * MEML * 1024);
    const unsigned kfo = (unsigned)(r * 1024 + head * 128 + 8 * hi) * 2u;
    const unsigned vlo = (unsigned)((lane >> 4) * 1024 + 512 + head * 128 + 8 * (lane & 15)) * 2u;
    s16x8 Kn[8]; v4u vn[8];
#pragma unroll
    for (int d0 = 0; d0 < 8; ++d0) Kn[d0] = *(const s16x8*)(kvc + kfo + 32 * d0);
#pragma unroll
    for (int i = 0; i < 8; ++i) vn[i] = *(const v4u*)(kvc + vlo + (size_t)(4 * i) * 2048);
    const float SCX = 0.08838834764831845f * 1.4426950408889634f;
    for (int jt = 0; jt < 8; ++jt) {
        f32x16 Sx;
#pragma unroll
        for (int i = 0; i < 16; ++i) Sx[i] = 0.f;
#pragma unroll
        for (int d0 = 0; d0 < 8; ++d0) Sx = MFMA32(Kn[d0], Qf[d0], Sx);
        { LAS unsigned char* dst = wl + (lane >> 4) * PV128 + 16 * (lane & 15);
#pragma unroll
          for (int i = 0; i < 8; ++i) *(LAS v4u*)(dst + 4 * i * PV128) = vn[i]; }
        if (jt < 7) { const char* tb = kvc + (size_t)((jt + 1) * 32) * 2048;
#pragma unroll
            for (int d0 = 0; d0 < 8; ++d0) Kn[d0] = *(const s16x8*)(tb + kfo + 32 * d0);
#pragma unroll
            for (int i = 0; i < 8; ++i) vn[i] = *(const v4u*)(tb + vlo + (size_t)(4 * i) * 2048); }
        float P[16]; float tmax = -1e30f;
#pragma unroll
        for (int i = 0; i < 16; ++i) { P[i] = Sx[i] * SCX; tmax = fmaxf(tmax, P[i]); }
        tmax = xh_max(tmax);
        if (__any(tmax > mrun)) { const float mnew = fmaxf(mrun, tmax), alpha = __builtin_amdgcn_exp2f(mrun - mnew); lsum *= alpha; mrun = mnew;
#pragma unroll
            for (int k = 0; k < 4; ++k)
#pragma unroll
                for (int i = 0; i < 16; ++i) O[k][i] *= alpha; }
        float ps = 0.f;
#pragma unroll
        for (int i = 0; i < 16; ++i) { P[i] = __builtin_amdgcn_exp2f(P[i] - mrun); ps += P[i]; }
        lsum += ps;
        const s16x8 Pf0 = pack8(P[0], P[1], P[2], P[3], P[4], P[5], P[6], P[7]), Pf1 = pack8(P[8], P[9], P[10], P[11], P[12], P[13], P[14], P[15]);
        LAS const unsigned char* vb = wl + trbase;
#pragma unroll
        for (int k = 0; k < 4; ++k) {
            const s16x8 Va = cat8(tr_read(vb + 64 * k), tr_read(vb + 8 * PV128 + 64 * k)), Vb = cat8(tr_read(vb + 16 * PV128 + 64 * k), tr_read(vb + 24 * PV128 + 64 * k));
            O[k] = MFMA32(Va, Pf0, O[k]); O[k] = MFMA32(Vb, Pf1, O[k]); }
    }
    lsum = xh_sum(lsum); const float inv = __builtin_amdgcn_rcpf(lsum);
    char* oc = (char*)ox; const unsigned oo = (unsigned)(token * DX + head * 128 + 4 * hi) * 2u;
#pragma unroll
    for (int k = 0; k < 4; ++k)
#pragma unroll
        for (int g = 0; g < 4; ++g) {
            const unsigned long long w0 = (unsigned long long)cvtpk(O[k][4 * g] * inv, O[k][4 * g + 1] * inv) | ((unsigned long long)cvtpk(O[k][4 * g + 2] * inv, O[k][4 * g + 3] * inv) << 32);
            *(unsigned long long*)(oc + oo + 64 * k + 16 * g) = w0; }
}

constexpr int ML_WSTRIDE = 18432, ML_RAWK = 0, ML_RAWQ = 5056, ML_WK = 5056, ML_V = 10112, ML_CW = 14720, ML_EB = 16768, ML_NL = 16896, ML_NW = 17152, ML_ITEM_F = 4224;
template <bool OUT>
__device__ __forceinline__ void mlstm_item(const bf16* u, bf16* y, float* scratch, const float* convw, const float* ib, const float* fbias, const float* normw, LAS unsigned char* wl, int bh, int c, int lane) {
    const int b = bh / 6, h = bh % 6, r = lane & 31, hi = lane >> 5;
    const bf16* ub = u + (size_t)b * S * NU;
    LAS float* cw = (LAS float*)(wl + ML_CW); LAS float* eb = (LAS float*)(wl + ML_EB); LAS float* nl = (LAS float*)(wl + ML_NL); LAS float* nwl = (LAS float*)(wl + ML_NW);
    for (int i = lane; i < 512; i += 64) { const int tap = i >> 7, ch = i & 127; cw[i] = convw[tap * 768 + (ch < 64 ? (64 * h + ch) : (384 + 64 * h + (ch - 64)))]; }
    if (OUT) nwl[lane] = normw[h * 64 + lane];
    const float ibh = ib[h], fbh = fbias[h];
    f32x16 X[2][2];
#pragma unroll
    for (int a = 0; a < 2; ++a)
#pragma unroll
        for (int bb = 0; bb < 2; ++bb)
#pragma unroll
            for (int i = 0; i < 16; ++i) X[a][bb][i] = 0.f;
    float nk = 0.f, Gsum = 0.f;
    if (OUT) {
        float dec = 1.f;
        for (int cp = c - 1; cp >= 0; --cp) {
            const float* s0 = scratch + (size_t)(bh * 16 + cp) * ML_ITEM_F;
            f32x16 v0[4];
#pragma unroll
            for (int blk = 0; blk < 4; ++blk) v0[blk] = *(const f32x16*)(s0 + blk * 1024 + lane * 16);
            const float n0 = s0[4096 + lane], g0 = s0[4160];
#pragma unroll
            for (int blk = 0; blk < 4; ++blk) X[blk >> 1][blk & 1] += v0[blk] * dec;
            nk += dec * n0;
            dec *= __expf(g0);
        }
    }
    nl[lane] = nk;
    const int trP = (4 * hi + ((lane >> 2) & 3)) * 144 + (16 * ((lane >> 4) & 1) + 4 * (lane & 3)) * 2;
    const int trN = (8 * hi + ((lane >> 2) & 3)) * 144 + (16 * ((lane >> 4) & 1) + 4 * (lane & 3)) * 2;
    for (int j = 0; j < 4; ++j) {
        const int t0 = c * 128 + j * 32, t = t0 + r;
        const bf16* trow = ub + (size_t)t * NU;
        const unsigned short gfr = trow[3468 + h], gir = trow[3462 + h];
        v4u vv[4], rk[5], rq[5];
        { const bf16* vrow = ub + (size_t)(t0 + (lane >> 3)) * NU + 2688 + 64 * h + 8 * (lane & 7);
#pragma unroll
          for (int i = 0; i < 4; ++i) vv[i] = *(const v4u*)(vrow + (size_t)(8 * i) * NU); }
#pragma unroll
        for (int i = 0; i < 5; ++i) { const int p = lane + 64 * i, row = p >> 3, ch8 = p & 7, tt = t0 - 3 + row; const bool ok = (p < 280) && (tt >= 0);
            const bf16* src = ub + (size_t)(ok ? tt : 0) * NU + 1920 + 64 * h + 8 * ch8;
            rk[i] = ok ? *(const v4u*)(src + 384) : (v4u){0u, 0u, 0u, 0u};
            if (OUT) rq[i] = ok ? *(const v4u*)(src) : (v4u){0u, 0u, 0u, 0u}; }
#pragma unroll
        for (int i = 0; i < 5; ++i) { const int p = lane + 64 * i, row = p >> 3, ch8 = p & 7;
            if (p < 280) { *(LAS v4u*)(wl + ML_RAWK + row * 144 + 16 * ch8) = rk[i]; if (OUT) *(LAS v4u*)(wl + ML_RAWQ + row * 144 + 16 * ch8) = rq[i]; } }
        { LAS unsigned char* dst = wl + ML_V + (lane >> 3) * 144 + 16 * (lane & 7);
#pragma unroll
          for (int i = 0; i < 4; ++i) *(LAS v4u*)(dst + 8 * i * 144) = vv[i]; }
        float bl = log_sigmoid_f(bf2f(gfr) + fbh); const float ii = bf2f(gir) + ibh;
#pragma unroll
        for (int o = 1; o < 32; o <<= 1) { const float v = __shfl_up(bl, o, 32); if (r >= o) bl += v; }
        const float g = __shfl(bl, 31, 32), es = ii - bl;
        eb[r] = es; Gsum += g;
        s16x8 Kf[4], Qf[4]; float dq = 0.f;
#pragma unroll
        for (int part = (OUT ? 0 : 1); part < 2; ++part) {
            LAS const unsigned char* raw = wl + (part ? ML_RAWK : ML_RAWQ);
#pragma unroll
            for (int f = 0; f < 4; ++f) { float vals[8];
#pragma unroll
                for (int e = 0; e < 2; ++e) { const int ch = 16 * f + 8 * e + 4 * hi; float a0 = 0.f, a1 = 0.f, a2 = 0.f, a3 = 0.f;
#pragma unroll
                    for (int tap = 0; tap < 4; ++tap) { const unsigned long long xw = *(LAS const unsigned long long*)(raw + (r + tap) * 144 + ch * 2);
                        const f32x4 w = *(LAS const f32x4*)(cw + tap * 128 + part * 64 + ch); const unsigned x0 = (unsigned)xw, x1 = (unsigned)(xw >> 32);
                        a0 += w[0] * lo_f(x0); a1 += w[1] * hi_f(x0); a2 += w[2] * lo_f(x1); a3 += w[3] * hi_f(x1); }
                    const float sc = part ? 0.125f : 1.0f;
                    vals[4 * e + 0] = a0 * sc * __builtin_amdgcn_rcpf(1.0f + __expf(-a0)); vals[4 * e + 1] = a1 * sc * __builtin_amdgcn_rcpf(1.0f + __expf(-a1));
                    vals[4 * e + 2] = a2 * sc * __builtin_amdgcn_rcpf(1.0f + __expf(-a2)); vals[4 * e + 3] = a3 * sc * __builtin_amdgcn_rcpf(1.0f + __expf(-a3));
                    if (OUT && part == 0) { const f32x4 n4 = *(LAS const f32x4*)(nl + ch); dq += vals[4 * e] * n4[0] + vals[4 * e + 1] * n4[1] + vals[4 * e + 2] * n4[2] + vals[4 * e + 3] * n4[3]; } }
                const s16x8 fr = pack8(vals[0], vals[1], vals[2], vals[3], vals[4], vals[5], vals[6], vals[7]);
                if (part) Kf[f] = fr; else Qf[f] = fr; }
        }
        if (OUT) {
            f32x16 Sx;
#pragma unroll
            for (int i = 0; i < 16; ++i) Sx[i] = 0.f;
#pragma unroll
            for (int f = 0; f < 4; ++f) Sx = MFMA32(Kf[f], Qf[f], Sx);
            float P[16]; float den = 0.f;
#pragma unroll
            for (int g4 = 0; g4 < 4; ++g4) { const f32x4 e4 = *(LAS const f32x4*)(eb + 8 * g4 + 4 * hi);
#pragma unroll
                for (int e = 0; e < 4; ++e) { const int sl = 8 * g4 + 4 * hi + e; const float d = (sl <= r) ? __expf(bl + e4[e]) : 0.f; P[4 * g4 + e] = Sx[4 * g4 + e] * d; den += P[4 * g4 + e]; } }
            den = xh_sum(den); dq = xh_sum(dq);
            const float ebt = __expf(bl);
            const float inv = 1.0f / fmaxf(fabsf(den + ebt * dq), 1.0f);
            const s16x8 Pf0 = pack8(P[0], P[1], P[2], P[3], P[4], P[5], P[6], P[7]), Pf1 = pack8(P[8], P[9], P[10], P[11], P[12], P[13], P[14], P[15]);
            unsigned long long ow[8];
#pragma unroll
            for (int vb = 0; vb < 2; ++vb)
#pragma unroll
                for (int g4 = 0; g4 < 4; ++g4) ow[4 * vb + g4] = *(const unsigned long long*)(trow + 3072 + 64 * h + 32 * vb + 8 * g4 + 4 * hi);
            f32x16 H[2]; float ms = 0.f;
#pragma unroll
            for (int vb = 0; vb < 2; ++vb) {
                LAS const unsigned char* vp = wl + ML_V + trP + 64 * vb;
                f32x16 Zi, Zx;
#pragma unroll
                for (int i = 0; i < 16; ++i) { Zi[i] = 0.f; Zx[i] = 0.f; }
                Zi = MFMA32(cat8(tr_read(vp), tr_read(vp + 8 * 144)), Pf0, Zi); Zi = MFMA32(cat8(tr_read(vp + 16 * 144), tr_read(vp + 24 * 144)), Pf1, Zi);
#pragma unroll
                for (int kb = 0; kb < 2; ++kb)
#pragma unroll
                    for (int sp = 0; sp < 2; ++sp) { const f32x16& xx = X[kb][vb];
                        const s16x8 xa = pack8(xx[8 * sp], xx[8 * sp + 1], xx[8 * sp + 2], xx[8 * sp + 3], xx[8 * sp + 4], xx[8 * sp + 5], xx[8 * sp + 6], xx[8 * sp + 7]);
                        Zx = MFMA32(xa, Qf[2 * kb + sp], Zx); }
#pragma unroll
                for (int i = 0; i < 16; ++i) { const float hv = (Zi[i] + ebt * Zx[i]) * inv; H[vb][i] = hv; ms += hv * hv; }
            }
            ms = xh_sum(ms);
            const float rs = rsqrtf(ms * (1.0f / 64.0f) + 1e-6f);
            bf16* yrow = y + ((size_t)b * S + t) * D + 640 + 64 * h;
#pragma unroll
            for (int vb = 0; vb < 2; ++vb)
#pragma unroll
                for (int g4 = 0; g4 < 4; ++g4) { const int v = 32 * vb + 8 * g4 + 4 * hi;
                    const unsigned o0 = (unsigned)ow[4 * vb + g4], o1 = (unsigned)(ow[4 * vb + g4] >> 32);
                    const f32x4 w4 = *(LAS const f32x4*)(nwl + v);
                    const float y0 = H[vb][4 * g4] * rs * w4[0] * sigmoid_f(lo_f(o0)), y1 = H[vb][4 * g4 + 1] * rs * w4[1] * sigmoid_f(hi_f(o0));
                    const float y2 = H[vb][4 * g4 + 2] * rs * w4[2] * sigmoid_f(lo_f(o1)), y3 = H[vb][4 * g4 + 3] * rs * w4[3] * sigmoid_f(hi_f(o1));
                    *(unsigned long long*)(yrow + v) = (unsigned long long)cvtpk(y0, y1) | ((unsigned long long)cvtpk(y2, y3) << 32); }
        }
        { const float wsc = __expf(g + es), eg = __expf(g);
#pragma unroll
          for (int f = 0; f < 4; ++f) { const v4u kw = __builtin_bit_cast(v4u, Kf[f]);
#pragma unroll
              for (int e = 0; e < 2; ++e) { const unsigned k0 = e ? kw.z : kw.x, k1 = e ? kw.w : kw.y; const int ch = 16 * f + 8 * e + 4 * hi;
                  *(LAS unsigned long long*)(wl + ML_WK + r * 144 + ch * 2) = (unsigned long long)cvtpk(lo_f(k0) * wsc, hi_f(k0) * wsc) | ((unsigned long long)cvtpk(lo_f(k1) * wsc, hi_f(k1) * wsc) << 32); } }
#pragma unroll
          for (int kb = 0; kb < 2; ++kb)
#pragma unroll
              for (int vb = 0; vb < 2; ++vb) { X[kb][vb] *= eg;
#pragma unroll
                  for (int sp = 0; sp < 2; ++sp) { LAS const unsigned char* kp = wl + ML_WK + trN + 16 * sp * 144 + 64 * kb; LAS const unsigned char* vp = wl + ML_V + trN + 16 * sp * 144 + 64 * vb;
                      X[kb][vb] = MFMA32(cat8(tr_read(kp), tr_read(kp + 4 * 144)), cat8(tr_read(vp), tr_read(vp + 4 * 144)), X[kb][vb]); } }
          float dn = 0.f;
#pragma unroll 8
          for (int s2 = 0; s2 < 32; ++s2) dn += bf2f(*(LAS const unsigned short*)(wl + ML_WK + s2 * 144 + 2 * lane));
          nk = eg * nk + dn; nl[lane] = nk; }
    }
    if (!OUT) {
        float* sp = scratch + (size_t)(bh * 16 + c) * ML_ITEM_F;
#pragma unroll
        for (int blk = 0; blk < 4; ++blk) {
#pragma unroll
            for (int i = 0; i < 8; ++i) st_wt64(sp + blk * 1024 + lane * 16 + 2 * i, X[blk >> 1][blk & 1][2 * i], X[blk >> 1][blk & 1][2 * i + 1]); }
        st_wt32(sp + 4096 + lane, nk);
        if (lane == 0) st_wt32(sp + 4160, Gsum);
    }
}

struct Args { const float* in[20]; float* out; unsigned char* ws; };
#define GEMM_PHASE(EpiT, SchedT, g, Sc, E) pg8::gemm_phase<EpiT, SchedT, true, true>(L, g, Sc, E)

__global__ void __launch_bounds__(512, 2) mega_fwd(Args a) {
    extern __shared__ __attribute__((aligned(16))) unsigned char lds[];
    LAS unsigned char* L = (LAS unsigned char*)lds;
    const int tid = threadIdx.x, lane = tid & 63, wave = __builtin_amdgcn_readfirstlane(tid >> 6);
    const int G = gridDim.x, bx = blockIdx.x;
    const int gw = bx * 8 + wave, NGW = G * 8;
    unsigned char* ws = a.ws;
    const float* x = a.in[0]; const float* mem = a.in[1];
    float* out = a.out;
    float* ssq = (float*)(ws + WS_SSQP); float* ssqm = (float*)(ws + WS_SSQP + 7 * MiB);
    bf16* ub = (bf16*)(ws + WS_U); bf16* actb = (bf16*)(ws + WS_U); bf16* yb = (bf16*)(ws + WS_Y); bf16* qxb = (bf16*)(ws + WS_QX); bf16* oxb = (bf16*)(ws + WS_OX);
    bf16* hb = (bf16*)(ws + WS_HB); bf16* memb = (bf16*)(ws + WS_MEMB); bf16* kvb = (bf16*)(ws + WS_KV);

    volatile LAS unsigned* bst = (volatile LAS unsigned*)(L + LDS_BARST); if (tid < 2) bst[tid] = 0u;
    __syncthreads();
    (void)xcd_barrier_post((unsigned*)(a.ws + WS_BAR), bst);
    {
        LAS float* tile = (LAS float*)L;
        constexpr int I_IN = 16 * 14, I_OUT = 16 * 4, I_XQ = 16 * 2, I_XKV = 16 * 4, I_XO = 8 * 4, I_GU = 16 * 22, I_DN = 44 * 4;
        constexpr int I_LAYER = I_IN + I_OUT + I_XQ + I_XKV + I_XO + I_GU + I_DN;
        for (int it = bx; it < 2 * I_LAYER; it += G) {
            const int l = it / I_LAYER; int r = it % I_LAYER;
            unsigned char* wl = ws + WS_W + (size_t)l * W_LAYER;
            if (r < I_IN) { conv_block_item(a.in[3] + (size_t)l * 1024 * 3474, nullptr, 3474, 1024, 1, a.in[2] + l * 1024, (bf16*)(wl + OW_IN), tile, r / 14, r % 14, tid); continue; } r -= I_IN;
            if (r < I_OUT) { conv_block_item(a.in[9] + (size_t)l * 1024 * 1024, nullptr, 1024, 1024, 0, nullptr, (bf16*)(wl + OW_OUT), tile, r / 4, r % 4, tid); continue; } r -= I_OUT;
            if (r < I_XQ) { conv_block_item(a.in[12] + (size_t)l * 1024 * 512, nullptr, 512, 1024, 0, a.in[10] + l * 1024, (bf16*)(wl + OW_XQ), tile, r / 2, r % 2, tid); continue; } r -= I_XQ;
            if (r < I_XKV) { conv_block_item(a.in[13] + (size_t)l * 1024 * 1024, nullptr, 1024, 1024, 0, a.in[11] + l * 1024, (bf16*)(wl + OW_XKV), tile, r / 4, r % 4, tid); continue; } r -= I_XKV;
            if (r < I_XO) { conv_block_item(a.in[14] + (size_t)l * 512 * 1024, nullptr, 1024, 512, 0, nullptr, (bf16*)(wl + OW_XO), tile, r / 4, r % 4, tid); continue; } r -= I_XO;
            if (r < I_GU) { conv_block_item(a.in[16] + (size_t)l * 1024 * DFF, a.in[17] + (size_t)l * 1024 * DFF, DFF, 1024, 2, a.in[15] + l * 1024, (bf16*)(wl + OW_GU), tile, r / 22, r % 22, tid); continue; } r -= I_GU;
            conv_block_item(a.in[18] + (size_t)l * DFF * 1024, nullptr, 1024, DFF, 0, nullptr, (bf16*)(wl + OW_DN), tile, r / 4, r % 4, tid);
        }
        for (int m = gw; m < M; m += NGW) row_to_bf16_ssq(x + (size_t)m * D, hb + (size_t)m * D, ssq + (size_t)m * 16, lane);
        for (int m = gw; m < MROWS; m += NGW) row_to_bf16_ssq(mem + (size_t)m * D, memb + (size_t)m * D, ssqm + (size_t)m * 16, lane);
        { float* prm = (float*)(ws + WS_PRM);
          for (int i = bx * 512 + tid; i < 2 * 8192 + 1024; i += G * 512) {
              float v = 0.f;
              if (i >= 2 * 8192) v = a.in[19][i - 2 * 8192];
              else { const int l = i >> 13, o = i & 8191;
                  if (o < 6) v = a.in[4][l * 6 + o]; else if (o >= 8 && o < 14) v = a.in[6][l * 6 + o - 8]; else if (o >= 16 && o < 22) v = a.in[7][l * 6 + o - 16];
                  else if (o >= 64 && o < 448) v = a.in[8][l * 384 + o - 64]; else if (o >= 512 && o < 3584) v = a.in[5][l * 3072 + o - 512]; }
              prm[i] = v; } }
    }
#define XBAR() do { XcdBarrier xb_; xb_.bar = (unsigned*)(ws + WS_BAR); xb_.x = xb_xcc_id(); xb_.st = (volatile LAS unsigned*)(L + LDS_BARST); xcd_barrier(xb_); } while (0)
    { unsigned char* ws = a.ws; XBAR(); }
    for (int ph = 0; ph < 16; ++ph) {
        const int l = ph >> 3, k = ph & 7;
        size_t zoff = 0; asm volatile("" : "+s"(zoff)); unsigned char* ws = a.ws + zoff;
        const unsigned char* wl = ws + WS_W + (size_t)l * W_LAYER;
        float* ssq = (float*)(ws + WS_SSQP); float* ssqm = (float*)(ws + WS_SSQP + 7 * MiB);
        bf16* ub = (bf16*)(ws + WS_U); bf16* actb = (bf16*)(ws + WS_U); bf16* yb = (bf16*)(ws + WS_Y); bf16* qxb = (bf16*)(ws + WS_QX); bf16* oxb = (bf16*)(ws + WS_OX);
        bf16* hb = (bf16*)(ws + WS_HB); bf16* memb = (bf16*)(ws + WS_MEMB); bf16* kvb = (bf16*)(ws + WS_KV);
        int tid_p = threadIdx.x; asm volatile("" : "+v"(tid_p)); const int lane = tid_p & 63, wave = __builtin_amdgcn_readfirstlane(tid_p >> 6), gw = bx * 8 + wave;
        if (k == 0 || k == 3) {
            const int j0 = (ph == 0) ? 0 : 2;
            for (int j = j0; j < 3; ++j) {
                pg8::Gemm g; pg8::EpiScaleBf16 E; int off = 0;
                if (j < 2) { g = pg8::Gemm{memb, (const bf16*)(ws + WS_W + (size_t)j * W_LAYER + OW_XKV), MROWS, 1024, 1024}; E = pg8::EpiScaleBf16{kvb + (size_t)j * MROWS * 1024, 1024, ssqm}; off = 128 + 32 * j; }
                else if (k == 0) { g = pg8::Gemm{hb, (const bf16*)(wl + OW_IN), M, NU, 1024}; E = pg8::EpiScaleBf16{ub, NU, ssq + (size_t)(3 * l) * M * 16}; }
                else { g = pg8::Gemm{hb, (const bf16*)(wl + OW_XQ), M, DX, 1024}; E = pg8::EpiScaleBf16{qxb, DX, ssq + (size_t)(3 * l + 1) * M * 16}; }
                pg8::OffsetOrder Sc; Sc.init(g.M, g.N, G, bx, off);
                GEMM_PHASE(pg8::EpiScaleBf16, pg8::OffsetOrder, g, Sc, E);
            }
        } else if (k == 2 || k == 5 || k == 7) {
            pg8::Gemm g; pg8::EpiResid E;
            if (k == 2) { g = pg8::Gemm{yb, (const bf16*)(wl + OW_OUT), M, 1024, 1024}; E = pg8::EpiResid{hb, ssq + (size_t)(3 * l + 1) * M * 16}; }
            else if (k == 5) { g = pg8::Gemm{oxb, (const bf16*)(wl + OW_XO), M, 1024, DX}; E = pg8::EpiResid{hb, ssq + (size_t)(3 * l + 2) * M * 16}; }
            else { g = pg8::Gemm{actb, (const bf16*)(wl + OW_DN), M, 1024, DFF}; E = pg8::EpiResid{hb, ssq + (size_t)(3 * l + 3) * M * 16}; }
            pg8::StaticOrder Sc; Sc.init(g.M, g.N, G, bx);
            GEMM_PHASE(pg8::EpiResid, pg8::StaticOrder, g, Sc, E);
        } else if (k == 6) {
            pg8::Gemm g{hb, (const bf16*)(wl + OW_GU), M, 2 * DFF, 1024}; pg8::StaticOrder Sc; Sc.init(M, 2 * DFF, G, bx);
            pg8::EpiSwiglu E{actb, DFF, ssq + (size_t)(3 * l + 2) * M * 16};
            GEMM_PHASE(pg8::EpiSwiglu, pg8::StaticOrder, g, Sc, E);
        } else if (k == 1) {
            const float* prm = (const float*)(ws + WS_PRM) + l * 8192;
            float* mscr = out;
            float* fcl = out + 14 * MiB / 4; float* ftot = out + 15 * MiB / 4;
            const int xcd0 = (int)(xb_xcc_id() & 7u); unsigned okmask = 0u;
            for (int qi = 0; qi < 8; ++qi) {
            const int xcd = (xcd0 + qi) & 7;
            unsigned* ctr = (unsigned*)(ws + WS_BAR + 14336) + 16 * (l * 8 + xcd); unsigned* done = (unsigned*)(ws + WS_BAR + 15360) + 16 * (l * 8 + xcd);
            for (;;) {
                int it = 0; if (lane == 0) it = (int)atomicAdd(ctr, 1u); it = __builtin_amdgcn_readfirstlane(it);
                if (it >= 874) break;
                if (it < 138) {
                    if (it < 90) { __builtin_amdgcn_s_setprio(3); mlstm_item<false>(ub, yb, mscr, prm + 512, prm + 8, prm + 16, prm + 64, L + wave * ML_WSTRIDE, xcd + 8 * (it / 15), it % 15, lane); __builtin_amdgcn_s_setprio(0); }
                    else { const int ci = it - 90; fox_cumsum_item(ub, prm, fcl, ftot, (xcd + 8 * (ci >> 3)) * 8 + (ci & 7), lane); }
                    asm volatile("s_waitcnt vmcnt(0)" ::: "memory");
                    if (lane == 0) atomicAdd(done, 1u);
                } else {
                    if (it >= 394 && !((okmask >> xcd) & 1u)) { unsigned sp = 0u;
                        while (__hip_atomic_load(done, __ATOMIC_RELAXED, __HIP_MEMORY_SCOPE_AGENT) < 138u) { __builtin_amdgcn_s_sleep(4); if (++sp > (1u << 21)) break; }
                        __builtin_amdgcn_fence(__ATOMIC_ACQUIRE, "agent"); okmask |= 1u << xcd; }
                    if (it >= 394 && it < 490) { const int ci = it - 394; __builtin_amdgcn_s_setprio(3); mlstm_item<true>(ub, yb, mscr, prm + 512, prm + 8, prm + 16, prm + 64, L + wave * ML_WSTRIDE, xcd + 8 * (ci >> 4), 15 - (ci & 15), lane); __builtin_amdgcn_s_setprio(0); }
                    else { int aitem; if (it < 394) { const int ai = it - 138; aitem = (ai >> 2) * 80 + 48 + xcd + 8 * (ai & 3); } else { const int ai = it - 490; aitem = (ai / 6) * 80 + xcd + 8 * (ai % 6); }
                        attn_mfma_item(ub, yb, fcl, ftot, L + wave * ML_WSTRIDE, aitem, lane); }
                }
            }
            }
        } else {
            for (int it = gw; it < 2048; it += NGW) xattn_mfma_item(qxb, kvb + (size_t)l * MROWS * 1024, oxb, L + wave * 16384, it, lane);
        }
        XBAR();
    }
    {
        int tid_f = threadIdx.x; asm volatile("" : "+v"(tid_f)); const int lane = tid_f & 63, gw = bx * 8 + __builtin_amdgcn_readfirstlane(tid_f >> 6);
        const float* fw = (const float*)(a.ws + WS_PRM) + 2 * 8192; const float* sq = (const float*)(a.ws + WS_SSQP) + (size_t)6 * M * 16;
        const bf16* hbf = (const bf16*)(a.ws + WS_HB);
        for (int m = gw; m < M; m += NGW) {
            float sm = 0.f; { const f32x4* qp = (const f32x4*)(sq + (size_t)m * 16); const f32x4 q0 = qp[0], q1 = qp[1], q2 = qp[2], q3 = qp[3];
              sm = ((((q0[0] + q0[1]) + (q0[2] + q0[3])) + ((q1[0] + q1[1]) + (q1[2] + q1[3]))) + (((q2[0] + q2[1]) + (q2[2] + q2[3])) + ((q3[0] + q3[1]) + (q3[2] + q3[3])))); }
            const float rs = rsqrtf(sm * (1.0f / 1024.0f) + 1e-6f);
            const unsigned long long* hp = (const unsigned long long*)(hbf + (size_t)m * D) + lane; f32x4* rp = (f32x4*)(out + (size_t)m * D) + lane; const f32x4* wp = (const f32x4*)fw + lane;
#pragma unroll
            for (int j = 0; j < 4; ++j) { const unsigned long long hw = hp[64 * j]; const unsigned h0 = (unsigned)hw, h1 = (unsigned)(hw >> 32); const f32x4 w = wp[64 * j];
                f32x4 v = {lo_f(h0), hi_f(h0), lo_f(h1), hi_f(h1)}; v = v * rs * w; rp[64 * j] = v; }
        }
    }
}

extern "C" void kernel_launch(void* const* d_in, const int* in_sizes, int n_in, void* d_out, int out_size, void* d_ws, size_t ws_size, hipStream_t stream) {
    static int grid = 0;
    if (grid == 0) {
        if (n_in != 20 || out_size != M * D || ws_size < WS_END) { fprintf(stderr, "kernel_launch: unexpected shapes (n_in %d out %d ws %zu)\n", n_in, out_size, ws_size); grid = -1; return; }
        int dev = 0, cus = 0, per_cu = 0;
        hipGetDevice(&dev); hipDeviceGetAttribute(&cus, hipDeviceAttributeMultiprocessorCount, dev);
        if (hipFuncSetAttribute((const void*)mega_fwd, hipFuncAttributeMaxDynamicSharedMemorySize, LDS_BYTES) != hipSuccess) { fprintf(stderr, "kernel_launch: hipFuncSetAttribute failed\n"); grid = -1; return; }
        if (hipOccupancyMaxActiveBlocksPerMultiprocessor(&per_cu, (const void*)mega_fwd, 512, LDS_BYTES) != hipSuccess || per_cu < 1) { fprintf(stderr, "kernel_launch: occupancy query says %d\n", per_cu); (void)hipGetLastError(); per_cu = 1; }
        grid = cus * per_cu;
    }
    if (grid < 0) return;
    Args a{};
    for (int i = 0; i < 20; ++i) a.in[i] = (const float*)d_in[i];
    a.out = (float*)d_out; a.ws = (unsigned char*)d_ws;
    if (hipMemsetAsync((char*)d_ws + WS_BAR, 0, BAR_BYTES, stream) != hipSuccess) { fprintf(stderr, "kernel_launch: memset of the barrier words failed\n"); return; }
    void* args[] = {&a};
    hipError_t e = hipLaunchCooperativeKernel((const void*)mega_fwd, dim3(grid), dim3(512), args, LDS_BYTES, stream);
    if (e != hipSuccess) fprintf(stderr, "kernel_launch: cooperative launch failed: %s (grid %d)\n", hipGetErrorString(e), grid);
}
```

```cpp
#include <hip/hip_runtime.h>
#include <hip/hip_cooperative_groups.h>
#include <cstdio>
#include <cstdint>
#include <cmath>
namespace cg = cooperative_groups;
namespace pg8 {
#define PG8_LAS __attribute__((address_space(3)))
typedef unsigned short bf16_t;
typedef short bf16x8 __attribute__((ext_vector_type(8)));
typedef float f32x4 __attribute__((ext_vector_type(4)));
typedef unsigned u32x4 __attribute__((ext_vector_type(4)));
constexpr int BM = 256, BK = 64, HALF = 128, HTB = HALF * BK * 2  , STAGE_BYTES = 8 * HTB, NXCD = 8, WGM = 4;

__host__ __device__ __forceinline__ int lds_byte(int r, int c) { const int st = (r >> 4) * 2 + (c >> 5), rr = r & 15, cc = c & 31, ob = rr * 64 + cc * 2; return st * 1024 + (ob ^ (((ob >> 9) & 1) << 5)); }
__host__ __device__ __forceinline__ void stage_rc(int b, int& R, int& C) { const int st = b / 1024, sb = b % 1024, swz = sb ^ (((sb >> 9) & 1) << 5); R = (st >> 1) * 16 + swz / 64; C = (st & 1) * 32 + (swz % 64) / 2; }
__host__ __device__ __forceinline__ int perm32(int rho) { const int n = rho >> 4, i = rho & 15; return 8 * (i >> 2) + 4 * n + (i & 3); }

struct Unit { int pm, pn; };
struct Gemm { const bf16_t* A; const bf16_t* Bt; int M, N, K; };

struct StaticOrder {
    int nM, nN, nwg, G, c;
    __host__ __device__ void init(int M, int N, int G_, int c_) { nM = M / BM; nN = N / BM; nwg = nM * nN; G = G_; c = c_; }
    __host__ __device__ bool next(int i, Unit& u) const {
        const long L = (long)i * G + c; if (L >= nwg) return false;
        int wgid = (int)L; { const int q = nwg / NXCD, r = nwg % NXCD, xcd = wgid % NXCD, off = wgid / NXCD; wgid = (xcd < r ? xcd * (q + 1) : r * (q + 1) + (xcd - r) * q) + off; }
        const int nig = WGM * nN, gid = wgid / nig, fm = gid * WGM, gsz = (nM - fm) < WGM ? (nM - fm) : WGM;
        u.pm = fm + ((wgid % nig) % gsz); u.pn = (wgid % nig) / gsz; return true;
    }
    __device__ __forceinline__ void a_ready(const Unit&) const {}
    __device__ __forceinline__ void done(const Unit&) const {}
};

__device__ __forceinline__ unsigned cvt_pk_bf16(float lo, float hi) { unsigned r; asm volatile("v_cvt_pk_bf16_f32 %0, %1, %2" : "=v"(r) : "v"(lo), "v"(hi)); return r; }
typedef float f32x2 __attribute__((ext_vector_type(2)));
struct OffsetOrder {
    StaticOrder b;
    __device__ void init(int M, int N, int G, int c, int off) { b.init(M, N, G, (c + G - (off % G)) % G); }
    __device__ bool next(int i, Unit& u) const { return b.next(i, u); }
    __device__ __forceinline__ void a_ready(const Unit&) const {}
    __device__ __forceinline__ void done(const Unit&) const {}
};
struct EpiScaleBf16 {
    static constexpr bool PERM = true, AFTER_DRAIN = false;
    bf16_t* O; int ldc; const float* ssq;
    __device__ __forceinline__ void operator()(const f32x4 (&acc)[2][2][4][2], const Unit& u, int wr, int wc, int fr, int fq) const {
        const int row0 = u.pm * BM + wr * 64 + fr, col0 = u.pn * BM + wc * 32 + 8 * fq;
#pragma unroll
        for (int ai = 0; ai < 2; ++ai)
#pragma unroll
            for (int m = 0; m < 4; ++m) { const int row = row0 + ai * HALF + m * 16; const f32x4 q0 = *(const f32x4*)(ssq + (size_t)row * 16), q1 = *(const f32x4*)(ssq + (size_t)row * 16 + 4), q2 = *(const f32x4*)(ssq + (size_t)row * 16 + 8), q3 = *(const f32x4*)(ssq + (size_t)row * 16 + 12);
                const float rs = rsqrtf(((((q0[0] + q0[1]) + (q0[2] + q0[3])) + ((q1[0] + q1[1]) + (q1[2] + q1[3]))) + (((q2[0] + q2[1]) + (q2[2] + q2[3])) + ((q3[0] + q3[1]) + (q3[2] + q3[3])))) * (1.0f / 1024.0f) + 1e-6f);
                bf16_t* rowp = O + (size_t)row * ldc + col0;
#pragma unroll
                for (int bj = 0; bj < 2; ++bj) { const f32x4 v0 = acc[ai][bj][m][0] * rs, v1 = acc[ai][bj][m][1] * rs;
                    u32x4 w; w.x = cvt_pk_bf16(v0[0], v0[1]); w.y = cvt_pk_bf16(v0[2], v0[3]); w.z = cvt_pk_bf16(v1[0], v1[1]); w.w = cvt_pk_bf16(v1[2], v1[3]);
                    *(u32x4*)(rowp + bj * HALF) = w; } }
    }
};
struct EpiResid {
    static constexpr bool PERM = true, AFTER_DRAIN = false;
    bf16_t* hb; float* ssq;
    __device__ __forceinline__ void operator()(const f32x4 (&acc)[2][2][4][2], const Unit& u, int wr, int wc, int fr, int fq) const {
        const int row0 = u.pm * BM + wr * 64 + fr, col0 = u.pn * BM + wc * 32 + 8 * fq;
#pragma unroll
        for (int ai = 0; ai < 2; ++ai)
#pragma unroll
            for (int m = 0; m < 4; ++m) { const int row = row0 + ai * HALF + m * 16; const size_t off = (size_t)row * 1024 + col0; float part = 0.f;
#pragma unroll
                for (int bj = 0; bj < 2; ++bj) { const u32x4 b = *(const u32x4*)(hb + off + bj * HALF);
                    f32x4 v0 = acc[ai][bj][m][0], v1 = acc[ai][bj][m][1];
                    v0[0] += __uint_as_float(b.x << 16); v0[1] += __uint_as_float(b.x & 0xffff0000u); v0[2] += __uint_as_float(b.y << 16); v0[3] += __uint_as_float(b.y & 0xffff0000u);
                    v1[0] += __uint_as_float(b.z << 16); v1[1] += __uint_as_float(b.z & 0xffff0000u); v1[2] += __uint_as_float(b.w << 16); v1[3] += __uint_as_float(b.w & 0xffff0000u);
                    u32x4 w; w.x = cvt_pk_bf16(v0[0], v0[1]); w.y = cvt_pk_bf16(v0[2], v0[3]); w.z = cvt_pk_bf16(v1[0], v1[1]); w.w = cvt_pk_bf16(v1[2], v1[3]);
                    *(u32x4*)(hb + off + bj * HALF) = w;
                    part += (v0[0] * v0[0] + v0[1] * v0[1]) + (v0[2] * v0[2] + v0[3] * v0[3]) + (v1[0] * v1[0] + v1[1] * v1[1]) + (v1[2] * v1[2] + v1[3] * v1[3]); }
                part += __shfl_xor(part, 16); part += __shfl_xor(part, 32);
                if (fq == 0) ssq[(size_t)row * 16 + u.pn * 4 + wc] = part; }
    }
};
struct EpiSwiglu {
    static constexpr bool PERM = true, AFTER_DRAIN = false;
    bf16_t* O; int ldc; const float* ssq;
    __device__ __forceinline__ void operator()(const f32x4 (&acc)[2][2][4][2], const Unit& u, int wr, int wc, int fr, int fq) const {
        const int row0 = u.pm * BM + wr * 64 + fr, col0 = u.pn * HALF + wc * 32 + 8 * fq;
#pragma unroll
        for (int ai = 0; ai < 2; ++ai)
#pragma unroll
            for (int m = 0; m < 4; ++m) { const int row = row0 + ai * HALF + m * 16; const f32x4 q0 = *(const f32x4*)(ssq + (size_t)row * 16), q1 = *(const f32x4*)(ssq + (size_t)row * 16 + 4), q2 = *(const f32x4*)(ssq + (size_t)row * 16 + 8), q3 = *(const f32x4*)(ssq + (size_t)row * 16 + 12);
                const float rs = rsqrtf(((((q0[0] + q0[1]) + (q0[2] + q0[3])) + ((q1[0] + q1[1]) + (q1[2] + q1[3]))) + (((q2[0] + q2[1]) + (q2[2] + q2[3])) + ((q3[0] + q3[1]) + (q3[2] + q3[3])))) * (1.0f / 1024.0f) + 1e-6f);
                float a[8];
#pragma unroll
                for (int n = 0; n < 2; ++n)
#pragma unroll
                    for (int j = 0; j < 4; ++j) { const float g = acc[ai][0][m][n][j] * rs, up = acc[ai][1][m][n][j] * rs; a[4 * n + j] = g * up * __builtin_amdgcn_rcpf(1.0f + __expf(-g)); }
                u32x4 w; w.x = cvt_pk_bf16(a[0], a[1]); w.y = cvt_pk_bf16(a[2], a[3]); w.z = cvt_pk_bf16(a[4], a[5]); w.w = cvt_pk_bf16(a[6], a[7]);
                *(u32x4*)(O + (size_t)row * ldc + col0) = w; }
    }
};
template <class Epi, class Sched, bool ALIGN_EPI = false, bool SP2 = false>
__device__ __forceinline__ void gemm_phase(PG8_LAS unsigned char* lds, const Gemm g, const Sched& S, const Epi& E) {
    int tid_l = threadIdx.x; asm volatile("" : "+v"(tid_l));
    const int tid = tid_l, wid = __builtin_amdgcn_readfirstlane(tid >> 6), lane = tid & 63, wr = wid >> 2, wc = wid & 3, fr = lane & 15, fq = lane >> 4;
    const int K = g.K, nt = K / BK;
    unsigned voffA[2], voffB[2];
#pragma unroll
    for (int i = 0; i < 2; ++i) { int R, C; stage_rc(tid * 16 + i * 8192, R, C); const int Rb = Epi::PERM ? ((R & ~31) + perm32(R & 31)) : R;
        voffA[i] = (unsigned)(R * K + C) * 2u; voffB[i] = (unsigned)(Rb * K + C) * 2u; }
    const size_t kstep = (size_t)(BK * 2);
    const size_t hstep = (size_t)HALF * K * 2;
    const size_t tstep = 2 * hstep;
    const unsigned ldsw = (unsigned)wid * 1024u;
    const int aoff = lds_byte(wr * 64 + fr, fq * 8), boff = lds_byte(wc * 32 + fr, fq * 8);
#define PG8_SA(b, h) (((b) * 2 + (h)) * HTB)
#define PG8_SB(b, h) ((4 + (b) * 2 + (h)) * HTB)
#define PG8_STAGE(bufoff, gbase, voff) do { _Pragma("unroll") for (int _i = 0; _i < 2; ++_i) \
        __builtin_amdgcn_global_load_lds((const unsigned*)((const char*)(gbase) + (voff)[_i]), (PG8_LAS unsigned*)(lds + (bufoff) + ldsw + _i * 8192), 16, 0, 0); } while (0)
#define PG8_LDA(dst, b, h) do { _Pragma("unroll") for (int m = 0; m < 4; ++m) _Pragma("unroll") for (int k = 0; k < 2; ++k) dst[m][k] = *(const PG8_LAS bf16x8*)(lds + PG8_SA(b, h) + aoff + m * 2048 + k * 1024); } while (0)
#define PG8_LDB(dst, b, h) do { _Pragma("unroll") for (int n = 0; n < 2; ++n) _Pragma("unroll") for (int k = 0; k < 2; ++k) dst[n][k] = *(const PG8_LAS bf16x8*)(lds + PG8_SB(b, h) + boff + n * 2048 + k * 1024); } while (0)
#define PG8_MMA(ai, bj, At, Bt) do { __builtin_amdgcn_s_setprio(1); _Pragma("unroll") for (int m = 0; m < 4; ++m) _Pragma("unroll") for (int n = 0; n < 2; ++n) _Pragma("unroll") for (int k = 0; k < 2; ++k) \
        acc[ai][bj][m][n] = __builtin_amdgcn_mfma_f32_16x16x32_bf16(Bt[n][k], At[m][k], acc[ai][bj][m][n], 0, 0, 0); __builtin_amdgcn_s_setprio(0); } while (0)
#define PG8_WAIT_V(n) asm volatile("s_waitcnt vmcnt(" #n ")" ::: "memory")
#define PG8_WAIT_L(n) asm volatile("s_waitcnt lgkmcnt(" #n ")" ::: "memory")
#define PG8_BAR __builtin_amdgcn_s_barrier()
#define PG8_SCHED __builtin_amdgcn_sched_barrier(0)
    Unit cur, nxt; int ui = 0;
    if (!S.next(0, cur)) return;
    f32x4 acc[2][2][4][2];
#pragma unroll
    for (int a = 0; a < 2; ++a)
#pragma unroll
        for (int b = 0; b < 2; ++b)
#pragma unroll
            for (int m = 0; m < 4; ++m)
#pragma unroll
                for (int n = 0; n < 2; ++n) acc[a][b][m][n] = (f32x4){0.f, 0.f, 0.f, 0.f};
    bf16x8 At[4][2], B0[2][2], B1[2][2];
    const char* cA = (const char*)g.A + (size_t)cur.pm * tstep; const char* cB = (const char*)g.Bt + (size_t)cur.pn * tstep;
    S.a_ready(cur);
    if constexpr (SP2) {
        PG8_STAGE(PG8_SB(0, 0), cB, voffB); PG8_STAGE(PG8_SB(0, 1), cB + hstep, voffB); PG8_STAGE(PG8_SA(0, 0), cA, voffA); PG8_STAGE(PG8_SA(0, 1), cA + hstep, voffA);
        if (wr == 1) PG8_BAR;
        PG8_WAIT_V(2); PG8_BAR;
        PG8_STAGE(PG8_SB(1, 0), cB + kstep, voffB); PG8_STAGE(PG8_SA(1, 0), cA + kstep, voffA); PG8_STAGE(PG8_SB(1, 1), cB + hstep + kstep, voffB);
        PG8_WAIT_V(6); PG8_BAR;
    } else {
        PG8_STAGE(PG8_SB(0, 0), cB, voffB); PG8_STAGE(PG8_SA(0, 0), cA, voffA); PG8_STAGE(PG8_SB(0, 1), cB + hstep, voffB); PG8_STAGE(PG8_SA(0, 1), cA + hstep, voffA);
        if (wr == 1) PG8_BAR;
        PG8_WAIT_V(4); PG8_BAR;
        PG8_STAGE(PG8_SB(1, 0), cB + kstep, voffB); PG8_STAGE(PG8_SA(1, 0), cA + kstep, voffA); PG8_STAGE(PG8_SB(1, 1), cB + hstep + kstep, voffB);
        PG8_WAIT_V(6); PG8_BAR;
    }
    for (;;) {
        const bool has_next = S.next(ui + 1, nxt);
        const char* nA = has_next ? (const char*)g.A + (size_t)nxt.pm * tstep : cA; const char* nB = has_next ? (const char*)g.Bt + (size_t)nxt.pn * tstep : cB;
        for (int t = 0; t < nt; t += 2) {
            const bool last = (t == nt - 2);
            const char* a1 = cA + (size_t)(t + 1) * kstep;
            const char* a2 = last ? nA : cA + (size_t)(t + 2) * kstep; const char* b2 = last ? nB : cB + (size_t)(t + 2) * kstep;
            const char* a3 = a2 + kstep; const char* b3 = b2 + kstep;
            if (last && has_next) S.a_ready(nxt);
            if constexpr (SP2) {
            PG8_LDB(B0, 0, 0); PG8_LDB(B1, 0, 1); PG8_SCHED; PG8_LDA(At, 0, 0); PG8_STAGE(PG8_SA(1, 1), a1 + hstep, voffA);
            PG8_WAIT_V(8); PG8_WAIT_L(0); PG8_BAR; PG8_MMA(0, 0, At, B0); PG8_MMA(0, 1, At, B1); PG8_BAR; PG8_SCHED;
            PG8_LDA(At, 0, 1); PG8_STAGE(PG8_SB(0, 0), b2, voffB); PG8_STAGE(PG8_SB(0, 1), b2 + hstep, voffB); PG8_STAGE(PG8_SA(0, 0), a2, voffA);
            PG8_WAIT_V(8); PG8_WAIT_L(0); PG8_BAR; PG8_MMA(1, 0, At, B0); PG8_MMA(1, 1, At, B1); PG8_BAR; PG8_SCHED;
            PG8_LDB(B0, 1, 0); PG8_LDB(B1, 1, 1); PG8_SCHED; PG8_LDA(At, 1, 0); PG8_STAGE(PG8_SA(0, 1), a2 + hstep, voffA);
            PG8_WAIT_V(8); PG8_WAIT_L(0); PG8_BAR; PG8_MMA(0, 0, At, B0); PG8_MMA(0, 1, At, B1); PG8_BAR; PG8_SCHED;
            PG8_LDA(At, 1, 1); PG8_STAGE(PG8_SB(1, 0), b3, voffB); PG8_STAGE(PG8_SB(1, 1), b3 + hstep, voffB); PG8_STAGE(PG8_SA(1, 0), a3, voffA);
            PG8_WAIT_V(8); PG8_WAIT_L(0); PG8_BAR; PG8_MMA(1, 0, At, B0); PG8_MMA(1, 1, At, B1); PG8_BAR; PG8_SCHED;
            } else {
            PG8_LDB(B0, 0, 0); PG8_SCHED; PG8_LDA(At, 0, 0); PG8_STAGE(PG8_SA(1, 1), a1 + hstep, voffA);
            PG8_WAIT_L(8); PG8_BAR; PG8_WAIT_L(0); PG8_MMA(0, 0, At, B0); PG8_BAR; PG8_SCHED;
            PG8_LDB(B1, 0, 1); PG8_STAGE(PG8_SB(0, 0), b2, voffB);
            PG8_BAR; PG8_WAIT_L(0); PG8_MMA(0, 1, At, B1); PG8_BAR;
            PG8_LDA(At, 0, 1); PG8_STAGE(PG8_SA(0, 0), a2, voffA);
            PG8_BAR; PG8_WAIT_L(0); PG8_MMA(1, 0, At, B0); PG8_BAR; PG8_SCHED;
            PG8_STAGE(PG8_SB(0, 1), b2 + hstep, voffB);
            PG8_WAIT_V(6); PG8_BAR; PG8_MMA(1, 1, At, B1); PG8_BAR;
            PG8_LDB(B0, 1, 0); PG8_SCHED; PG8_LDA(At, 1, 0); PG8_STAGE(PG8_SA(0, 1), a2 + hstep, voffA);
            PG8_WAIT_L(8); PG8_BAR; PG8_WAIT_L(0); PG8_MMA(0, 0, At, B0); PG8_BAR; PG8_SCHED;
            PG8_LDB(B1, 1, 1); PG8_STAGE(PG8_SB(1, 0), b3, voffB);
            PG8_BAR; PG8_WAIT_L(0); PG8_MMA(0, 1, At, B1); PG8_BAR;
            PG8_LDA(At, 1, 1); PG8_STAGE(PG8_SA(1, 0), a3, voffA);
            PG8_BAR; PG8_WAIT_L(0); PG8_MMA(1, 0, At, B0); PG8_BAR; PG8_SCHED;
            PG8_STAGE(PG8_SB(1, 1), b3 + hstep, voffB);
            PG8_WAIT_V(6); PG8_BAR; PG8_MMA(1, 1, At, B1); PG8_BAR;
            }
        }
        if constexpr (ALIGN_EPI) { if (wr == 0) PG8_BAR; }
        if constexpr (!Epi::AFTER_DRAIN) { E(acc, cur, wr, wc, fr, fq); S.done(cur); }
        if (!has_next) break;
#pragma unroll
        for (int a = 0; a < 2; ++a)
#pragma unroll
            for (int b = 0; b < 2; ++b)
#pragma unroll
                for (int m = 0; m < 4; ++m)
#pragma unroll
                    for (int n = 0; n < 2; ++n) acc[a][b][m][n] = (f32x4){0.f, 0.f, 0.f, 0.f};
        cur = nxt; cA = nA; cB = nB; ++ui;
        if constexpr (ALIGN_EPI) { if (wr == 1) PG8_BAR; }
    }
    PG8_WAIT_V(0);
    if constexpr (!ALIGN_EPI) { if (wr == 0) PG8_BAR; }
    PG8_BAR;
    if constexpr (Epi::AFTER_DRAIN) { E.fused(acc, cur, wr, wc, fr, fq, lds, wid, lane); S.done(cur); }
#undef PG8_SA
#undef PG8_SB
#undef PG8_STAGE
#undef PG8_LDA
#undef PG8_LDB
#undef PG8_MMA
#undef PG8_WAIT_V
#undef PG8_WAIT_L
#undef PG8_BAR
#undef PG8_SCHED
}
}
#define LAS __attribute__((address_space(3)))
typedef unsigned short bf16;
typedef unsigned v4u __attribute__((ext_vector_type(4)));
typedef float f32x4 __attribute__((ext_vector_type(4)));

constexpr int NB = 8, S = 2048, D = 1024, M = NB * S, NU = 3584, DFF = 2816, MEML = 256, MROWS = NB * MEML, DX = 512;
constexpr size_t MiB = 1u << 20;
constexpr size_t WS_SSQ = 0;
constexpr size_t WS_SSQM = 512 * 1024;
constexpr size_t WS_BAR = 768 * 1024, BAR_BYTES = 16384;
constexpr int LDS_BARST = 147392;
constexpr size_t WS_PRM = 800 * 1024;
constexpr size_t WS_W = 1 * MiB, W_LAYER = 29 * MiB + MiB / 2;
constexpr size_t OW_IN = 0, OW_OUT = 7 * MiB, OW_XQ = 9 * MiB, OW_XKV = 10 * MiB, OW_XO = 12 * MiB, OW_GU = 13 * MiB, OW_DN = 24 * MiB;
constexpr size_t WS_U = 60 * MiB;
constexpr size_t WS_Y = 172 * MiB;
constexpr size_t WS_QX = 172 * MiB, WS_OX = 188 * MiB;
constexpr size_t WS_HB = 204 * MiB;
constexpr size_t WS_MEMB = 236 * MiB;
constexpr size_t WS_KV = 240 * MiB;
constexpr size_t WS_SSQP = 248 * MiB;
constexpr size_t WS_END = 256 * MiB;
constexpr int LDS_BYTES = 147456;

__device__ __forceinline__ unsigned f2bf(float f) { unsigned u = __builtin_bit_cast(unsigned, f); return (u + 0x7fffu + ((u >> 16) & 1u)) >> 16; }
__device__ __forceinline__ unsigned pk2(float lo, float hi) { return f2bf(lo) | (f2bf(hi) << 16); }
__device__ __forceinline__ float bf2f(unsigned short v) { return __uint_as_float(((unsigned)v) << 16); }
__device__ __forceinline__ float lo_f(unsigned w) { return __uint_as_float(w << 16); }
__device__ __forceinline__ float hi_f(unsigned w) { return __uint_as_float(w & 0xffff0000u); }
__device__ __forceinline__ float log_sigmoid_f(float x) { return fminf(x, 0.f) - __logf(1.0f + __expf(-fabsf(x))); }
__device__ __forceinline__ float sigmoid_f(float x) { return __builtin_amdgcn_rcpf(1.0f + __expf(-x)); }
__device__ __forceinline__ float wave_sum(float v) {
#pragma unroll
    for (int o = 1; o < 64; o <<= 1) v += __shfl_xor(v, o);
    return v;
}

#define XB_TMO      128
#define XB_XCNT(j)  (256  + 64 * (j))
#define XB_XSUB(j)  (1280 + 64 * (j))
#define XB_XGEN(j)  (2304 + 64 * (j))
#define XB_TOP      3328
#define XB_TOPGEN   3392
#define XCD_BAR_WORDS 3456
#define XB_SPIN_CAP (1u << 18)

__device__ __forceinline__ unsigned xb_ld(unsigned* p)              { return __hip_atomic_load(p, __ATOMIC_RELAXED, __HIP_MEMORY_SCOPE_AGENT); }
__device__ __forceinline__ unsigned xb_add(unsigned* p, unsigned v) { return __hip_atomic_fetch_add(p, v, __ATOMIC_RELAXED, __HIP_MEMORY_SCOPE_AGENT); }
__device__ __forceinline__ unsigned xb_xcc_id() { return (unsigned)__builtin_amdgcn_s_getreg((3 << 11) | 20) & 0xFu; }
#define XB_SPIN(cond, bar) do { unsigned _sp = 0; while (cond) { __builtin_amdgcn_s_sleep(1); \
    if ((++_sp & 255u) == 0u) { if (xb_ld(&(bar)[XB_TMO])) break; if (_sp > XB_SPIN_CAP) { atomicAdd(&(bar)[XB_TMO], 1u); break; } } } } while (0)

struct XcdBarrier {
    unsigned* bar; unsigned x;
    volatile LAS unsigned* st;
};

__device__ __forceinline__ XcdBarrier xcd_barrier_post(unsigned* bar, volatile LAS unsigned* st) {
    XcdBarrier b; b.bar = bar; b.x = xb_xcc_id(); b.st = st;
    if (threadIdx.x == 0) (void)xb_add(&bar[XB_XCNT(b.x)], 1u);
    return b;
}
__device__ __forceinline__ void xcd_barrier_complete(unsigned* bar, unsigned x, unsigned& nloc, unsigned& nx) {
    const unsigned G = gridDim.x * gridDim.y * gridDim.z;
    unsigned sum, cnt, mine, sp = 0u;
    for (;;) {
        sum = 0u; cnt = 0u; mine = 0u;
#pragma unroll
        for (unsigned j = 0; j < 16; ++j) { const unsigned c = xb_ld(&bar[XB_XCNT(j)]); sum += c; cnt += (c > 0u) ? 1u : 0u; mine = (j == x) ? c : mine; }
        if (sum == G) break;
        __builtin_amdgcn_s_sleep(1);
        if ((++sp & 255u) == 0u) { if (xb_ld(&bar[XB_TMO])) break; if (sp > XB_SPIN_CAP) { atomicAdd(&bar[XB_TMO], 1u); break; } }
    }
    nloc = mine > 0u ? mine : 1u; nx = cnt > 0u ? cnt : 1u;
}

__device__ __forceinline__ void xcd_barrier(const XcdBarrier& b) {
    asm volatile("s_waitcnt vmcnt(0)" ::: "memory");
    __syncthreads();
    if (threadIdx.x == 0) {
        unsigned* bar = b.bar;
        __builtin_amdgcn_s_waitcnt(0);
        unsigned nloc = b.st[0], nx = b.st[1];
        if (nloc == 0u) { xcd_barrier_complete(bar, b.x, nloc, nx); b.st[0] = nloc; b.st[1] = nx; }
        const unsigned old = xb_add(&bar[XB_XSUB(b.x)], 1u);
        const unsigned gen = old / nloc;
        if (old + 1u == (gen + 1u) * nloc) {
            __builtin_amdgcn_fence(__ATOMIC_RELEASE, "agent");
            asm volatile("s_waitcnt vmcnt(0)" ::: "memory");
            const unsigned og = xb_add(&bar[XB_TOP], 1u);
            const unsigned tg = og / nx;
            if (og + 1u == (tg + 1u) * nx) xb_add(&bar[XB_TOPGEN], 1u);
            else XB_SPIN(xb_ld(&bar[XB_TOPGEN]) == tg, bar);
            __builtin_amdgcn_fence(__ATOMIC_ACQUIRE, "agent");
            xb_add(&bar[XB_XGEN(b.x)], 1u);
            asm volatile("s_waitcnt vmcnt(0)" ::: "memory");
        } else {
            XB_SPIN(xb_ld(&bar[XB_XGEN(b.x)]) == gen, bar);
            __builtin_amdgcn_fence(__ATOMIC_ACQUIRE, "agent");
            asm volatile("s_waitcnt vmcnt(0)" ::: "memory");
        }
    }
    __syncthreads();
}

__device__ __forceinline__ void conv_item(const float* W0, const float* W1, int pitch, int K, int mode, const float* rowscale, bf16* WT, LAS float* scr, int item, int nblk, int lane) {
    const int kb = item / nblk, nb = item % nblk, k0 = 64 * kb, n0 = 32 * nb;
    const int n = n0 + (lane & 31);
    const float* src = nullptr;
    if (mode == 0) src = W0 + n;
    else if (mode == 1) { if (n < 1152) src = W0 + n; else if (n < 3456) src = W0 + n + 6; else if (n < 3462) src = W0 + 1152 + (n - 3456); else if (n < 3474) src = W0 + n; }
    else { const int t = n >> 8, j = n & 255; src = (j < 128) ? (W0 + 128 * t + j) : (W1 + 128 * t + (j - 128)); }
#pragma unroll
    for (int i = 0; i < 32; ++i) { const int kk = 2 * i + (lane >> 5); float v = src ? src[(size_t)(k0 + kk) * pitch] : 0.f; if (rowscale) v *= rowscale[k0 + kk]; scr[kk * 33 + (lane & 31)] = v; }
    asm volatile("s_waitcnt lgkmcnt(0)" ::: "memory");
    const int c = lane & 7;
#pragma unroll
    for (int j = 0; j < 4; ++j) { const int nn = (lane >> 3) + 8 * j; const LAS float* s = scr + (8 * c) * 33 + nn;
        v4u o; o.x = pk2(s[0 * 33], s[1 * 33]); o.y = pk2(s[2 * 33], s[3 * 33]); o.z = pk2(s[4 * 33], s[5 * 33]); o.w = pk2(s[6 * 33], s[7 * 33]);
        *(v4u*)(WT + (size_t)(n0 + nn) * K + k0 + 8 * c) = o; }
    asm volatile("s_waitcnt lgkmcnt(0)" ::: "memory");
}
__device__ __forceinline__ void conv_block_item(const float* W0, const float* W1, int pitch, int K, int mode, const float* rowscale, bf16* WT, LAS float* tile, int kb, int nb, int tid) {
    const int k0 = 64 * kb, n0 = 256 * nb, c4 = (tid & 63) * 4;
#pragma unroll
    for (int i = 0; i < 8; ++i) { const int row = 8 * i + (tid >> 6); f32x4 v = {0.f, 0.f, 0.f, 0.f};
        const float* rp = W0 + (size_t)(k0 + row) * pitch;
        if (mode == 0) v = *(const f32x4*)(rp + n0 + c4);
        else if (mode == 2) { const float* rq = (c4 < 128 ? rp : W1 + (size_t)(k0 + row) * pitch) + 128 * nb + (c4 & 127); v = *(const f32x4*)rq; }
        else {
#pragma unroll
            for (int j = 0; j < 4; ++j) { const int n = n0 + c4 + j; int sc = -1;
                if (n < 1152) sc = n; else if (n < 3456) sc = n + 6; else if (n < 3462) sc = 1152 + (n - 3456); else if (n < 3474) sc = n;
                v[j] = sc >= 0 ? rp[sc] : 0.f; } }
        if (rowscale) v = v * rowscale[k0 + row];
        LAS float* d = tile + row * 257 + c4; d[0] = v[0]; d[1] = v[1]; d[2] = v[2]; d[3] = v[3]; }
    __syncthreads();
    const int q = tid & 7;
#pragma unroll
    for (int pass = 0; pass < 4; ++pass) { const int nl = (tid >> 3) + 64 * pass; const LAS float* sp = tile + (8 * q) * 257 + nl;
        v4u o; o.x = pk2(sp[0], sp[257]); o.y = pk2(sp[2 * 257], sp[3 * 257]); o.z = pk2(sp[4 * 257], sp[5 * 257]); o.w = pk2(sp[6 * 257], sp[7 * 257]);
        *(v4u*)(WT + (size_t)(n0 + nl) * K + k0 + 8 * q) = o; }
    __syncthreads();
}
__device__ __forceinline__ void row_to_bf16_ssq(const float* xrow, bf16* orow, float* ssq_out, int lane) {
    const f32x4* xr = (const f32x4*)xrow + lane; f32x4 v[4]; float s2 = 0.f;
#pragma unroll
    for (int j = 0; j < 4; ++j) { v[j] = xr[64 * j]; s2 += (v[j].x * v[j].x + v[j].y * v[j].y) + (v[j].z * v[j].z + v[j].w * v[j].w); }
    s2 = wave_sum(s2);
    unsigned long long* o8 = (unsigned long long*)orow + lane;
#pragma unroll
    for (int j = 0; j < 4; ++j) o8[64 * j] = (unsigned long long)pk2(v[j].x, v[j].y) | ((unsigned long long)pk2(v[j].z, v[j].w) << 32);
    if (lane < 16) ssq_out[lane] = lane == 0 ? s2 : 0.f;
}

typedef short s16x8 __attribute__((ext_vector_type(8)));
typedef short s16x4 __attribute__((ext_vector_type(4)));
typedef float f32x16 __attribute__((ext_vector_type(16)));
__device__ __forceinline__ s16x4 tr_read(LAS const unsigned char* p) { return __builtin_bit_cast(s16x4, __builtin_amdgcn_ds_read_tr16_b64_v4i16((LAS s16x4*)p)); }
__device__ __forceinline__ s16x8 cat8(s16x4 a, s16x4 b) { return (s16x8){a[0], a[1], a[2], a[3], b[0], b[1], b[2], b[3]}; }
__device__ __forceinline__ unsigned cvtpk(float lo, float hi) { return pg8::cvt_pk_bf16(lo, hi); }
__device__ __forceinline__ s16x8 pack8(float a0, float a1, float a2, float a3, float a4, float a5, float a6, float a7) {
    v4u w; w.x = cvtpk(a0, a1); w.y = cvtpk(a2, a3); w.z = cvtpk(a4, a5); w.w = cvtpk(a6, a7); return __builtin_bit_cast(s16x8, w); }
#define MFMA32(a, b, c) __builtin_amdgcn_mfma_f32_32x32x16_bf16(a, b, c, 0, 0, 0)
__device__ __forceinline__ float xh_sum(float x) { auto rr = __builtin_amdgcn_permlane32_swap(__float_as_uint(x), __float_as_uint(x), false, false); return __uint_as_float(rr[0]) + __uint_as_float(rr[1]); }
__device__ __forceinline__ float xh_max(float x) { auto rr = __builtin_amdgcn_permlane32_swap(__float_as_uint(x), __float_as_uint(x), false, false); return fmaxf(__uint_as_float(rr[0]), __uint_as_float(rr[1])); }
__device__ __forceinline__ float xh_prod(float x) { auto rr = __builtin_amdgcn_permlane32_swap(__float_as_uint(x), __float_as_uint(x), false, false); return __uint_as_float(rr[0]) * __uint_as_float(rr[1]); }
__device__ __forceinline__ float xh_other(float x) { auto rr = __builtin_amdgcn_permlane32_swap(__float_as_uint(x), __float_as_uint(x), false, false); return __uint_as_float(rr[0] == __float_as_uint(x) ? rr[1] : rr[0]); }
__device__ __forceinline__ void st_wt64(float* p, float a, float b) { __hip_atomic_store((unsigned long long*)p, ((unsigned long long)__float_as_uint(b) << 32) | (unsigned long long)__float_as_uint(a), __ATOMIC_RELAXED, __HIP_MEMORY_SCOPE_AGENT); }
__device__ __forceinline__ void st_wt32(float* p, float a) { __hip_atomic_store((unsigned*)p, __float_as_uint(a), __ATOMIC_RELAXED, __HIP_MEMORY_SCOPE_AGENT); }
__device__ __forceinline__ void fox_cumsum_item(const bf16* u, const float* foxb, float* cl, float* tot, int item, int lane) {
    const int bhf = item >> 3, seg = item & 7, b = bhf / 6, h = bhf % 6;
    const float fb = foxb[h];
    const bf16* p = u + ((size_t)b * S + seg * 256 + 4 * lane) * NU + 3456 + h;
    const float L2E = 1.4426950408889634f;
    float l0 = L2E * log_sigmoid_f(bf2f(p[0]) + fb), l1 = L2E * log_sigmoid_f(bf2f(p[NU]) + fb), l2 = L2E * log_sigmoid_f(bf2f(p[2 * NU]) + fb), l3 = L2E * log_sigmoid_f(bf2f(p[3 * NU]) + fb);
    l1 += l0; l2 += l1; l3 += l2;
    float inc = l3;
#pragma unroll
    for (int o = 1; o < 64; o <<= 1) { const float v = __shfl_up(inc, o, 64); if (lane >= o) inc += v; }
    const float ex = inc - l3;
    { float* d = cl + (size_t)bhf * S + seg * 256 + 4 * lane; st_wt64(d, ex + l0, ex + l1); st_wt64(d + 2, ex + l2, ex + l3); }
    if (lane == 63) st_wt32(tot + bhf * 8 + seg, inc);
}
constexpr int PV64 = 144;
__device__ __forceinline__ void attn_mfma_item(const bf16* u, bf16* y, const float* cl, const float* tot, LAS unsigned char* wl, int item, int lane) {
    const int bh = item % 80, qb = 63 - item / 80;
    const bool fox = bh < 48;
    int b, h, qoff, koff, voff, yoff;
    if (fox) { b = bh / 6; h = bh % 6; qoff = h * 64; koff = 384 + h * 64; voff = 768 + h * 64; yoff = h * 64; }
    else { const int rr = bh - 48; b = rr / 4; h = rr % 4; qoff = 1152 + h * 64; koff = 1408 + h * 64; voff = 1664 + h * 64; yoff = 384 + h * 64; }
    const int r = lane & 31, hi = lane >> 5;
    const char* ubc = (const char*)(u + (size_t)b * S * NU);
    const int t = qb * 32 + r;
    const float* clh = cl + (size_t)(fox ? bh : 0) * S;
    s16x8 Qf[4];
    { const unsigned qo = (unsigned)(t * NU + qoff + 8 * hi) * 2u;
#pragma unroll
      for (int d0 = 0; d0 < 4; ++d0) Qf[d0] = *(const s16x8*)(ubc + qo + 32 * d0);
      if (!fox) {
          const float qs = -0.125f * 1.4426950408889634f;
#pragma unroll
          for (int d0 = 0; d0 < 4; ++d0) { const v4u w = __builtin_bit_cast(v4u, Qf[d0]);
              Qf[d0] = pack8(lo_f(w.x) * qs, hi_f(w.x) * qs, lo_f(w.y) * qs, hi_f(w.y) * qs, lo_f(w.z) * qs, hi_f(w.z) * qs, lo_f(w.w) * qs, hi_f(w.w) * qs); } } }
    f32x16 O0, O1;
#pragma unroll
    for (int i = 0; i < 16; ++i) { O0[i] = 0.f; O1[i] = 0.f; }
    float mrun = -1e30f, lsum = 0.f, Rsb = 1.f, Doff = 0.f;
    const float clt = fox ? clh[t] : 0.f;
    LAS float* gl = (LAS float*)(wl + 4608);
    const int trbase = (4 * hi + ((lane >> 2) & 3)) * PV64 + (16 * ((lane >> 4) & 1) + 4 * (lane & 3)) * 2;
    const unsigned lane_off = (unsigned)((lane >> 3) * NU + 8 * (lane & 7)) * 2u;
    v4u kn[4], vn[4]; float gn = 0.f;
    { const char* tb = ubc + (size_t)(qb * 32) * NU * 2;
#pragma unroll
      for (int i = 0; i < 4; ++i) { kn[i] = *(const v4u*)(tb + (size_t)(8 * i * NU + koff) * 2 + lane_off); vn[i] = *(const v4u*)(tb + (size_t)(8 * i * NU + voff) * 2 + lane_off); }
      if (fox) gn = clh[qb * 32 + r]; }
    LAS unsigned char* kl = wl + 4736;
    const int kfoff = r * PV64 + 16 * hi;
    const float SC2 = 0.125f * 1.4426950408889634f;
    { LAS unsigned char* z = wl + 9344 + (lane >> 3) * PV64 + 16 * (lane & 7);
#pragma unroll
      for (int i = 0; i < 4; ++i) *(LAS v4u*)(z + 8 * i * PV64) = (v4u){0u, 0u, 0u, 0u}; }
    s16x8 Pp0 = {0, 0, 0, 0, 0, 0, 0, 0}, Pp1 = {0, 0, 0, 0, 0, 0, 0, 0};
    for (int jt = qb; jt >= 0; --jt) {
        const bool diag = (jt == qb);
        const int vcur = ((qb - jt) & 1) ? 9344 : 0, vprev = 9344 - vcur;
        { LAS unsigned char* dk = kl + (lane >> 3) * PV64 + 16 * (lane & 7); LAS unsigned char* dv = wl + vcur + (lane >> 3) * PV64 + 16 * (lane & 7);
#pragma unroll
          for (int i = 0; i < 4; ++i) { *(LAS v4u*)(dk + 8 * i * PV64) = kn[i]; *(LAS v4u*)(dv + 8 * i * PV64) = vn[i]; } }
        if (fox) gl[r] = -gn;
        if (jt > 0) { const char* tb = ubc + (size_t)((jt - 1) * 32) * NU * 2;
#pragma unroll
          for (int i = 0; i < 4; ++i) { kn[i] = *(const v4u*)(tb + (size_t)(8 * i * NU + koff) * 2 + lane_off); vn[i] = *(const v4u*)(tb + (size_t)(8 * i * NU + voff) * 2 + lane_off); }
          if (fox) gn = clh[(jt - 1) * 32 + r]; }
        s16x8 Kf[4];
#pragma unroll
        for (int d0 = 0; d0 < 4; ++d0) Kf[d0] = *(LAS const s16x8*)(kl + kfoff + 32 * d0);
        LAS const unsigned char* vb = wl + vprev + trbase;
        const s16x8 V00 = cat8(tr_read(vb), tr_read(vb + 8 * PV64)), V01 = cat8(tr_read(vb + 16 * PV64), tr_read(vb + 24 * PV64));
        const s16x8 V10 = cat8(tr_read(vb + 64), tr_read(vb + 8 * PV64 + 64)), V11 = cat8(tr_read(vb + 16 * PV64 + 64), tr_read(vb + 24 * PV64 + 64));
        f32x16 Sx;
#pragma unroll
        for (int i = 0; i < 16; ++i) Sx[i] = 0.f;
        Sx = MFMA32(Kf[0], Qf[0], Sx); O0 = MFMA32(V00, Pp0, O0);
        Sx = MFMA32(Kf[1], Qf[1], Sx); O1 = MFMA32(V10, Pp0, O1);
        Sx = MFMA32(Kf[2], Qf[2], Sx); O0 = MFMA32(V01, Pp1, O0);
        Sx = MFMA32(Kf[3], Qf[3], Sx); O1 = MFMA32(V11, Pp1, O1);
        float P[16];
        if (fox) {
            const float off = clt + Doff;
            float tmax = -1e30f;
#pragma unroll
            for (int g = 0; g < 4; ++g) { const f32x4 ncs = *(LAS const f32x4*)(gl + 8 * g + 4 * hi);
#pragma unroll
                for (int e = 0; e < 4; ++e) P[4 * g + e] = fmaf(SC2, Sx[4 * g + e], ncs[e]); }
            if (diag) {
#pragma unroll
                for (int i = 0; i < 16; ++i) { const int sl = 8 * (i >> 2) + 4 * hi + (i & 3); if (sl > r) P[i] = -1e30f; } }
#pragma unroll
            for (int i = 0; i < 16; ++i) tmax = fmaxf(tmax, P[i]);
            tmax = xh_max(tmax) + off;
            if (__any(tmax > mrun)) {
                const float mnew = fmaxf(mrun, tmax), alpha = __builtin_amdgcn_exp2f(mrun - mnew); lsum *= alpha; mrun = mnew;
#pragma unroll
                for (int i = 0; i < 16; ++i) { O0[i] *= alpha; O1[i] *= alpha; } }
            const float msh = mrun - off; float ps = 0.f;
#pragma unroll
            for (int i = 0; i < 16; ++i) { P[i] = __builtin_amdgcn_exp2f(P[i] - msh); ps += P[i]; }
            lsum += ps;
            if (jt > 0 && ((jt - 1) >> 3) != (jt >> 3)) Doff += tot[bh * 8 + ((jt - 1) >> 3)];
        } else {
            float kp[16], gs[4], go[4]; float T = 1.f;
#pragma unroll
            for (int i = 0; i < 16; ++i) { const float ee = __builtin_amdgcn_exp2f(Sx[i]); const float sig = __builtin_amdgcn_rcpf(1.0f + ee); P[i] = sig; kp[i] = 1.0f - sig; }
            if (diag) {
#pragma unroll
                for (int i = 0; i < 16; ++i) { const int sl = 8 * (i >> 2) + 4 * hi + (i & 3); if (sl >= r) { P[i] = 0.f; kp[i] = 1.f; } } }
#pragma unroll
            for (int g = 0; g < 4; ++g) { gs[g] = (kp[4 * g] * kp[4 * g + 1]) * (kp[4 * g + 2] * kp[4 * g + 3]); T *= gs[g]; }
#pragma unroll
            for (int g = 0; g < 4; ++g) go[g] = xh_other(gs[g]);
            float above = Rsb;
#pragma unroll
            for (int g = 3; g >= 0; --g) {
                float suf = hi == 0 ? above * go[g] : above;
#pragma unroll
                for (int e = 3; e >= 0; --e) { const float a = P[4 * g + e] * suf; suf *= kp[4 * g + e]; P[4 * g + e] = a; }
                above *= gs[g] * go[g];
            }
            Rsb *= xh_prod(T);
        }
        Pp0 = pack8(P[0], P[1], P[2], P[3], P[4], P[5], P[6], P[7]); Pp1 = pack8(P[8], P[9], P[10], P[11], P[12], P[13], P[14], P[15]);
    }
    { LAS const unsigned char* vb = wl + ((qb & 1) ? 9344 : 0) + trbase;
      const s16x8 V00 = cat8(tr_read(vb), tr_read(vb + 8 * PV64)), V01 = cat8(tr_read(vb + 16 * PV64), tr_read(vb + 24 * PV64));
      const s16x8 V10 = cat8(tr_read(vb + 64), tr_read(vb + 8 * PV64 + 64)), V11 = cat8(tr_read(vb + 16 * PV64 + 64), tr_read(vb + 24 * PV64 + 64));
      O0 = MFMA32(V00, Pp0, O0); O1 = MFMA32(V10, Pp0, O1); O0 = MFMA32(V01, Pp1, O0); O1 = MFMA32(V11, Pp1, O1); }
    float inv = 1.0f;
    if (fox) { lsum = xh_sum(lsum); inv = __builtin_amdgcn_rcpf(lsum); }
    char* yb0 = (char*)(y + (size_t)b * S * D); const unsigned yo = (unsigned)(t * D + yoff + 4 * hi) * 2u;
#pragma unroll
    for (int g = 0; g < 4; ++g) {
        unsigned long long w0 = (unsigned long long)cvtpk(O0[4 * g] * inv, O0[4 * g + 1] * inv) | ((unsigned long long)cvtpk(O0[4 * g + 2] * inv, O0[4 * g + 3] * inv) << 32);
        unsigned long long w1 = (unsigned long long)cvtpk(O1[4 * g] * inv, O1[4 * g + 1] * inv) | ((unsigned long long)cvtpk(O1[4 * g + 2] * inv, O1[4 * g + 3] * inv) << 32);
        *(unsigned long long*)(yb0 + yo + 16 * g) = w0; *(unsigned long long*)(yb0 + yo + 64 + 16 * g) = w1; }
}
constexpr int PV128 = 272;
__device__ __forceinline__ void xattn_mfma_item(const bf16* qx, const bf16* kv, bf16* ox, LAS unsigned char* wl, int item, int lane) {
    const int head = item & 3, qblk = item >> 2;
    const int r = lane & 31, hi = lane >> 5;
    const int token = qblk * 32 + r, b = (qblk * 32) / S;
    s16x8 Qf[8];
    { const char* qb_ = (const char*)qx; const unsigned qo = (unsigned)(token * DX + head * 128 + 8 * hi) * 2u;
#pragma unroll
      for (int d0 = 0; d0 < 8; ++d0) Qf[d0] = *(const s16x8*)(qb_ + qo + 32 * d0); }
    f32x16 O[4];
#pragma unroll
    for (int k = 0; k < 4; ++k)
#pragma unroll
        for (int i = 0; i < 16; ++i) O[k][i] = 0.f;
    float mrun = -1e30f, lsum = 0.f;
    const int trbase = (4 * hi + ((lane >> 2) & 3)) * PV128 + (16 * ((lane >> 4) & 1) + 4 * (lane & 3)) * 2;
    const char* kvc = (const char*)(kv + (size_t)b * MEML * 1024);
    const unsigned kfo = (unsigned)(r * 1024 + head * 128 + 8 * hi) * 2u;
    const unsigned vlo = (unsigned)((lane >> 4) * 1024 + 512 + head * 128 + 8 * (lane & 15)) * 2u;
    s16x8 Kn[8]; v4u vn[8];
#pragma unroll
    for (int d0 = 0; d0 < 8; ++d0) Kn[d0] = *(const s16x8*)(kvc + kfo + 32 * d0);
#pragma unroll
    for (int i = 0; i < 8; ++i) vn[i] = *(const v4u*)(kvc + vlo + (size_t)(4 * i) * 2048);
    const float SCX = 0.08838834764831845f * 1.4426950408889634f;
    for (int jt = 0; jt < 8; ++jt) {
        f32x16 Sx;
#pragma unroll
        for (int i = 0; i < 16; ++i) Sx[i] = 0.f;
#pragma unroll
        for (int d0 = 0; d0 < 8; ++d0) Sx = MFMA32(Kn[d0], Qf[d0], Sx);
        { LAS unsigned char* dst = wl + (lane >> 4) * PV128 + 16 * (lane & 15);
#pragma unroll
          for (int i = 0; i < 8; ++i) *(LAS v4u*)(dst + 4 * i * PV128) = vn[i]; }
        if (jt < 7) { const char* tb = kvc + (size_t)((jt + 1) * 32) * 2048;
#pragma unroll
            for (int d0 = 0; d0 < 8; ++d0) Kn[d0] = *(const s16x8*)(tb + kfo + 32 * d0);
#pragma unroll
            for (int i = 0; i < 8; ++i) vn[i] = *(const v4u*)(tb + vlo + (size_t)(4 * i) * 2048); }
        float P[16]; float tmax = -1e30f;
#pragma unroll
        for (int i = 0; i < 16; ++i) { P[i] = Sx[i] * SCX; tmax = fmaxf(tmax, P[i]); }
        tmax = xh_max(tmax);
        if (__any(tmax > mrun)) { const float mnew = fmaxf(mrun, tmax), alpha = __builtin_amdgcn_exp2f(mrun - mnew); lsum *= alpha; mrun = mnew;
#pragma unroll
            for (int k = 0; k < 4; ++k)
#pragma unroll
                for (int i = 0; i < 16; ++i) O[k][i] *= alpha; }
        float ps = 0.f;
#pragma unroll
        for (int i = 0; i < 16; ++i) { P[i] = __builtin_amdgcn_exp2f(P[i] - mrun); ps += P[i]; }
        lsum += ps;
        const s16x8 Pf0 = pack8(P[0], P[1], P[2], P[3], P[4], P[5], P[6], P[7]), Pf1 = pack8(P[8], P[9], P[10], P[11], P[12], P[13], P[14], P[15]);
        LAS const unsigned char* vb = wl + trbase;
#pragma unroll
        for (int k = 0; k < 4; ++k) {
            const s16x8 Va = cat8(tr_read(vb + 64 * k), tr_read(vb + 8 * PV128 + 64 * k)), Vb = cat8(tr_read(vb + 16 * PV128 + 64 * k), tr_read(vb + 24 * PV128 + 64 * k));
            O[k] = MFMA32(Va, Pf0, O[k]); O[k] = MFMA32(Vb, Pf1, O[k]); }
    }
    lsum = xh_sum(lsum); const float inv = __builtin_amdgcn_rcpf(lsum);
    char* oc = (char*)ox; const unsigned oo = (unsigned)(token * DX + head * 128 + 4 * hi) * 2u;
#pragma unroll
    for (int k = 0; k < 4; ++k)
#pragma unroll
        for (int g = 0; g < 4; ++g) {
            const unsigned long long w0 = (unsigned long long)cvtpk(O[k][4 * g] * inv, O[k][4 * g + 1] * inv) | ((unsigned long long)cvtpk(O[k][4 * g + 2] * inv, O[k][4 * g + 3] * inv) << 32);
            *(unsigned long long*)(oc + oo + 64 * k + 16 * g) = w0; }
}

constexpr int ML_WSTRIDE = 18432, ML_RAWK = 0, ML_RAWQ = 5056, ML_WK = 5056, ML_V = 10112, ML_CW = 14720, ML_EB = 16768, ML_NL = 16896, ML_NW = 17152, ML_ITEM_F = 4224;
template <bool OUT>
__device__ __forceinline__ void mlstm_item(const bf16* u, bf16* y, float* scratch, const float* convw, const float* ib, const float* fbias, const float* normw, LAS unsigned char* wl, int bh, int c, int lane) {
    const int b = bh / 6, h = bh % 6, r = lane & 31, hi = lane >> 5;
    const bf16* ub = u + (size_t)b * S * NU;
    LAS float* cw = (LAS float*)(wl + ML_CW); LAS float* eb = (LAS float*)(wl + ML_EB); LAS float* nl = (LAS float*)(wl + ML_NL); LAS float* nwl = (LAS float*)(wl + ML_NW);
    for (int i = lane; i < 512; i += 64) { const int tap = i >> 7, ch = i & 127; cw[i] = convw[tap * 768 + (ch < 64 ? (64 * h + ch) : (384 + 64 * h + (ch - 64)))]; }
    if (OUT) nwl[lane] = normw[h * 64 + lane];
    const float ibh = ib[h], fbh = fbias[h];
    f32x16 X[2][2];
#pragma unroll
    for (int a = 0; a < 2; ++a)
#pragma unroll
        for (int bb = 0; bb < 2; ++bb)
#pragma unroll
            for (int i = 0; i < 16; ++i) X[a][bb][i] = 0.f;
    float nk = 0.f, Gsum = 0.f;
    if (OUT) {
        float dec = 1.f;
        for (int cp = c - 1; cp >= 0; --cp) {
            const float* s0 = scratch + (size_t)(bh * 16 + cp) * ML_ITEM_F;
            f32x16 v0[4];
#pragma unroll
            for (int blk = 0; blk < 4; ++blk) v0[blk] = *(const f32x16*)(s0 + blk * 1024 + lane * 16);
            const float n0 = s0[4096 + lane], g0 = s0[4160];
#pragma unroll
            for (int blk = 0; blk < 4; ++blk) X[blk >> 1][blk & 1] += v0[blk] * dec;
            nk += dec * n0;
            dec *= __expf(g0);
        }
    }
    nl[lane] = nk;
    const int trP = (4 * hi + ((lane >> 2) & 3)) * 144 + (16 * ((lane >> 4) & 1) + 4 * (lane & 3)) * 2;
    const int trN = (8 * hi + ((lane >> 2) & 3)) * 144 + (16 * ((lane >> 4) & 1) + 4 * (lane & 3)) * 2;
    for (int j = 0; j < 4; ++j) {
        const int t0 = c * 128 + j * 32, t = t0 + r;
        const bf16* trow = ub + (size_t)t * NU;
        const unsigned short gfr = trow[3468 + h], gir = trow[3462 + h];
        v4u vv[4], rk[5], rq[5];
        { const bf16* vrow = ub + (size_t)(t0 + (lane >> 3)) * NU + 2688 + 64 * h + 8 * (lane & 7);
#pragma unroll
          for (int i = 0; i < 4; ++i) vv[i] = *(const v4u*)(vrow + (size_t)(8 * i) * NU); }
#pragma unroll
        for (int i = 0; i < 5; ++i) { const int p = lane + 64 * i, row = p >> 3, ch8 = p & 7, tt = t0 - 3 + row; const bool ok = (p < 280) && (tt >= 0);
            const bf16* src = ub + (size_t)(ok ? tt : 0) * NU + 1920 + 64 * h + 8 * ch8;
            rk[i] = ok ? *(const v4u*)(src + 384) : (v4u){0u, 0u, 0u, 0u};
            if (OUT) rq[i] = ok ? *(const v4u*)(src) : (v4u){0u, 0u, 0u, 0u}; }
#pragma unroll
        for (int i = 0; i < 5; ++i) { const int p = lane + 64 * i, row = p >> 3, ch8 = p & 7;
            if (p < 280) { *(LAS v4u*)(wl + ML_RAWK + row * 144 + 16 * ch8) = rk[i]; if (OUT) *(LAS v4u*)(wl + ML_RAWQ + row * 144 + 16 * ch8) = rq[i]; } }
        { LAS unsigned char* dst = wl + ML_V + (lane >> 3) * 144 + 16 * (lane & 7);
#pragma unroll
          for (int i = 0; i < 4; ++i) *(LAS v4u*)(dst + 8 * i * 144) = vv[i]; }
        float bl = log_sigmoid_f(bf2f(gfr) + fbh); const float ii = bf2f(gir) + ibh;
#pragma unroll
        for (int o = 1; o < 32; o <<= 1) { const float v = __shfl_up(bl, o, 32); if (r >= o) bl += v; }
        const float g = __shfl(bl, 31, 32), es = ii - bl;
        eb[r] = es; Gsum += g;
        s16x8 Kf[4], Qf[4]; float dq = 0.f;
#pragma unroll
        for (int part = (OUT ? 0 : 1); part < 2; ++part) {
            LAS const unsigned char* raw = wl + (part ? ML_RAWK : ML_RAWQ);
#pragma unroll
            for (int f = 0; f < 4; ++f) { float vals[8];
#pragma unroll
                for (int e = 0; e < 2; ++e) { const int ch = 16 * f + 8 * e + 4 * hi; float a0 = 0.f, a1 = 0.f, a2 = 0.f, a3 = 0.f;
#pragma unroll
                    for (int tap = 0; tap < 4; ++tap) { const unsigned long long xw = *(LAS const unsigned long long*)(raw + (r + tap) * 144 + ch * 2);
                        const f32x4 w = *(LAS const f32x4*)(cw + tap * 128 + part * 64 + ch); const unsigned x0 = (unsigned)xw, x1 = (unsigned)(xw >> 32);
                        a0 += w[0] * lo_f(x0); a1 += w[1] * hi_f(x0); a2 += w[2] * lo_f(x1); a3 += w[3] * hi_f(x1); }
                    const float sc = part ? 0.125f : 1.0f;
                    vals[4 * e + 0] = a0 * sc * __builtin_amdgcn_rcpf(1.0f + __expf(-a0)); vals[4 * e + 1] = a1 * sc * __builtin_amdgcn_rcpf(1.0f + __expf(-a1));
                    vals[4 * e + 2] = a2 * sc * __builtin_amdgcn_rcpf(1.0f + __expf(-a2)); vals[4 * e + 3] = a3 * sc * __builtin_amdgcn_rcpf(1.0f + __expf(-a3));
                    if (OUT && part == 0) { const f32x4 n4 = *(LAS const f32x4*)(nl + ch); dq += vals[4 * e] * n4[0] + vals[4 * e + 1] * n4[1] + vals[4 * e + 2] * n4[2] + vals[4 * e + 3] * n4[3]; } }
                const s16x8 fr = pack8(vals[0], vals[1], vals[2], vals[3], vals[4], vals[5], vals[6], vals[7]);
                if (part) Kf[f] = fr; else Qf[f] = fr; }
        }
        if (OUT) {
            f32x16 Sx;
#pragma unroll
            for (int i = 0; i < 16; ++i) Sx[i] = 0.f;
#pragma unroll
            for (int f = 0; f < 4; ++f) Sx = MFMA32(Kf[f], Qf[f], Sx);
            float P[16]; float den = 0.f;
#pragma unroll
            for (int g4 = 0; g4 < 4; ++g4) { const f32x4 e4 = *(LAS const f32x4*)(eb + 8 * g4 + 4 * hi);
#pragma unroll
                for (int e = 0; e < 4; ++e) { const int sl = 8 * g4 + 4 * hi + e; const float d = (sl <= r) ? __expf(bl + e4[e]) : 0.f; P[4 * g4 + e] = Sx[4 * g4 + e] * d; den += P[4 * g4 + e]; } }
            den = xh_sum(den); dq = xh_sum(dq);
            const float ebt = __expf(bl);
            const float inv = 1.0f / fmaxf(fabsf(den + ebt * dq), 1.0f);
            const s16x8 Pf0 = pack8(P[0], P[1], P[2], P[3], P[4], P[5], P[6], P[7]), Pf1 = pack8(P[8], P[9], P[10], P[11], P[12], P[13], P[14], P[15]);
            unsigned long long ow[8];
#pragma unroll
            for (int vb = 0; vb < 2; ++vb)
#pragma unroll
                for (int g4 = 0; g4 < 4; ++g4) ow[4 * vb + g4] = *(const unsigned long long*)(trow + 3072 + 64 * h + 32 * vb + 8 * g4 + 4 * hi);
            f32x16 H[2]; float ms = 0.f;
#pragma unroll
            for (int vb = 0; vb < 2; ++vb) {
                LAS const unsigned char* vp = wl + ML_V + trP + 64 * vb;
                f32x16 Zi, Zx;
#pragma unroll
                for (int i = 0; i < 16; ++i) { Zi[i] = 0.f; Zx[i] = 0.f; }
                Zi = MFMA32(cat8(tr_read(vp), tr_read(vp + 8 * 144)), Pf0, Zi); Zi = MFMA32(cat8(tr_read(vp + 16 * 144), tr_read(vp + 24 * 144)), Pf1, Zi);
#pragma unroll
                for (int kb = 0; kb < 2; ++kb)
#pragma unroll
                    for (int sp = 0; sp < 2; ++sp) { const f32x16& xx = X[kb][vb];
                        const s16x8 xa = pack8(xx[8 * sp], xx[8 * sp + 1], xx[8 * sp + 2], xx[8 * sp + 3], xx[8 * sp + 4], xx[8 * sp + 5], xx[8 * sp + 6], xx[8 * sp + 7]);
                        Zx = MFMA32(xa, Qf[2 * kb + sp], Zx); }
#pragma unroll
                for (int i = 0; i < 16; ++i) { const float hv = (Zi[i] + ebt * Zx[i]) * inv; H[vb][i] = hv; ms += hv * hv; }
            }
            ms = xh_sum(ms);
            const float rs = rsqrtf(ms * (1.0f / 64.0f) + 1e-6f);
            bf16* yrow = y + ((size_t)b * S + t) * D + 640 + 64 * h;
#pragma unroll
            for (int vb = 0; vb < 2; ++vb)
#pragma unroll
                for (int g4 = 0; g4 < 4; ++g4) { const int v = 32 * vb + 8 * g4 + 4 * hi;
                    const unsigned o0 = (unsigned)ow[4 * vb + g4], o1 = (unsigned)(ow[4 * vb + g4] >> 32);
                    const f32x4 w4 = *(LAS const f32x4*)(nwl + v);
                    const float y0 = H[vb][4 * g4] * rs * w4[0] * sigmoid_f(lo_f(o0)), y1 = H[vb][4 * g4 + 1] * rs * w4[1] * sigmoid_f(hi_f(o0));
                    const float y2 = H[vb][4 * g4 + 2] * rs * w4[2] * sigmoid_f(lo_f(o1)), y3 = H[vb][4 * g4 + 3] * rs * w4[3] * sigmoid_f(hi_f(o1));
                    *(unsigned long long*)(yrow + v) = (unsigned long long)cvtpk(y0, y1) | ((unsigned long long)cvtpk(y2, y3) << 32); }
        }
        { const float wsc = __expf(g + es), eg = __expf(g);
#pragma unroll
          for (int f = 0; f < 4; ++f) { const v4u kw = __builtin_bit_cast(v4u, Kf[f]);
#pragma unroll
              for (int e = 0; e < 2; ++e) { const unsigned k0 = e ? kw.z : kw.x, k1 = e ? kw.w : kw.y; const int ch = 16 * f + 8 * e + 4 * hi;
                  *(LAS unsigned long long*)(wl + ML_WK + r * 144 + ch * 2) = (unsigned long long)cvtpk(lo_f(k0) * wsc, hi_f(k0) * wsc) | ((unsigned long long)cvtpk(lo_f(k1) * wsc, hi_f(k1) * wsc) << 32); } }
#pragma unroll
          for (int kb = 0; kb < 2; ++kb)
#pragma unroll
              for (int vb = 0; vb < 2; ++vb) { X[kb][vb] *= eg;
#pragma unroll
                  for (int sp = 0; sp < 2; ++sp) { LAS const unsigned char* kp = wl + ML_WK + trN + 16 * sp * 144 + 64 * kb; LAS const unsigned char* vp = wl + ML_V + trN + 16 * sp * 144 + 64 * vb;
                      X[kb][vb] = MFMA32(cat8(tr_read(kp), tr_read(kp + 4 * 144)), cat8(tr_read(vp), tr_read(vp + 4 * 144)), X[kb][vb]); } }
          float dn = 0.f;
#pragma unroll 8
          for (int s2 = 0; s2 < 32; ++s2) dn += bf2f(*(LAS const unsigned short*)(wl + ML_WK + s2 * 144 + 2 * lane));
          nk = eg * nk + dn; nl[lane] = nk; }
    }
    if (!OUT) {
        float* sp = scratch + (size_t)(bh * 16 + c) * ML_ITEM_F;
#pragma unroll
        for (int blk = 0; blk < 4; ++blk) {
#pragma unroll
            for (int i = 0; i < 8; ++i) st_wt64(sp + blk * 1024 + lane * 16 + 2 * i, X[blk >> 1][blk & 1][2 * i], X[blk >> 1][blk & 1][2 * i + 1]); }
        st_wt32(sp + 4096 + lane, nk);
        if (lane == 0) st_wt32(sp + 4160, Gsum);
    }
}

struct Args { const float* in[20]; float* out; unsigned char* ws; };
#define GEMM_PHASE(EpiT, SchedT, g, Sc, E) pg8::gemm_phase<EpiT, SchedT, true, true>(L, g, Sc, E)

__global__ void __launch_bounds__(512, 2) mega_fwd(Args a) {
    extern __shared__ __attribute__((aligned(16))) unsigned char lds[];
    LAS unsigned char* L = (LAS unsigned char*)lds;
    const int tid = threadIdx.x, lane = tid & 63, wave = __builtin_amdgcn_readfirstlane(tid >> 6);
    const int G = gridDim.x, bx = blockIdx.x;
    const int gw = bx * 8 + wave, NGW = G * 8;
    unsigned char* ws = a.ws;
    const float* x = a.in[0]; const float* mem = a.in[1];
    float* out = a.out;
    float* ssq = (float*)(ws + WS_SSQP); float* ssqm = (float*)(ws + WS_SSQP + 7 * MiB);
    bf16* ub = (bf16*)(ws + WS_U); bf16* actb = (bf16*)(ws + WS_U); bf16* yb = (bf16*)(ws + WS_Y); bf16* qxb = (bf16*)(ws + WS_QX); bf16* oxb = (bf16*)(ws + WS_OX);
    bf16* hb = (bf16*)(ws + WS_HB); bf16* memb = (bf16*)(ws + WS_MEMB); bf16* kvb = (bf16*)(ws + WS_KV);

    volatile LAS unsigned* bst = (volatile LAS unsigned*)(L + LDS_BARST); if (tid < 2) bst[tid] = 0u;
    __syncthreads();
    (void)xcd_barrier_post((unsigned*)(a.ws + WS_BAR), bst);
    {
        LAS float* tile = (LAS float*)L;
        constexpr int I_IN = 16 * 14, I_OUT = 16 * 4, I_XQ = 16 * 2, I_XKV = 16 * 4, I_XO = 8 * 4, I_GU = 16 * 22, I_DN = 44 * 4;
        constexpr int I_LAYER = I_IN + I_OUT + I_XQ + I_XKV + I_XO + I_GU + I_DN;
        for (int it = bx; it < 2 * I_LAYER; it += G) {
            const int l = it / I_LAYER; int r = it % I_LAYER;
            unsigned char* wl = ws + WS_W + (size_t)l * W_LAYER;
            if (r < I_IN) { conv_block_item(a.in[3] + (size_t)l * 1024 * 3474, nullptr, 3474, 1024, 1, a.in[2] + l * 1024, (bf16*)(wl + OW_IN), tile, r / 14, r % 14, tid); continue; } r -= I_IN;
            if (r < I_OUT) { conv_block_item(a.in[9] + (size_t)l * 1024 * 1024, nullptr, 1024, 1024, 0, nullptr, (bf16*)(wl + OW_OUT), tile, r / 4, r % 4, tid); continue; } r -= I_OUT;
            if (r < I_XQ) { conv_block_item(a.in[12] + (size_t)l * 1024 * 512, nullptr, 512, 1024, 0, a.in[10] + l * 1024, (bf16*)(wl + OW_XQ), tile, r / 2, r % 2, tid); continue; } r -= I_XQ;
            if (r < I_XKV) { conv_block_item(a.in[13] + (size_t)l * 1024 * 1024, nullptr, 1024, 1024, 0, a.in[11] + l * 1024, (bf16*)(wl + OW_XKV), tile, r / 4, r % 4, tid); continue; } r -= I_XKV;
            if (r < I_XO) { conv_block_item(a.in[14] + (size_t)l * 512 * 1024, nullptr, 1024, 512, 0, nullptr, (bf16*)(wl + OW_XO), tile, r / 4, r % 4, tid); continue; } r -= I_XO;
            if (r < I_GU) { conv_block_item(a.in[16] + (size_t)l * 1024 * DFF, a.in[17] + (size_t)l * 1024 * DFF, DFF, 1024, 2, a.in[15] + l * 1024, (bf16*)(wl + OW_GU), tile, r / 22, r % 22, tid); continue; } r -= I_GU;
            conv_block_item(a.in[18] + (size_t)l * DFF * 1024, nullptr, 1024, DFF, 0, nullptr, (bf16*)(wl + OW_DN), tile, r / 4, r % 4, tid);
        }
        for (int m = gw; m < M; m += NGW) row_to_bf16_ssq(x + (size_t)m * D, hb + (size_t)m * D, ssq + (size_t)m * 16, lane);
        for (int m = gw; m < MROWS; m += NGW) row_to_bf16_ssq(mem + (size_t)m * D, memb + (size_t)m * D, ssqm + (size_t)m * 16, lane);
        { float* prm = (float*)(ws + WS_PRM);
          for (int i = bx * 512 + tid; i < 2 * 8192 + 1024; i += G * 512) {
              float v = 0.f;
              if (i >= 2 * 8192) v = a.in[19][i - 2 * 8192];
              else { const int l = i >> 13, o = i & 8191;
                  if (o < 6) v = a.in[4][l * 6 + o]; else if (o >= 8 && o < 14) v = a.in[6][l * 6 + o - 8]; else if (o >= 16 && o < 22) v = a.in[7][l * 6 + o - 16];
                  else if (o >= 64 && o < 448) v = a.in[8][l * 384 + o - 64]; else if (o >= 512 && o < 3584) v = a.in[5][l * 3072 + o - 512]; }
              prm[i] = v; } }
    }
#define XBAR() do { XcdBarrier xb_; xb_.bar = (unsigned*)(ws + WS_BAR); xb_.x = xb_xcc_id(); xb_.st = (volatile LAS unsigned*)(L + LDS_BARST); xcd_barrier(xb_); } while (0)
    { unsigned char* ws = a.ws; XBAR(); }
    for (int ph = 0; ph < 16; ++ph) {
        const int l = ph >> 3, k = ph & 7;
        size_t zoff = 0; asm volatile("" : "+s"(zoff)); unsigned char* ws = a.ws + zoff;
        const unsigned char* wl = ws + WS_W + (size_t)l * W_LAYER;
        float* ssq = (float*)(ws + WS_SSQP); float* ssqm = (float*)(ws + WS_SSQP + 7 * MiB);
        bf16* ub = (bf16*)(ws + WS_U); bf16* actb = (bf16*)(ws + WS_U); bf16* yb = (bf16*)(ws + WS_Y); bf16* qxb = (bf16*)(ws + WS_QX); bf16* oxb = (bf16*)(ws + WS_OX);
        bf16* hb = (bf16*)(ws + WS_HB); bf16* memb = (bf16*)(ws + WS_MEMB); bf16* kvb = (bf16*)(ws + WS_KV);
        int tid_p = threadIdx.x; asm volatile("" : "+v"(tid_p)); const int lane = tid_p & 63, wave = __builtin_amdgcn_readfirstlane(tid_p >> 6), gw = bx * 8 + wave;
        if (k == 0 || k == 3) {
            const int j0 = (ph == 0) ? 0 : 2;
            for (int j = j0; j < 3; ++j) {
                pg8::Gemm g; pg8::EpiScaleBf16 E; int off = 0;
                if (j < 2) { g = pg8::Gemm{memb, (const bf16*)(ws + WS_W + (size_t)j * W_LAYER + OW_XKV), MROWS, 1024, 1024}; E = pg8::EpiScaleBf16{kvb + (size_t)j * MROWS * 1024, 1024, ssqm}; off = 128 + 32 * j; }
                else if (k == 0) { g = pg8::Gemm{hb, (const bf16*)(wl + OW_IN), M, NU, 1024}; E = pg8::EpiScaleBf16{ub, NU, ssq + (size_t)(3 * l) * M * 16}; }
                else { g = pg8::Gemm{hb, (const bf16*)(wl + OW_XQ), M, DX, 1024}; E = pg8::EpiScaleBf16{qxb, DX, ssq + (size_t)(3 * l + 1) * M * 16}; }
                pg8::OffsetOrder Sc; Sc.init(g.M, g.N, G, bx, off);
                GEMM_PHASE(pg8::EpiScaleBf16, pg8::OffsetOrder, g, Sc, E);
            }
        } else if (k == 2 || k == 5 || k == 7) {
            pg8::Gemm g; pg8::EpiResid E;
            if (k == 2) { g = pg8::Gemm{yb, (const bf16*)(wl + OW_OUT), M, 1024, 1024}; E = pg8::EpiResid{hb, ssq + (size_t)(3 * l + 1) * M * 16}; }
            else if (k == 5) { g = pg8::Gemm{oxb, (const bf16*)(wl + OW_XO), M, 1024, DX}; E = pg8::EpiResid{hb, ssq + (size_t)(3 * l + 2) * M * 16}; }
            else { g = pg8::Gemm{actb, (const bf16*)(wl + OW_DN), M, 1024, DFF}; E = pg8::EpiResid{hb, ssq + (size_t)(3 * l + 3) * M * 16}; }
            pg8::StaticOrder Sc; Sc.init(g.M, g.N, G, bx);
            GEMM_PHASE(pg8::EpiResid, pg8::StaticOrder, g, Sc, E);
        } else if (k == 6) {
            pg8::Gemm g{hb, (const bf16*)(wl + OW_GU), M, 2 * DFF, 1024}; pg8::StaticOrder Sc; Sc.init(M, 2 * DFF, G, bx);
            pg8::EpiSwiglu E{actb, DFF, ssq + (size_t)(3 * l + 2) * M * 16};
            GEMM_PHASE(pg8::EpiSwiglu, pg8::StaticOrder, g, Sc, E);
        } else if (k == 1) {
            const float* prm = (const float*)(ws + WS_PRM) + l * 8192;
            float* mscr = out;
            float* fcl = out + 14 * MiB / 4; float* ftot = out + 15 * MiB / 4;
            const int xcd0 = (int)(xb_xcc_id() & 7u); unsigned okmask = 0u;
            for (int qi = 0; qi < 8; ++qi) {
            const int xcd = (xcd0 + qi) & 7;
            unsigned* ctr = (unsigned*)(ws + WS_BAR + 14336) + 16 * (l * 8 + xcd); unsigned* done = (unsigned*)(ws + WS_BAR + 15360) + 16 * (l * 8 + xcd);
            for (;;) {
                int it = 0; if (lane == 0) it = (int)atomicAdd(ctr, 1u); it = __builtin_amdgcn_readfirstlane(it);
                if (it >= 874) break;
                if (it < 138) {
                    if (it < 90) mlstm_item<false>(ub, yb, mscr, prm + 512, prm + 8, prm + 16, prm + 64, L + wave * ML_WSTRIDE, xcd + 8 * (it / 15), it % 15, lane);
                    else { const int ci = it - 90; fox_cumsum_item(ub, prm, fcl, ftot, (xcd + 8 * (ci >> 3)) * 8 + (ci & 7), lane); }
                    asm volatile("s_waitcnt vmcnt(0)" ::: "memory");
                    if (lane == 0) atomicAdd(done, 1u);
                } else {
                    if (it >= 394 && !((okmask >> xcd) & 1u)) { unsigned sp = 0u;
                        while (__hip_atomic_load(done, __ATOMIC_RELAXED, __HIP_MEMORY_SCOPE_AGENT) < 138u) { __builtin_amdgcn_s_sleep(4); if (++sp > (1u << 21)) break; }
                        __builtin_amdgcn_fence(__ATOMIC_ACQUIRE, "agent"); okmask |= 1u << xcd; }
                    if (it >= 394 && it < 490) { const int ci = it - 394; mlstm_item<true>(ub, yb, mscr, prm + 512, prm + 8, prm + 16, prm + 64, L + wave * ML_WSTRIDE, xcd + 8 * (ci >> 4), 15 - (ci & 15), lane); }
                    else { int aitem; if (it < 394) { const int ai = it - 138; aitem = (ai >> 2) * 80 + 48 + xcd + 8 * (ai & 3); } else { const int ai = it - 490; aitem = (ai / 6) * 80 + xcd + 8 * (ai % 6); }
                        attn_mfma_item(ub, yb, fcl, ftot, L + wave * ML_WSTRIDE, aitem, lane); }
                }
            }
            }
        } else {
            for (int it = gw; it < 2048; it += NGW) xattn_mfma_item(qxb, kvb + (size_t)l * MROWS * 1024, oxb, L + wave * 16384, it, lane);
        }
        XBAR();
    }
    {
        int tid_f = threadIdx.x; asm volatile("" : "+v"(tid_f)); const int lane = tid_f & 63, gw = bx * 8 + __builtin_amdgcn_readfirstlane(tid_f >> 6);
        const float* fw = (const float*)(a.ws + WS_PRM) + 2 * 8192; const float* sq = (const float*)(a.ws + WS_SSQP) + (size_t)6 * M * 16;
        const bf16* hbf = (const bf16*)(a.ws + WS_HB);
        for (int m = gw; m < M; m += NGW) {
            float sm = 0.f; { const f32x4* qp = (const f32x4*)(sq + (size_t)m * 16); const f32x4 q0 = qp[0], q1 = qp[1], q2 = qp[2], q3 = qp[3];
              sm = ((((q0[0] + q0[1]) + (q0[2] + q0[3])) + ((q1[0] + q1[1]) + (q1[2] + q1[3]))) + (((q2[0] + q2[1]) + (q2[2] + q2[3])) + ((q3[0] + q3[1]) + (q3[2] + q3[3])))); }
            const float rs = rsqrtf(sm * (1.0f / 1024.0f) + 1e-6f);
            const unsigned long long* hp = (const unsigned long long*)(hbf + (size_t)m * D) + lane; f32x4* rp = (f32x4*)(out + (size_t)m * D) + lane; const f32x4* wp = (const f32x4*)fw + lane;
#pragma unroll
            for (int j = 0; j < 4; ++j) { const unsigned long long hw = hp[64 * j]; const unsigned h0 = (unsigned)hw, h1 = (unsigned)(hw >> 32); const f32x4 w = wp[64 * j];
                f32x4 v = {lo_f(h0), hi_f(h0), lo_f(h1), hi_f(h1)}; v = v * rs * w; rp[64 * j] = v; }
        }
    }
}

extern "C" void kernel_launch(void* const* d_in, const int* in_sizes, int n_in, void* d_out, int out_size, void* d_ws, size_t ws_size, hipStream_t stream) {
    static int grid = 0;
    if (grid == 0) {
        if (n_in != 20 || out_size != M * D || ws_size < WS_END) { fprintf(stderr, "kernel_launch: unexpected shapes (n_in %d out %d ws %zu)\n", n_in, out_size, ws_size); grid = -1; return; }
        int dev = 0, cus = 0, per_cu = 0;
        hipGetDevice(&dev); hipDeviceGetAttribute(&cus, hipDeviceAttributeMultiprocessorCount, dev);
        if (hipFuncSetAttribute((const void*)mega_fwd, hipFuncAttributeMaxDynamicSharedMemorySize, LDS_BYTES) != hipSuccess) { fprintf(stderr, "kernel_launch: hipFuncSetAttribute failed\n"); grid = -1; return; }
        if (hipOccupancyMaxActiveBlocksPerMultiprocessor(&per_cu, (const void*)mega_fwd, 512, LDS_BYTES) != hipSuccess || per_cu < 1) { fprintf(stderr, "kernel_launch: occupancy query says %d\n", per_cu); (void)hipGetLastError(); per_cu = 1; }
        grid = cus * per_cu;
    }
    if (grid < 0) return;
    Args a{};
    for (int i = 0; i < 20; ++i) a.in[i] = (const float*)d_in[i];
    a.out = (float*)d_out; a.ws = (unsigned char*)d_ws;
    if (hipMemsetAsync((char*)d_ws + WS_BAR, 0, BAR_BYTES, stream) != hipSuccess) { fprintf(stderr, "kernel_launch: memset of the barrier words failed\n"); return; }
    void* args[] = {&a};
    hipError_t e = hipLaunchCooperativeKernel((const void*)mega_fwd, dim3(grid), dim3(512), args, LDS_BYTES, stream);
    if (e != hipSuccess) fprintf(stderr, "kernel_launch: cooperative launch failed: %s (grid %d)\n", hipGetErrorString(e), grid);
}
```

```cpp
#include <hip/hip_runtime.h>
#include <hip/hip_cooperative_groups.h>
#include <cstdio>
#include <cstdint>
#include <cmath>
namespace cg = cooperative_groups;
namespace pg8 {
#define PG8_LAS __attribute__((address_space(3)))
typedef unsigned short bf16_t;
typedef short bf16x8 __attribute__((ext_vector_type(8)));
typedef float f32x4 __attribute__((ext_vector_type(4)));
typedef unsigned u32x4 __attribute__((ext_vector_type(4)));
constexpr int BM = 256, BK = 64, HALF = 128, HTB = HALF * BK * 2  , STAGE_BYTES = 8 * HTB, NXCD = 8, WGM = 4;

__host__ __device__ __forceinline__ int lds_byte(int r, int c) { const int st = (r >> 4) * 2 + (c >> 5), rr = r & 15, cc = c & 31, ob = rr * 64 + cc * 2; return st * 1024 + (ob ^ (((ob >> 9) & 1) << 5)); }
__host__ __device__ __forceinline__ void stage_rc(int b, int& R, int& C) { const int st = b / 1024, sb = b % 1024, swz = sb ^ (((sb >> 9) & 1) << 5); R = (st >> 1) * 16 + swz / 64; C = (st & 1) * 32 + (swz % 64) / 2; }
__host__ __device__ __forceinline__ int perm32(int rho) { const int n = rho >> 4, i = rho & 15; return 8 * (i >> 2) + 4 * n + (i & 3); }

struct Unit { int pm, pn; };
struct Gemm { const bf16_t* A; const bf16_t* Bt; int M, N, K; };

struct StaticOrder {
    int nM, nN, nwg, G, c;
    __host__ __device__ void init(int M, int N, int G_, int c_) { nM = M / BM; nN = N / BM; nwg = nM * nN; G = G_; c = c_; }
    __host__ __device__ bool next(int i, Unit& u) const {
        const long L = (long)i * G + c; if (L >= nwg) return false;
        int wgid = (int)L; { const int q = nwg / NXCD, r = nwg % NXCD, xcd = wgid % NXCD, off = wgid / NXCD; wgid = (xcd < r ? xcd * (q + 1) : r * (q + 1) + (xcd - r) * q) + off; }
        const int nig = WGM * nN, gid = wgid / nig, fm = gid * WGM, gsz = (nM - fm) < WGM ? (nM - fm) : WGM;
        u.pm = fm + ((wgid % nig) % gsz); u.pn = (wgid % nig) / gsz; return true;
    }
    __device__ __forceinline__ void a_ready(const Unit&) const {}
    __device__ __forceinline__ void done(const Unit&) const {}
};

__device__ __forceinline__ unsigned cvt_pk_bf16(float lo, float hi) { unsigned r; asm volatile("v_cvt_pk_bf16_f32 %0, %1, %2" : "=v"(r) : "v"(lo), "v"(hi)); return r; }
typedef float f32x2 __attribute__((ext_vector_type(2)));
struct OffsetOrder {
    StaticOrder b;
    __device__ void init(int M, int N, int G, int c, int off) { b.init(M, N, G, (c + G - (off % G)) % G); }
    __device__ bool next(int i, Unit& u) const { return b.next(i, u); }
    __device__ __forceinline__ void a_ready(const Unit&) const {}
    __device__ __forceinline__ void done(const Unit&) const {}
};
struct EpiScaleBf16 {
    static constexpr bool PERM = true, AFTER_DRAIN = false;
    bf16_t* O; int ldc; const float* ssq;
    __device__ __forceinline__ void operator()(const f32x4 (&acc)[2][2][4][2], const Unit& u, int wr, int wc, int fr, int fq) const {
        const int row0 = u.pm * BM + wr * 64 + fr, col0 = u.pn * BM + wc * 32 + 8 * fq;
#pragma unroll
        for (int ai = 0; ai < 2; ++ai)
#pragma unroll
            for (int m = 0; m < 4; ++m) { const int row = row0 + ai * HALF + m * 16; const f32x4 q0 = *(const f32x4*)(ssq + (size_t)row * 16), q1 = *(const f32x4*)(ssq + (size_t)row * 16 + 4), q2 = *(const f32x4*)(ssq + (size_t)row * 16 + 8), q3 = *(const f32x4*)(ssq + (size_t)row * 16 + 12);
                const float rs = rsqrtf(((((q0[0] + q0[1]) + (q0[2] + q0[3])) + ((q1[0] + q1[1]) + (q1[2] + q1[3]))) + (((q2[0] + q2[1]) + (q2[2] + q2[3])) + ((q3[0] + q3[1]) + (q3[2] + q3[3])))) * (1.0f / 1024.0f) + 1e-6f);
                bf16_t* rowp = O + (size_t)row * ldc + col0;
#pragma unroll
                for (int bj = 0; bj < 2; ++bj) { const f32x4 v0 = acc[ai][bj][m][0] * rs, v1 = acc[ai][bj][m][1] * rs;
                    u32x4 w; w.x = cvt_pk_bf16(v0[0], v0[1]); w.y = cvt_pk_bf16(v0[2], v0[3]); w.z = cvt_pk_bf16(v1[0], v1[1]); w.w = cvt_pk_bf16(v1[2], v1[3]);
                    *(u32x4*)(rowp + bj * HALF) = w; } }
    }
};
struct EpiResid {
    static constexpr bool PERM = true, AFTER_DRAIN = false;
    bf16_t* hb; float* ssq;
    __device__ __forceinline__ void operator()(const f32x4 (&acc)[2][2][4][2], const Unit& u, int wr, int wc, int fr, int fq) const {
        const int row0 = u.pm * BM + wr * 64 + fr, col0 = u.pn * BM + wc * 32 + 8 * fq;
#pragma unroll
        for (int ai = 0; ai < 2; ++ai)
#pragma unroll
            for (int m = 0; m < 4; ++m) { const int row = row0 + ai * HALF + m * 16; const size_t off = (size_t)row * 1024 + col0; float part = 0.f;
#pragma unroll
                for (int bj = 0; bj < 2; ++bj) { const u32x4 b = *(const u32x4*)(hb + off + bj * HALF);
                    f32x4 v0 = acc[ai][bj][m][0], v1 = acc[ai][bj][m][1];
                    v0[0] += __uint_as_float(b.x << 16); v0[1] += __uint_as_float(b.x & 0xffff0000u); v0[2] += __uint_as_float(b.y << 16); v0[3] += __uint_as_float(b.y & 0xffff0000u);
                    v1[0] += __uint_as_float(b.z << 16); v1[1] += __uint_as_float(b.z & 0xffff0000u); v1[2] += __uint_as_float(b.w << 16); v1[3] += __uint_as_float(b.w & 0xffff0000u);
                    u32x4 w; w.x = cvt_pk_bf16(v0[0], v0[1]); w.y = cvt_pk_bf16(v0[2], v0[3]); w.z = cvt_pk_bf16(v1[0], v1[1]); w.w = cvt_pk_bf16(v1[2], v1[3]);
                    *(u32x4*)(hb + off + bj * HALF) = w;
                    part += (v0[0] * v0[0] + v0[1] * v0[1]) + (v0[2] * v0[2] + v0[3] * v0[3]) + (v1[0] * v1[0] + v1[1] * v1[1]) + (v1[2] * v1[2] + v1[3] * v1[3]); }
                part += __shfl_xor(part, 16); part += __shfl_xor(part, 32);
                if (fq == 0) ssq[(size_t)row * 16 + u.pn * 4 + wc] = part; }
    }
};
struct EpiSwiglu {
    static constexpr bool PERM = true, AFTER_DRAIN = false;
    bf16_t* O; int ldc; const float* ssq;
    __device__ __forceinline__ void operator()(const f32x4 (&acc)[2][2][4][2], const Unit& u, int wr, int wc, int fr, int fq) const {
        const int row0 = u.pm * BM + wr * 64 + fr, col0 = u.pn * HALF + wc * 32 + 8 * fq;
#pragma unroll
        for (int ai = 0; ai < 2; ++ai)
#pragma unroll
            for (int m = 0; m < 4; ++m) { const int row = row0 + ai * HALF + m * 16; const f32x4 q0 = *(const f32x4*)(ssq + (size_t)row * 16), q1 = *(const f32x4*)(ssq + (size_t)row * 16 + 4), q2 = *(const f32x4*)(ssq + (size_t)row * 16 + 8), q3 = *(const f32x4*)(ssq + (size_t)row * 16 + 12);
                const float rs = rsqrtf(((((q0[0] + q0[1]) + (q0[2] + q0[3])) + ((q1[0] + q1[1]) + (q1[2] + q1[3]))) + (((q2[0] + q2[1]) + (q2[2] + q2[3])) + ((q3[0] + q3[1]) + (q3[2] + q3[3])))) * (1.0f / 1024.0f) + 1e-6f);
                float a[8];
#pragma unroll
                for (int n = 0; n < 2; ++n)
#pragma unroll
                    for (int j = 0; j < 4; ++j) { const float g = acc[ai][0][m][n][j] * rs, up = acc[ai][1][m][n][j] * rs; a[4 * n + j] = g * up * __builtin_amdgcn_rcpf(1.0f + __expf(-g)); }
                u32x4 w; w.x = cvt_pk_bf16(a[0], a[1]); w.y = cvt_pk_bf16(a[2], a[3]); w.z = cvt_pk_bf16(a[4], a[5]); w.w = cvt_pk_bf16(a[6], a[7]);
                *(u32x4*)(O + (size_t)row * ldc + col0) = w; }
    }
};
template <class Epi, class Sched, bool ALIGN_EPI = false, bool SP2 = false>
__device__ __forceinline__ void gemm_phase(PG8_LAS unsigned char* lds, const Gemm g, const Sched& S, const Epi& E) {
    int tid_l = threadIdx.x; asm volatile("" : "+v"(tid_l));
    const int tid = tid_l, wid = __builtin_amdgcn_readfirstlane(tid >> 6), lane = tid & 63, wr = wid >> 2, wc = wid & 3, fr = lane & 15, fq = lane >> 4;
    const int K = g.K, nt = K / BK;
    unsigned voffA[2], voffB[2];
#pragma unroll
    for (int i = 0; i < 2; ++i) { int R, C; stage_rc(tid * 16 + i * 8192, R, C); const int Rb = Epi::PERM ? ((R & ~31) + perm32(R & 31)) : R;
        voffA[i] = (unsigned)(R * K + C) * 2u; voffB[i] = (unsigned)(Rb * K + C) * 2u; }
    const size_t kstep = (size_t)(BK * 2);
    const size_t hstep = (size_t)HALF * K * 2;
    const size_t tstep = 2 * hstep;
    const unsigned ldsw = (unsigned)wid * 1024u;
    const int aoff = lds_byte(wr * 64 + fr, fq * 8), boff = lds_byte(wc * 32 + fr, fq * 8);
#define PG8_SA(b, h) (((b) * 2 + (h)) * HTB)
#define PG8_SB(b, h) ((4 + (b) * 2 + (h)) * HTB)
#define PG8_STAGE(bufoff, gbase, voff) do { _Pragma("unroll") for (int _i = 0; _i < 2; ++_i) \
        __builtin_amdgcn_global_load_lds((const unsigned*)((const char*)(gbase) + (voff)[_i]), (PG8_LAS unsigned*)(lds + (bufoff) + ldsw + _i * 8192), 16, 0, 0); } while (0)
#define PG8_LDA(dst, b, h) do { _Pragma("unroll") for (int m = 0; m < 4; ++m) _Pragma("unroll") for (int k = 0; k < 2; ++k) dst[m][k] = *(const PG8_LAS bf16x8*)(lds + PG8_SA(b, h) + aoff + m * 2048 + k * 1024); } while (0)
#define PG8_LDB(dst, b, h) do { _Pragma("unroll") for (int n = 0; n < 2; ++n) _Pragma("unroll") for (int k = 0; k < 2; ++k) dst[n][k] = *(const PG8_LAS bf16x8*)(lds + PG8_SB(b, h) + boff + n * 2048 + k * 1024); } while (0)
#define PG8_MMA(ai, bj, At, Bt) do { __builtin_amdgcn_s_setprio(1); _Pragma("unroll") for (int m = 0; m < 4; ++m) _Pragma("unroll") for (int n = 0; n < 2; ++n) _Pragma("unroll") for (int k = 0; k < 2; ++k) \
        acc[ai][bj][m][n] = __builtin_amdgcn_mfma_f32_16x16x32_bf16(Bt[n][k], At[m][k], acc[ai][bj][m][n], 0, 0, 0); __builtin_amdgcn_s_setprio(0); } while (0)
#define PG8_WAIT_V(n) asm volatile("s_waitcnt vmcnt(" #n ")" ::: "memory")
#define PG8_WAIT_L(n) asm volatile("s_waitcnt lgkmcnt(" #n ")" ::: "memory")
#define PG8_BAR __builtin_amdgcn_s_barrier()
#define PG8_SCHED __builtin_amdgcn_sched_barrier(0)
    Unit cur, nxt; int ui = 0;
    if (!S.next(0, cur)) return;
    f32x4 acc[2][2][4][2];
#pragma unroll
    for (int a = 0; a < 2; ++a)
#pragma unroll
        for (int b = 0; b < 2; ++b)
#pragma unroll
            for (int m = 0; m < 4; ++m)
#pragma unroll
                for (int n = 0; n < 2; ++n) acc[a][b][m][n] = (f32x4){0.f, 0.f, 0.f, 0.f};
    bf16x8 At[4][2], B0[2][2], B1[2][2];
    const char* cA = (const char*)g.A + (size_t)cur.pm * tstep; const char* cB = (const char*)g.Bt + (size_t)cur.pn * tstep;
    S.a_ready(cur);
    if constexpr (SP2) {
        PG8_STAGE(PG8_SB(0, 0), cB, voffB); PG8_STAGE(PG8_SB(0, 1), cB + hstep, voffB); PG8_STAGE(PG8_SA(0, 0), cA, voffA); PG8_STAGE(PG8_SA(0, 1), cA + hstep, voffA);
        if (wr == 1) PG8_BAR;
        PG8_WAIT_V(2); PG8_BAR;
        PG8_STAGE(PG8_SB(1, 0), cB + kstep, voffB); PG8_STAGE(PG8_SA(1, 0), cA + kstep, voffA); PG8_STAGE(PG8_SB(1, 1), cB + hstep + kstep, voffB);
        PG8_WAIT_V(6); PG8_BAR;
    } else {
        PG8_STAGE(PG8_SB(0, 0), cB, voffB); PG8_STAGE(PG8_SA(0, 0), cA, voffA); PG8_STAGE(PG8_SB(0, 1), cB + hstep, voffB); PG8_STAGE(PG8_SA(0, 1), cA + hstep, voffA);
        if (wr == 1) PG8_BAR;
        PG8_WAIT_V(4); PG8_BAR;
        PG8_STAGE(PG8_SB(1, 0), cB + kstep, voffB); PG8_STAGE(PG8_SA(1, 0), cA + kstep, voffA); PG8_STAGE(PG8_SB(1, 1), cB + hstep + kstep, voffB);
        PG8_WAIT_V(6); PG8_BAR;
    }
    for (;;) {
        const bool has_next = S.next(ui + 1, nxt);
        const char* nA = has_next ? (const char*)g.A + (size_t)nxt.pm * tstep : cA; const char* nB = has_next ? (const char*)g.Bt + (size_t)nxt.pn * tstep : cB;
        for (int t = 0; t < nt; t += 2) {
            const bool last = (t == nt - 2);
            const char* a1 = cA + (size_t)(t + 1) * kstep;
            const char* a2 = last ? nA : cA + (size_t)(t + 2) * kstep; const char* b2 = last ? nB : cB + (size_t)(t + 2) * kstep;
            const char* a3 = a2 + kstep; const char* b3 = b2 + kstep;
            if (last && has_next) S.a_ready(nxt);
            if constexpr (SP2) {
            PG8_LDB(B0, 0, 0); PG8_LDB(B1, 0, 1); PG8_SCHED; PG8_LDA(At, 0, 0); PG8_STAGE(PG8_SA(1, 1), a1 + hstep, voffA);
            PG8_WAIT_V(8); PG8_WAIT_L(0); PG8_BAR; PG8_MMA(0, 0, At, B0); PG8_MMA(0, 1, At, B1); PG8_BAR; PG8_SCHED;
            PG8_LDA(At, 0, 1); PG8_STAGE(PG8_SB(0, 0), b2, voffB); PG8_STAGE(PG8_SB(0, 1), b2 + hstep, voffB); PG8_STAGE(PG8_SA(0, 0), a2, voffA);
            PG8_WAIT_V(8); PG8_WAIT_L(0); PG8_BAR; PG8_MMA(1, 0, At, B0); PG8_MMA(1, 1, At, B1); PG8_BAR; PG8_SCHED;
            PG8_LDB(B0, 1, 0); PG8_LDB(B1, 1, 1); PG8_SCHED; PG8_LDA(At, 1, 0); PG8_STAGE(PG8_SA(0, 1), a2 + hstep, voffA);
            PG8_WAIT_V(8); PG8_WAIT_L(0); PG8_BAR; PG8_MMA(0, 0, At, B0); PG8_MMA(0, 1, At, B1); PG8_BAR; PG8_SCHED;
            PG8_LDA(At, 1, 1); PG8_STAGE(PG8_SB(1, 0), b3, voffB); PG8_STAGE(PG8_SB(1, 1), b3 + hstep, voffB); PG8_STAGE(PG8_SA(1, 0), a3, voffA);
            PG8_WAIT_V(8); PG8_WAIT_L(0); PG8_BAR; PG8_MMA(1, 0, At, B0); PG8_MMA(1, 1, At, B1); PG8_BAR; PG8_SCHED;
            } else {
            PG8_LDB(B0, 0, 0); PG8_SCHED; PG8_LDA(At, 0, 0); PG8_STAGE(PG8_SA(1, 1), a1 + hstep, voffA);
            PG8_WAIT_L(8); PG8_BAR; PG8_WAIT_L(0); PG8_MMA(0, 0, At, B0); PG8_BAR; PG8_SCHED;
            PG8_LDB(B1, 0, 1); PG8_STAGE(PG8_SB(0, 0), b2, voffB);
            PG8_BAR; PG8_WAIT_L(0); PG8_MMA(0, 1, At, B1); PG8_BAR;
            PG8_LDA(At, 0, 1); PG8_STAGE(PG8_SA(0, 0), a2, voffA);
            PG8_BAR; PG8_WAIT_L(0); PG8_MMA(1, 0, At, B0); PG8_BAR; PG8_SCHED;
            PG8_STAGE(PG8_SB(0, 1), b2 + hstep, voffB);
            PG8_WAIT_V(6); PG8_BAR; PG8_MMA(1, 1, At, B1); PG8_BAR;
            PG8_LDB(B0, 1, 0); PG8_SCHED; PG8_LDA(At, 1, 0); PG8_STAGE(PG8_SA(0, 1), a2 + hstep, voffA);
            PG8_WAIT_L(8); PG8_BAR; PG8_WAIT_L(0); PG8_MMA(0, 0, At, B0); PG8_BAR; PG8_SCHED;
            PG8_LDB(B1, 1, 1); PG8_STAGE(PG8_SB(1, 0), b3, voffB);
            PG8_BAR; PG8_WAIT_L(0); PG8_MMA(0, 1, At, B1); PG8_BAR;
            PG8_LDA(At, 1, 1); PG8_STAGE(PG8_SA(1, 0), a3, voffA);
            PG8_BAR; PG8_WAIT_L(0); PG8_MMA(1, 0, At, B0); PG8_BAR; PG8_SCHED;
            PG8_STAGE(PG8_SB(1, 1), b3 + hstep, voffB);
            PG8_WAIT_V(6); PG8_BAR; PG8_MMA(1, 1, At, B1); PG8_BAR;
            }
        }
        if constexpr (ALIGN_EPI) { if (wr == 0) PG8_BAR; }
        if constexpr (!Epi::AFTER_DRAIN) { E(acc, cur, wr, wc, fr, fq); S.done(cur); }
        if (!has_next) break;
#pragma unroll
        for (int a = 0; a < 2; ++a)
#pragma unroll
            for (int b = 0; b < 2; ++b)
#pragma unroll
                for (int m = 0; m < 4; ++m)
#pragma unroll
                    for (int n = 0; n < 2; ++n) acc[a][b][m][n] = (f32x4){0.f, 0.f, 0.f, 0.f};
        cur = nxt; cA = nA; cB = nB; ++ui;
        if constexpr (ALIGN_EPI) { if (wr == 1) PG8_BAR; }
    }
    PG8_WAIT_V(0);
    if constexpr (!ALIGN_EPI) { if (wr == 0) PG8_BAR; }
    PG8_BAR;
    if constexpr (Epi::AFTER_DRAIN) { E.fused(acc, cur, wr, wc, fr, fq, lds, wid, lane); S.done(cur); }
#undef PG8_SA
#undef PG8_SB
#undef PG8_STAGE
#undef PG8_LDA
#undef PG8_LDB
#undef PG8_MMA
#undef PG8_WAIT_V
#undef PG8_WAIT_L
#undef PG8_BAR
#undef PG8_SCHED
}
}
#define LAS __attribute__((address_space(3)))
typedef unsigned short bf16;
typedef unsigned v4u __attribute__((ext_vector_type(4)));
typedef float f32x4 __attribute__((ext_vector_type(4)));

constexpr int NB = 8, S = 2048, D = 1024, M = NB * S, NU = 3584, DFF = 2816, MEML = 256, MROWS = NB * MEML, DX = 512;
constexpr size_t MiB = 1u << 20;
constexpr size_t WS_SSQ = 0;
constexpr size_t WS_SSQM = 512 * 1024;
constexpr size_t WS_BAR = 768 * 1024, BAR_BYTES = 16384;
constexpr int LDS_BARST = 147392;
constexpr size_t WS_PRM = 800 * 1024;
constexpr size_t WS_W = 1 * MiB, W_LAYER = 29 * MiB + MiB / 2;
constexpr size_t OW_IN = 0, OW_OUT = 7 * MiB, OW_XQ = 9 * MiB, OW_XKV = 10 * MiB, OW_XO = 12 * MiB, OW_GU = 13 * MiB, OW_DN = 24 * MiB;
constexpr size_t WS_U = 60 * MiB;
constexpr size_t WS_Y = 172 * MiB;
constexpr size_t WS_QX = 172 * MiB, WS_OX = 188 * MiB;
constexpr size_t WS_HB = 204 * MiB;
constexpr size_t WS_MEMB = 236 * MiB;
constexpr size_t WS_KV = 240 * MiB;
constexpr size_t WS_SSQP = 248 * MiB;
constexpr size_t WS_END = 256 * MiB;
constexpr int LDS_BYTES = 147456;

__device__ __forceinline__ unsigned f2bf(float f) { unsigned u = __builtin_bit_cast(unsigned, f); return (u + 0x7fffu + ((u >> 16) & 1u)) >> 16; }
__device__ __forceinline__ unsigned pk2(float lo, float hi) { return f2bf(lo) | (f2bf(hi) << 16); }
__device__ __forceinline__ float bf2f(unsigned short v) { return __uint_as_float(((unsigned)v) << 16); }
__device__ __forceinline__ float lo_f(unsigned w) { return __uint_as_float(w << 16); }
__device__ __forceinline__ float hi_f(unsigned w) { return __uint_as_float(w & 0xffff0000u); }
__device__ __forceinline__ float log_sigmoid_f(float x) { return fminf(x, 0.f) - __logf(1.0f + __expf(-fabsf(x))); }
__device__ __forceinline__ float sigmoid_f(float x) { return __builtin_amdgcn_rcpf(1.0f + __expf(-x)); }
__device__ __forceinline__ float wave_sum(float v) {
#pragma unroll
    for (int o = 1; o < 64; o <<= 1) v += __shfl_xor(v, o);
    return v;
}

#define XB_TMO      128
#define XB_XCNT(j)  (256  + 64 * (j))
#define XB_XSUB(j)  (1280 + 64 * (j))
#define XB_XGEN(j)  (2304 + 64 * (j))
#define XB_TOP      3328
#define XB_TOPGEN   3392
#define XCD_BAR_WORDS 3456
#define XB_SPIN_CAP (1u << 18)

__device__ __forceinline__ unsigned xb_ld(unsigned* p)              { return __hip_atomic_load(p, __ATOMIC_RELAXED, __HIP_MEMORY_SCOPE_AGENT); }
__device__ __forceinline__ unsigned xb_add(unsigned* p, unsigned v) { return __hip_atomic_fetch_add(p, v, __ATOMIC_RELAXED, __HIP_MEMORY_SCOPE_AGENT); }
__device__ __forceinline__ unsigned xb_xcc_id() { return (unsigned)__builtin_amdgcn_s_getreg((3 << 11) | 20) & 0xFu; }
#define XB_SPIN(cond, bar) do { unsigned _sp = 0; while (cond) { __builtin_amdgcn_s_sleep(1); \
    if ((++_sp & 255u) == 0u) { if (xb_ld(&(bar)[XB_TMO])) break; if (_sp > XB_SPIN_CAP) { atomicAdd(&(bar)[XB_TMO], 1u); break; } } } } while (0)

struct XcdBarrier {
    unsigned* bar; unsigned x;
    volatile LAS unsigned* st;
};

__device__ __forceinline__ XcdBarrier xcd_barrier_post(unsigned* bar, volatile LAS unsigned* st) {
    XcdBarrier b; b.bar = bar; b.x = xb_xcc_id(); b.st = st;
    if (threadIdx.x == 0) (void)xb_add(&bar[XB_XCNT(b.x)], 1u);
    return b;
}
__device__ __forceinline__ void xcd_barrier_complete(unsigned* bar, unsigned x, unsigned& nloc, unsigned& nx) {
    const unsigned G = gridDim.x * gridDim.y * gridDim.z;
    unsigned sum, cnt, mine, sp = 0u;
    for (;;) {
        sum = 0u; cnt = 0u; mine = 0u;
#pragma unroll
        for (unsigned j = 0; j < 16; ++j) { const unsigned c = xb_ld(&bar[XB_XCNT(j)]); sum += c; cnt += (c > 0u) ? 1u : 0u; mine = (j == x) ? c : mine; }
        if (sum == G) break;
        __builtin_amdgcn_s_sleep(1);
        if ((++sp & 255u) == 0u) { if (xb_ld(&bar[XB_TMO])) break; if (sp > XB_SPIN_CAP) { atomicAdd(&bar[XB_TMO], 1u); break; } }
    }
    nloc = mine > 0u ? mine : 1u; nx = cnt > 0u ? cnt : 1u;
}

__device__ __forceinline__ void xcd_barrier(const XcdBarrier& b) {
    asm volatile("s_waitcnt vmcnt(0)" ::: "memory");
    __syncthreads();
    if (threadIdx.x == 0) {
        unsigned* bar = b.bar;
        __builtin_amdgcn_s_waitcnt(0);
        unsigned nloc = b.st[0], nx = b.st[1];
        if (nloc == 0u) { xcd_barrier_complete(bar, b.x, nloc, nx); b.st[0] = nloc; b.st[1] = nx; }
        const unsigned old = xb_add(&bar[XB_XSUB(b.x)], 1u);
        const unsigned gen = old / nloc;
        if (old + 1u == (gen + 1u) * nloc) {
            __builtin_amdgcn_fence(__ATOMIC_RELEASE, "agent");
            asm volatile("s_waitcnt vmcnt(0)" ::: "memory");
            const unsigned og = xb_add(&bar[XB_TOP], 1u);
            const unsigned tg = og / nx;
            if (og + 1u == (tg + 1u) * nx) xb_add(&bar[XB_TOPGEN], 1u);
            else XB_SPIN(xb_ld(&bar[XB_TOPGEN]) == tg, bar);
            __builtin_amdgcn_fence(__ATOMIC_ACQUIRE, "agent");
            xb_add(&bar[XB_XGEN(b.x)], 1u);
            asm volatile("s_waitcnt vmcnt(0)" ::: "memory");
        } else {
            XB_SPIN(xb_ld(&bar[XB_XGEN(b.x)]) == gen, bar);
            __builtin_amdgcn_fence(__ATOMIC_ACQUIRE, "agent");
            asm volatile("s_waitcnt vmcnt(0)" ::: "memory");
        }
    }
    __syncthreads();
}

__device__ __forceinline__ void conv_item(const float* W0, const float* W1, int pitch, int K, int mode, const float* rowscale, bf16* WT, LAS float* scr, int item, int nblk, int lane) {
    const int kb = item / nblk, nb = item % nblk, k0 = 64 * kb, n0 = 32 * nb;
    const int n = n0 + (lane & 31);
    const float* src = nullptr;
    if (mode == 0) src = W0 + n;
    else if (mode == 1) { if (n < 1152) src = W0 + n; else if (n < 3456) src = W0 + n + 6; else if (n < 3462) src = W0 + 1152 + (n - 3456); else if (n < 3474) src = W0 + n; }
    else { const int t = n >> 8, j = n & 255; src = (j < 128) ? (W0 + 128 * t + j) : (W1 + 128 * t + (j - 128)); }
#pragma unroll
    for (int i = 0; i < 32; ++i) { const int kk = 2 * i + (lane >> 5); float v = src ? src[(size_t)(k0 + kk) * pitch] : 0.f; if (rowscale) v *= rowscale[k0 + kk]; scr[kk * 33 + (lane & 31)] = v; }
    asm volatile("s_waitcnt lgkmcnt(0)" ::: "memory");
    const int c = lane & 7;
#pragma unroll
    for (int j = 0; j < 4; ++j) { const int nn = (lane >> 3) + 8 * j; const LAS float* s = scr + (8 * c) * 33 + nn;
        v4u o; o.x = pk2(s[0 * 33], s[1 * 33]); o.y = pk2(s[2 * 33], s[3 * 33]); o.z = pk2(s[4 * 33], s[5 * 33]); o.w = pk2(s[6 * 33], s[7 * 33]);
        *(v4u*)(WT + (size_t)(n0 + nn) * K + k0 + 8 * c) = o; }
    asm volatile("s_waitcnt lgkmcnt(0)" ::: "memory");
}
__device__ __forceinline__ void conv_block_item(const float* W0, const float* W1, int pitch, int K, int mode, const float* rowscale, bf16* WT, LAS float* tile, int kb, int nb, int tid) {
    const int k0 = 64 * kb, n0 = 256 * nb, c4 = (tid & 63) * 4;
#pragma unroll
    for (int i = 0; i < 8; ++i) { const int row = 8 * i + (tid >> 6); f32x4 v = {0.f, 0.f, 0.f, 0.f};
        const float* rp = W0 + (size_t)(k0 + row) * pitch;
        if (mode == 0) v = *(const f32x4*)(rp + n0 + c4);
        else if (mode == 2) { const float* rq = (c4 < 128 ? rp : W1 + (size_t)(k0 + row) * pitch) + 128 * nb + (c4 & 127); v = *(const f32x4*)rq; }
        else {
#pragma unroll
            for (int j = 0; j < 4; ++j) { const int n = n0 + c4 + j; int sc = -1;
                if (n < 1152) sc = n; else if (n < 3456) sc = n + 6; else if (n < 3462) sc = 1152 + (n - 3456); else if (n < 3474) sc = n;
                v[j] = sc >= 0 ? rp[sc] : 0.f; } }
        if (rowscale) v = v * rowscale[k0 + row];
        LAS float* d = tile + row * 257 + c4; d[0] = v[0]; d[1] = v[1]; d[2] = v[2]; d[3] = v[3]; }
    __syncthreads();
    const int q = tid & 7;
#pragma unroll
    for (int pass = 0; pass < 4; ++pass) { const int nl = (tid >> 3) + 64 * pass; const LAS float* sp = tile + (8 * q) * 257 + nl;
        v4u o; o.x = pk2(sp[0], sp[257]); o.y = pk2(sp[2 * 257], sp[3 * 257]); o.z = pk2(sp[4 * 257], sp[5 * 257]); o.w = pk2(sp[6 * 257], sp[7 * 257]);
        *(v4u*)(WT + (size_t)(n0 + nl) * K + k0 + 8 * q) = o; }
    __syncthreads();
}
__device__ __forceinline__ void row_to_bf16_ssq(const float* xrow, bf16* orow, float* ssq_out, int lane) {
    const f32x4* xr = (const f32x4*)xrow + lane; f32x4 v[4]; float s2 = 0.f;
#pragma unroll
    for (int j = 0; j < 4; ++j) { v[j] = xr[64 * j]; s2 += (v[j].x * v[j].x + v[j].y * v[j].y) + (v[j].z * v[j].z + v[j].w * v[j].w); }
    s2 = wave_sum(s2);
    unsigned long long* o8 = (unsigned long long*)orow + lane;
#pragma unroll
    for (int j = 0; j < 4; ++j) o8[64 * j] = (unsigned long long)pk2(v[j].x, v[j].y) | ((unsigned long long)pk2(v[j].z, v[j].w) << 32);
    if (lane < 16) ssq_out[lane] = lane == 0 ? s2 : 0.f;
}

typedef short s16x8 __attribute__((ext_vector_type(8)));
typedef short s16x4 __attribute__((ext_vector_type(4)));
typedef float f32x16 __attribute__((ext_vector_type(16)));
__device__ __forceinline__ s16x4 tr_read(LAS const unsigned char* p) { return __builtin_bit_cast(s16x4, __builtin_amdgcn_ds_read_tr16_b64_v4i16((LAS s16x4*)p)); }
__device__ __forceinline__ s16x8 cat8(s16x4 a, s16x4 b) { return (s16x8){a[0], a[1], a[2], a[3], b[0], b[1], b[2], b[3]}; }
__device__ __forceinline__ unsigned cvtpk(float lo, float hi) { return pg8::cvt_pk_bf16(lo, hi); }
__device__ __forceinline__ s16x8 pack8(float a0, float a1, float a2, float a3, float a4, float a5, float a6, float a7) {
    v4u w; w.x = cvtpk(a0, a1); w.y = cvtpk(a2, a3); w.z = cvtpk(a4, a5); w.w = cvtpk(a6, a7); return __builtin_bit_cast(s16x8, w); }
#define MFMA32(a, b, c) __builtin_amdgcn_mfma_f32_32x32x16_bf16(a, b, c, 0, 0, 0)
__device__ __forceinline__ float xh_sum(float x) { auto rr = __builtin_amdgcn_permlane32_swap(__float_as_uint(x), __float_as_uint(x), false, false); return __uint_as_float(rr[0]) + __uint_as_float(rr[1]); }
__device__ __forceinline__ float xh_max(float x) { auto rr = __builtin_amdgcn_permlane32_swap(__float_as_uint(x), __float_as_uint(x), false, false); return fmaxf(__uint_as_float(rr[0]), __uint_as_float(rr[1])); }
__device__ __forceinline__ float xh_prod(float x) { auto rr = __builtin_amdgcn_permlane32_swap(__float_as_uint(x), __float_as_uint(x), false, false); return __uint_as_float(rr[0]) * __uint_as_float(rr[1]); }
__device__ __forceinline__ float xh_other(float x) { auto rr = __builtin_amdgcn_permlane32_swap(__float_as_uint(x), __float_as_uint(x), false, false); return __uint_as_float(rr[0] == __float_as_uint(x) ? rr[1] : rr[0]); }
__device__ __forceinline__ void st_wt64(float* p, float a, float b) { __hip_atomic_store((unsigned long long*)p, ((unsigned long long)__float_as_uint(b) << 32) | (unsigned long long)__float_as_uint(a), __ATOMIC_RELAXED, __HIP_MEMORY_SCOPE_AGENT); }
__device__ __forceinline__ void st_wt32(float* p, float a) { __hip_atomic_store((unsigned*)p, __float_as_uint(a), __ATOMIC_RELAXED, __HIP_MEMORY_SCOPE_AGENT); }
__device__ __forceinline__ void fox_cumsum_item(const bf16* u, const float* foxb, float* cl, float* tot, int item, int lane) {
    const int bhf = item >> 3, seg = item & 7, b = bhf / 6, h = bhf % 6;
    const float fb = foxb[h];
    const bf16* p = u + ((size_t)b * S + seg * 256 + 4 * lane) * NU + 3456 + h;
    const float L2E = 1.4426950408889634f;
    float l0 = L2E * log_sigmoid_f(bf2f(p[0]) + fb), l1 = L2E * log_sigmoid_f(bf2f(p[NU]) + fb), l2 = L2E * log_sigmoid_f(bf2f(p[2 * NU]) + fb), l3 = L2E * log_sigmoid_f(bf2f(p[3 * NU]) + fb);
    l1 += l0; l2 += l1; l3 += l2;
    float inc = l3;
#pragma unroll
    for (int o = 1; o < 64; o <<= 1) { const float v = __shfl_up(inc, o, 64); if (lane >= o) inc += v; }
    const float ex = inc - l3;
    { float* d = cl + (size_t)bhf * S + seg * 256 + 4 * lane; st_wt64(d, ex + l0, ex + l1); st_wt64(d + 2, ex + l2, ex + l3); }
    if (lane == 63) st_wt32(tot + bhf * 8 + seg, inc);
}
constexpr int PV64 = 144;
__device__ __forceinline__ void attn_mfma_item(const bf16* u, bf16* y, const float* cl, const float* tot, LAS unsigned char* wl, int item, int lane) {
    const int bh = item % 80, qb = 63 - item / 80;
    const bool fox = bh < 48;
    int b, h, qoff, koff, voff, yoff;
    if (fox) { b = bh / 6; h = bh % 6; qoff = h * 64; koff = 384 + h * 64; voff = 768 + h * 64; yoff = h * 64; }
    else { const int rr = bh - 48; b = rr / 4; h = rr % 4; qoff = 1152 + h * 64; koff = 1408 + h * 64; voff = 1664 + h * 64; yoff = 384 + h * 64; }
    const int r = lane & 31, hi = lane >> 5;
    const char* ubc = (const char*)(u + (size_t)b * S * NU);
    const int t = qb * 32 + r;
    const float* clh = cl + (size_t)(fox ? bh : 0) * S;
    s16x8 Qf[4];
    { const unsigned qo = (unsigned)(t * NU + qoff + 8 * hi) * 2u;
#pragma unroll
      for (int d0 = 0; d0 < 4; ++d0) Qf[d0] = *(const s16x8*)(ubc + qo + 32 * d0);
      if (!fox) {
          const float qs = -0.125f * 1.4426950408889634f;
#pragma unroll
          for (int d0 = 0; d0 < 4; ++d0) { const v4u w = __builtin_bit_cast(v4u, Qf[d0]);
              Qf[d0] = pack8(lo_f(w.x) * qs, hi_f(w.x) * qs, lo_f(w.y) * qs, hi_f(w.y) * qs, lo_f(w.z) * qs, hi_f(w.z) * qs, lo_f(w.w) * qs, hi_f(w.w) * qs); } } }
    f32x16 O0, O1;
#pragma unroll
    for (int i = 0; i < 16; ++i) { O0[i] = 0.f; O1[i] = 0.f; }
    float mrun = -1e30f, lsum = 0.f, Rsb = 1.f, Doff = 0.f;
    const float clt = fox ? clh[t] : 0.f;
    LAS float* gl = (LAS float*)(wl + 4608);
    const int trbase = (4 * hi + ((lane >> 2) & 3)) * PV64 + (16 * ((lane >> 4) & 1) + 4 * (lane & 3)) * 2;
    const unsigned lane_off = (unsigned)((lane >> 3) * NU + 8 * (lane & 7)) * 2u;
    v4u kn[4], vn[4]; float gn = 0.f;
    { const char* tb = ubc + (size_t)(qb * 32) * NU * 2;
#pragma unroll
      for (int i = 0; i < 4; ++i) { kn[i] = *(const v4u*)(tb + (size_t)(8 * i * NU + koff) * 2 + lane_off); vn[i] = *(const v4u*)(tb + (size_t)(8 * i * NU + voff) * 2 + lane_off); }
      if (fox) gn = clh[qb * 32 + r]; }
    LAS unsigned char* kl = wl + 4736;
    const int kfoff = r * PV64 + 16 * hi;
    const float SC2 = 0.125f * 1.4426950408889634f;
    { LAS unsigned char* z = wl + 9344 + (lane >> 3) * PV64 + 16 * (lane & 7);
#pragma unroll
      for (int i = 0; i < 4; ++i) *(LAS v4u*)(z + 8 * i * PV64) = (v4u){0u, 0u, 0u, 0u}; }
    s16x8 Pp0 = {0, 0, 0, 0, 0, 0, 0, 0}, Pp1 = {0, 0, 0, 0, 0, 0, 0, 0};
    int vlast = 0;
    for (int jt = qb; jt >= 0; --jt) {
        const bool diag = (jt == qb);
        const int vcur = ((qb - jt) & 1) ? 9344 : 0, vprev = 9344 - vcur; vlast = vcur;
        { LAS unsigned char* dk = kl + (lane >> 3) * PV64 + 16 * (lane & 7); LAS unsigned char* dv = wl + vcur + (lane >> 3) * PV64 + 16 * (lane & 7);
#pragma unroll
          for (int i = 0; i < 4; ++i) { *(LAS v4u*)(dk + 8 * i * PV64) = kn[i]; *(LAS v4u*)(dv + 8 * i * PV64) = vn[i]; } }
        if (fox) gl[r] = -gn;
        if (jt > 0) { const char* tb = ubc + (size_t)((jt - 1) * 32) * NU * 2;
#pragma unroll
          for (int i = 0; i < 4; ++i) { kn[i] = *(const v4u*)(tb + (size_t)(8 * i * NU + koff) * 2 + lane_off); vn[i] = *(const v4u*)(tb + (size_t)(8 * i * NU + voff) * 2 + lane_off); }
          if (fox) gn = clh[(jt - 1) * 32 + r]; }
        s16x8 Kf[4];
#pragma unroll
        for (int d0 = 0; d0 < 4; ++d0) Kf[d0] = *(LAS const s16x8*)(kl + kfoff + 32 * d0);
        LAS const unsigned char* vb = wl + vprev + trbase;
        const s16x8 V00 = cat8(tr_read(vb), tr_read(vb + 8 * PV64)), V01 = cat8(tr_read(vb + 16 * PV64), tr_read(vb + 24 * PV64));
        const s16x8 V10 = cat8(tr_read(vb + 64), tr_read(vb + 8 * PV64 + 64)), V11 = cat8(tr_read(vb + 16 * PV64 + 64), tr_read(vb + 24 * PV64 + 64));
        f32x16 Sx;
#pragma unroll
        for (int i = 0; i < 16; ++i) Sx[i] = 0.f;
        Sx = MFMA32(Kf[0], Qf[0], Sx); O0 = MFMA32(V00, Pp0, O0);
        Sx = MFMA32(Kf[1], Qf[1], Sx); O1 = MFMA32(V10, Pp0, O1);
        Sx = MFMA32(Kf[2], Qf[2], Sx); O0 = MFMA32(V01, Pp1, O0);
        Sx = MFMA32(Kf[3], Qf[3], Sx); O1 = MFMA32(V11, Pp1, O1);
        float P[16];
        if (fox) {
            const float off = clt + Doff;
            float tmax = -1e30f;
#pragma unroll
            for (int g = 0; g < 4; ++g) { const f32x4 ncs = *(LAS const f32x4*)(gl + 8 * g + 4 * hi);
#pragma unroll
                for (int e = 0; e < 4; ++e) P[4 * g + e] = fmaf(SC2, Sx[4 * g + e], ncs[e]); }
            if (diag) {
#pragma unroll
                for (int i = 0; i < 16; ++i) { const int sl = 8 * (i >> 2) + 4 * hi + (i & 3); if (sl > r) P[i] = -1e30f; } }
#pragma unroll
            for (int i = 0; i < 16; ++i) tmax = fmaxf(tmax, P[i]);
            tmax = xh_max(tmax) + off;
            if (__any(tmax > mrun)) {
                const float mnew = fmaxf(mrun, tmax), alpha = __builtin_amdgcn_exp2f(mrun - mnew); lsum *= alpha; mrun = mnew;
#pragma unroll
                for (int i = 0; i < 16; ++i) { O0[i] *= alpha; O1[i] *= alpha; } }
            const float msh = mrun - off; float ps = 0.f;
#pragma unroll
            for (int i = 0; i < 16; ++i) { P[i] = __builtin_amdgcn_exp2f(P[i] - msh); ps += P[i]; }
            lsum += ps;
            if (jt > 0 && ((jt - 1) >> 3) != (jt >> 3)) Doff += tot[bh * 8 + ((jt - 1) >> 3)];
        } else {
            float kp[16], gs[4], go[4]; float T = 1.f;
#pragma unroll
            for (int i = 0; i < 16; ++i) { const float ee = __builtin_amdgcn_exp2f(Sx[i]); const float sig = __builtin_amdgcn_rcpf(1.0f + ee); P[i] = sig; kp[i] = 1.0f - sig; }
            if (diag) {
#pragma unroll
                for (int i = 0; i < 16; ++i) { const int sl = 8 * (i >> 2) + 4 * hi + (i & 3); if (sl >= r) { P[i] = 0.f; kp[i] = 1.f; } } }
#pragma unroll
            for (int g = 0; g < 4; ++g) { gs[g] = (kp[4 * g] * kp[4 * g + 1]) * (kp[4 * g + 2] * kp[4 * g + 3]); T *= gs[g]; }
#pragma unroll
            for (int g = 0; g < 4; ++g) go[g] = xh_other(gs[g]);
            float above = Rsb;
#pragma unroll
            for (int g = 3; g >= 0; --g) {
                float suf = hi == 0 ? above * go[g] : above;
#pragma unroll
                for (int e = 3; e >= 0; --e) { const float a = P[4 * g + e] * suf; suf *= kp[4 * g + e]; P[4 * g + e] = a; }
                above *= gs[g] * go[g];
            }
            Rsb *= xh_prod(T);
        }
        Pp0 = pack8(P[0], P[1], P[2], P[3], P[4], P[5], P[6], P[7]); Pp1 = pack8(P[8], P[9], P[10], P[11], P[12], P[13], P[14], P[15]);
        if (!fox && __all(Rsb == 0.0f)) break;
    }
    { LAS const unsigned char* vb = wl + vlast + trbase;
      const s16x8 V00 = cat8(tr_read(vb), tr_read(vb + 8 * PV64)), V01 = cat8(tr_read(vb + 16 * PV64), tr_read(vb + 24 * PV64));
      const s16x8 V10 = cat8(tr_read(vb + 64), tr_read(vb + 8 * PV64 + 64)), V11 = cat8(tr_read(vb + 16 * PV64 + 64), tr_read(vb + 24 * PV64 + 64));
      O0 = MFMA32(V00, Pp0, O0); O1 = MFMA32(V10, Pp0, O1); O0 = MFMA32(V01, Pp1, O0); O1 = MFMA32(V11, Pp1, O1); }
    float inv = 1.0f;
    if (fox) { lsum = xh_sum(lsum); inv = __builtin_amdgcn_rcpf(lsum); }
    char* yb0 = (char*)(y + (size_t)b * S * D); const unsigned yo = (unsigned)(t * D + yoff + 4 * hi) * 2u;
#pragma unroll
    for (int g = 0; g < 4; ++g) {
        unsigned long long w0 = (unsigned long long)cvtpk(O0[4 * g] * inv, O0[4 * g + 1] * inv) | ((unsigned long long)cvtpk(O0[4 * g + 2] * inv, O0[4 * g + 3] * inv) << 32);
        unsigned long long w1 = (unsigned long long)cvtpk(O1[4 * g] * inv, O1[4 * g + 1] * inv) | ((unsigned long long)cvtpk(O1[4 * g + 2] * inv, O1[4 * g + 3] * inv) << 32);
        *(unsigned long long*)(yb0 + yo + 16 * g) = w0; *(unsigned long long*)(yb0 + yo + 64 + 16 * g) = w1; }
}
constexpr int PV128 = 272;
__device__ __forceinline__ void xattn_mfma_item(const bf16* qx, const bf16* kv, bf16* ox, LAS unsigned char* wl, int item, int lane) {
    const int head = item & 3, qblk = item >> 2;
    const int r = lane & 31, hi = lane >> 5;
    const int token = qblk * 32 + r, b = (qblk * 32) / S;
    s16x8 Qf[8];
    { const char* qb_ = (const char*)qx; const unsigned qo = (unsigned)(token * DX + head * 128 + 8 * hi) * 2u;
#pragma unroll
      for (int d0 = 0; d0 < 8; ++d0) Qf[d0] = *(const s16x8*)(qb_ + qo + 32 * d0); }
    f32x16 O[4];
#pragma unroll
    for (int k = 0; k < 4; ++k)
#pragma unroll
        for (int i = 0; i < 16; ++i) O[k][i] = 0.f;
    float mrun = -1e30f, lsum = 0.f;
    const int trbase = (4 * hi + ((lane >> 2) & 3)) * PV128 + (16 * ((lane >> 4) & 1) + 4 * (lane & 3)) * 2;
    const char* kvc = (const char*)(kv + (size_t)b * MEML * 1024);
    const unsigned kfo = (unsigned)(r * 1024 + head * 128 + 8 * hi) * 2u;
    const unsigned vlo = (unsigned)((lane >> 4) * 1024 + 512 + head * 128 + 8 * (lane & 15)) * 2u;
    s16x8 Kn[8]; v4u vn[8];
#pragma unroll
    for (int d0 = 0; d0 < 8; ++d0) Kn[d0] = *(const s16x8*)(kvc + kfo + 32 * d0);
#pragma unroll
    for (int i = 0; i < 8; ++i) vn[i] = *(const v4u*)(kvc + vlo + (size_t)(4 * i) * 2048);
    const float SCX = 0.08838834764831845f * 1.4426950408889634f;
    for (int jt = 0; jt < 8; ++jt) {
        f32x16 Sx;
#pragma unroll
        for (int i = 0; i < 16; ++i) Sx[i] = 0.f;
#pragma unroll
        for (int d0 = 0; d0 < 8; ++d0) Sx = MFMA32(Kn[d0], Qf[d0], Sx);
        { LAS unsigned char* dst = wl + (lane >> 4) * PV128 + 16 * (lane & 15);
#pragma unroll
          for (int i = 0; i < 8; ++i) *(LAS v4u*)(dst + 4 * i * PV128) = vn[i]; }
        if (jt < 7) { const char* tb = kvc + (size_t)((jt + 1) * 32) * 2048;
#pragma unroll
            for (int d0 = 0; d0 < 8; ++d0) Kn[d0] = *(const s16x8*)(tb + kfo + 32 * d0);
#pragma unroll
            for (int i = 0; i < 8; ++i) vn[i] = *(const v4u*)(tb + vlo + (size_t)(4 * i) * 2048); }
        float P[16]; float tmax = -1e30f;
#pragma unroll
        for (int i = 0; i < 16; ++i) { P[i] = Sx[i] * SCX; tmax = fmaxf(tmax, P[i]); }
        tmax = xh_max(tmax);
        if (__any(tmax > mrun)) { const float mnew = fmaxf(mrun, tmax), alpha = __builtin_amdgcn_exp2f(mrun - mnew); lsum *= alpha; mrun = mnew;
#pragma unroll
            for (int k = 0; k < 4; ++k)
#pragma unroll
                for (int i = 0; i < 16; ++i) O[k][i] *= alpha; }
        float ps = 0.f;
#pragma unroll
        for (int i = 0; i < 16; ++i) { P[i] = __builtin_amdgcn_exp2f(P[i] - mrun); ps += P[i]; }
        lsum += ps;
        const s16x8 Pf0 = pack8(P[0], P[1], P[2], P[3], P[4], P[5], P[6], P[7]), Pf1 = pack8(P[8], P[9], P[10], P[11], P[12], P[13], P[14], P[15]);
        LAS const unsigned char* vb = wl + trbase;
#pragma unroll
        for (int k = 0; k < 4; ++k) {
            const s16x8 Va = cat8(tr_read(vb + 64 * k), tr_read(vb + 8 * PV128 + 64 * k)), Vb = cat8(tr_read(vb + 16 * PV128 + 64 * k), tr_read(vb + 24 * PV128 + 64 * k));
            O[k] = MFMA32(Va, Pf0, O[k]); O[k] = MFMA32(Vb, Pf1, O[k]); }
    }
    lsum = xh_sum(lsum); const float inv = __builtin_amdgcn_rcpf(lsum);
    char* oc = (char*)ox; const unsigned oo = (unsigned)(token * DX + head * 128 + 4 * hi) * 2u;
#pragma unroll
    for (int k = 0; k < 4; ++k)
#pragma unroll
        for (int g = 0; g < 4; ++g) {
            const unsigned long long w0 = (unsigned long long)cvtpk(O[k][4 * g] * inv, O[k][4 * g + 1] * inv) | ((unsigned long long)cvtpk(O[k][4 * g + 2] * inv, O[k][4 * g + 3] * inv) << 32);
            *(unsigned long long*)(oc + oo + 64 * k + 16 * g) = w0; }
}

constexpr int ML_WSTRIDE = 18432, ML_RAWK = 0, ML_RAWQ = 5056, ML_WK = 5056, ML_V = 10112, ML_CW = 14720, ML_EB = 16768, ML_NL = 16896, ML_NW = 17152, ML_ITEM_F = 4224;
template <bool OUT>
__device__ __forceinline__ void mlstm_item(const bf16* u, bf16* y, float* scratch, const float* convw, const float* ib, const float* fbias, const float* normw, LAS unsigned char* wl, int bh, int c, int lane) {
    const int b = bh / 6, h = bh % 6, r = lane & 31, hi = lane >> 5;
    const bf16* ub = u + (size_t)b * S * NU;
    LAS float* cw = (LAS float*)(wl + ML_CW); LAS float* eb = (LAS float*)(wl + ML_EB); LAS float* nl = (LAS float*)(wl + ML_NL); LAS float* nwl = (LAS float*)(wl + ML_NW);
    for (int i = lane; i < 512; i += 64) { const int tap = i >> 7, ch = i & 127; cw[i] = convw[tap * 768 + (ch < 64 ? (64 * h + ch) : (384 + 64 * h + (ch - 64)))]; }
    if (OUT) nwl[lane] = normw[h * 64 + lane];
    const float ibh = ib[h], fbh = fbias[h];
    f32x16 X[2][2];
#pragma unroll
    for (int a = 0; a < 2; ++a)
#pragma unroll
        for (int bb = 0; bb < 2; ++bb)
#pragma unroll
            for (int i = 0; i < 16; ++i) X[a][bb][i] = 0.f;
    float nk = 0.f, Gsum = 0.f;
    if (OUT) {
        float dec = 1.f;
        for (int cp = c - 1; cp >= 0; --cp) {
            const float* s0 = scratch + (size_t)(bh * 16 + cp) * ML_ITEM_F;
            f32x16 v0[4];
#pragma unroll
            for (int blk = 0; blk < 4; ++blk) v0[blk] = *(const f32x16*)(s0 + blk * 1024 + lane * 16);
            const float n0 = s0[4096 + lane], g0 = s0[4160];
#pragma unroll
            for (int blk = 0; blk < 4; ++blk) X[blk >> 1][blk & 1] += v0[blk] * dec;
            nk += dec * n0;
            dec *= __expf(g0);
        }
    }
    nl[lane] = nk;
    const int trP = (4 * hi + ((lane >> 2) & 3)) * 144 + (16 * ((lane >> 4) & 1) + 4 * (lane & 3)) * 2;
    const int trN = (8 * hi + ((lane >> 2) & 3)) * 144 + (16 * ((lane >> 4) & 1) + 4 * (lane & 3)) * 2;
    for (int j = 0; j < 4; ++j) {
        const int t0 = c * 128 + j * 32, t = t0 + r;
        const bf16* trow = ub + (size_t)t * NU;
        const unsigned short gfr = trow[3468 + h], gir = trow[3462 + h];
        v4u vv[4], rk[5], rq[5];
        { const bf16* vrow = ub + (size_t)(t0 + (lane >> 3)) * NU + 2688 + 64 * h + 8 * (lane & 7);
#pragma unroll
          for (int i = 0; i < 4; ++i) vv[i] = *(const v4u*)(vrow + (size_t)(8 * i) * NU); }
#pragma unroll
        for (int i = 0; i < 5; ++i) { const int p = lane + 64 * i, row = p >> 3, ch8 = p & 7, tt = t0 - 3 + row; const bool ok = (p < 280) && (tt >= 0);
            const bf16* src = ub + (size_t)(ok ? tt : 0) * NU + 1920 + 64 * h + 8 * ch8;
            rk[i] = ok ? *(const v4u*)(src + 384) : (v4u){0u, 0u, 0u, 0u};
            if (OUT) rq[i] = ok ? *(const v4u*)(src) : (v4u){0u, 0u, 0u, 0u}; }
#pragma unroll
        for (int i = 0; i < 5; ++i) { const int p = lane + 64 * i, row = p >> 3, ch8 = p & 7;
            if (p < 280) { *(LAS v4u*)(wl + ML_RAWK + row * 144 + 16 * ch8) = rk[i]; if (OUT) *(LAS v4u*)(wl + ML_RAWQ + row * 144 + 16 * ch8) = rq[i]; } }
        { LAS unsigned char* dst = wl + ML_V + (lane >> 3) * 144 + 16 * (lane & 7);
#pragma unroll
          for (int i = 0; i < 4; ++i) *(LAS v4u*)(dst + 8 * i * 144) = vv[i]; }
        float bl = log_sigmoid_f(bf2f(gfr) + fbh); const float ii = bf2f(gir) + ibh;
#pragma unroll
        for (int o = 1; o < 32; o <<= 1) { const float v = __shfl_up(bl, o, 32); if (r >= o) bl += v; }
        const float g = __shfl(bl, 31, 32), es = ii - bl;
        eb[r] = es; Gsum += g;
        s16x8 Kf[4], Qf[4]; float dq = 0.f;
#pragma unroll
        for (int part = (OUT ? 0 : 1); part < 2; ++part) {
            LAS unsigned char* raw = wl + (part ? ML_RAWK : ML_RAWQ);
            const float w0 = cw[part * 64 + lane], w1 = cw[128 + part * 64 + lane], w2 = cw[256 + part * 64 + lane], w3 = cw[384 + part * 64 + lane];
            const float sc = part ? 0.125f : 1.0f;
            float xv[35];
#pragma unroll
            for (int i = 0; i < 35; ++i) xv[i] = bf2f(*(LAS const unsigned short*)(raw + i * 144 + 2 * lane));
#pragma unroll
            for (int i = 0; i < 16; ++i) {
                const float a0 = w0 * xv[2 * i] + w1 * xv[2 * i + 1] + w2 * xv[2 * i + 2] + w3 * xv[2 * i + 3];
                const float a1 = w0 * xv[2 * i + 1] + w1 * xv[2 * i + 2] + w2 * xv[2 * i + 3] + w3 * xv[2 * i + 4];
                const unsigned pk = cvtpk(a0 * sc * __builtin_amdgcn_rcpf(1.0f + __expf(-a0)), a1 * sc * __builtin_amdgcn_rcpf(1.0f + __expf(-a1)));
                *(LAS unsigned short*)(raw + (2 * i) * 144 + 2 * lane) = (unsigned short)pk; *(LAS unsigned short*)(raw + (2 * i + 1) * 144 + 2 * lane) = (unsigned short)(pk >> 16); }
#pragma unroll
            for (int f = 0; f < 4; ++f) {
                const unsigned long long p0 = *(LAS const unsigned long long*)(raw + r * 144 + (16 * f + 4 * hi) * 2), p1 = *(LAS const unsigned long long*)(raw + r * 144 + (16 * f + 8 + 4 * hi) * 2);
                const v4u fw = {(unsigned)p0, (unsigned)(p0 >> 32), (unsigned)p1, (unsigned)(p1 >> 32)};
                if (part) Kf[f] = __builtin_bit_cast(s16x8, fw); else Qf[f] = __builtin_bit_cast(s16x8, fw);
                if (OUT && part == 0) { const f32x4 n0 = *(LAS const f32x4*)(nl + 16 * f + 4 * hi), n1 = *(LAS const f32x4*)(nl + 16 * f + 8 + 4 * hi);
                    dq += (lo_f(fw.x) * n0[0] + hi_f(fw.x) * n0[1]) + (lo_f(fw.y) * n0[2] + hi_f(fw.y) * n0[3]) + (lo_f(fw.z) * n1[0] + hi_f(fw.z) * n1[1]) + (lo_f(fw.w) * n1[2] + hi_f(fw.w) * n1[3]); } }
        }
        if (OUT) {
            f32x16 Sx;
#pragma unroll
            for (int i = 0; i < 16; ++i) Sx[i] = 0.f;
#pragma unroll
            for (int f = 0; f < 4; ++f) Sx = MFMA32(Kf[f], Qf[f], Sx);
            float P[16]; float den = 0.f;
#pragma unroll
            for (int g4 = 0; g4 < 4; ++g4) { const f32x4 e4 = *(LAS const f32x4*)(eb + 8 * g4 + 4 * hi);
#pragma unroll
                for (int e = 0; e < 4; ++e) { const int sl = 8 * g4 + 4 * hi + e; const float d = (sl <= r) ? __expf(bl + e4[e]) : 0.f; P[4 * g4 + e] = Sx[4 * g4 + e] * d; den += P[4 * g4 + e]; } }
            den = xh_sum(den); dq = xh_sum(dq);
            const float ebt = __expf(bl);
            const float inv = 1.0f / fmaxf(fabsf(den + ebt * dq), 1.0f);
            const s16x8 Pf0 = pack8(P[0], P[1], P[2], P[3], P[4], P[5], P[6], P[7]), Pf1 = pack8(P[8], P[9], P[10], P[11], P[12], P[13], P[14], P[15]);
            unsigned long long ow[8];
#pragma unroll
            for (int vb = 0; vb < 2; ++vb)
#pragma unroll
                for (int g4 = 0; g4 < 4; ++g4) ow[4 * vb + g4] = *(const unsigned long long*)(trow + 3072 + 64 * h + 32 * vb + 8 * g4 + 4 * hi);
            f32x16 H[2]; float ms = 0.f;
#pragma unroll
            for (int vb = 0; vb < 2; ++vb) {
                LAS const unsigned char* vp = wl + ML_V + trP + 64 * vb;
                f32x16 Zi, Zx;
#pragma unroll
                for (int i = 0; i < 16; ++i) { Zi[i] = 0.f; Zx[i] = 0.f; }
                Zi = MFMA32(cat8(tr_read(vp), tr_read(vp + 8 * 144)), Pf0, Zi); Zi = MFMA32(cat8(tr_read(vp + 16 * 144), tr_read(vp + 24 * 144)), Pf1, Zi);
#pragma unroll
                for (int kb = 0; kb < 2; ++kb)
#pragma unroll
                    for (int sp = 0; sp < 2; ++sp) { const f32x16& xx = X[kb][vb];
                        const s16x8 xa = pack8(xx[8 * sp], xx[8 * sp + 1], xx[8 * sp + 2], xx[8 * sp + 3], xx[8 * sp + 4], xx[8 * sp + 5], xx[8 * sp + 6], xx[8 * sp + 7]);
                        Zx = MFMA32(xa, Qf[2 * kb + sp], Zx); }
#pragma unroll
                for (int i = 0; i < 16; ++i) { const float hv = (Zi[i] + ebt * Zx[i]) * inv; H[vb][i] = hv; ms += hv * hv; }
            }
            ms = xh_sum(ms);
            const float rs = rsqrtf(ms * (1.0f / 64.0f) + 1e-6f);
            bf16* yrow = y + ((size_t)b * S + t) * D + 640 + 64 * h;
#pragma unroll
            for (int vb = 0; vb < 2; ++vb)
#pragma unroll
                for (int g4 = 0; g4 < 4; ++g4) { const int v = 32 * vb + 8 * g4 + 4 * hi;
                    const unsigned o0 = (unsigned)ow[4 * vb + g4], o1 = (unsigned)(ow[4 * vb + g4] >> 32);
                    const f32x4 w4 = *(LAS const f32x4*)(nwl + v);
                    const float y0 = H[vb][4 * g4] * rs * w4[0] * sigmoid_f(lo_f(o0)), y1 = H[vb][4 * g4 + 1] * rs * w4[1] * sigmoid_f(hi_f(o0));
                    const float y2 = H[vb][4 * g4 + 2] * rs * w4[2] * sigmoid_f(lo_f(o1)), y3 = H[vb][4 * g4 + 3] * rs * w4[3] * sigmoid_f(hi_f(o1));
                    *(unsigned long long*)(yrow + v) = (unsigned long long)cvtpk(y0, y1) | ((unsigned long long)cvtpk(y2, y3) << 32); }
        }
        { const float wsc = __expf(g + es), eg = __expf(g);
#pragma unroll
          for (int f = 0; f < 4; ++f) { const v4u kw = __builtin_bit_cast(v4u, Kf[f]);
#pragma unroll
              for (int e = 0; e < 2; ++e) { const unsigned k0 = e ? kw.z : kw.x, k1 = e ? kw.w : kw.y; const int ch = 16 * f + 8 * e + 4 * hi;
                  *(LAS unsigned long long*)(wl + ML_WK + r * 144 + ch * 2) = (unsigned long long)cvtpk(lo_f(k0) * wsc, hi_f(k0) * wsc) | ((unsigned long long)cvtpk(lo_f(k1) * wsc, hi_f(k1) * wsc) << 32); } }
#pragma unroll
          for (int kb = 0; kb < 2; ++kb)
#pragma unroll
              for (int vb = 0; vb < 2; ++vb) { X[kb][vb] *= eg;
#pragma unroll
                  for (int sp = 0; sp < 2; ++sp) { LAS const unsigned char* kp = wl + ML_WK + trN + 16 * sp * 144 + 64 * kb; LAS const unsigned char* vp = wl + ML_V + trN + 16 * sp * 144 + 64 * vb;
                      X[kb][vb] = MFMA32(cat8(tr_read(kp), tr_read(kp + 4 * 144)), cat8(tr_read(vp), tr_read(vp + 4 * 144)), X[kb][vb]); } }
          float dn = 0.f;
#pragma unroll 8
          for (int s2 = 0; s2 < 32; ++s2) dn += bf2f(*(LAS const unsigned short*)(wl + ML_WK + s2 * 144 + 2 * lane));
          nk = eg * nk + dn; nl[lane] = nk; }
    }
    if (!OUT) {
        float* sp = scratch + (size_t)(bh * 16 + c) * ML_ITEM_F;
#pragma unroll
        for (int blk = 0; blk < 4; ++blk) {
#pragma unroll
            for (int i = 0; i < 8; ++i) st_wt64(sp + blk * 1024 + lane * 16 + 2 * i, X[blk >> 1][blk & 1][2 * i], X[blk >> 1][blk & 1][2 * i + 1]); }
        st_wt32(sp + 4096 + lane, nk);
        if (lane == 0) st_wt32(sp + 4160, Gsum);
    }
}

struct Args { const float* in[20]; float* out; unsigned char* ws; };
#define GEMM_PHASE(EpiT, SchedT, g, Sc, E) pg8::gemm_phase<EpiT, SchedT, true, true>(L, g, Sc, E)

__global__ void __launch_bounds__(512, 2) mega_fwd(Args a) {
    extern __shared__ __attribute__((aligned(16))) unsigned char lds[];
    LAS unsigned char* L = (LAS unsigned char*)lds;
    const int tid = threadIdx.x, lane = tid & 63, wave = __builtin_amdgcn_readfirstlane(tid >> 6);
    const int G = gridDim.x, bx = blockIdx.x;
    const int gw = bx * 8 + wave, NGW = G * 8;
    unsigned char* ws = a.ws;
    const float* x = a.in[0]; const float* mem = a.in[1];
    float* out = a.out;
    float* ssq = (float*)(ws + WS_SSQP); float* ssqm = (float*)(ws + WS_SSQP + 7 * MiB);
    bf16* ub = (bf16*)(ws + WS_U); bf16* actb = (bf16*)(ws + WS_U); bf16* yb = (bf16*)(ws + WS_Y); bf16* qxb = (bf16*)(ws + WS_QX); bf16* oxb = (bf16*)(ws + WS_OX);
    bf16* hb = (bf16*)(ws + WS_HB); bf16* memb = (bf16*)(ws + WS_MEMB); bf16* kvb = (bf16*)(ws + WS_KV);

    volatile LAS unsigned* bst = (volatile LAS unsigned*)(L + LDS_BARST); if (tid < 2) bst[tid] = 0u;
    __syncthreads();
    (void)xcd_barrier_post((unsigned*)(a.ws + WS_BAR), bst);
    {
        LAS float* tile = (LAS float*)L;
        constexpr int I_IN = 16 * 14, I_OUT = 16 * 4, I_XQ = 16 * 2, I_XKV = 16 * 4, I_XO = 8 * 4, I_GU = 16 * 22, I_DN = 44 * 4;
        constexpr int I_LAYER = I_IN + I_OUT + I_XQ + I_XKV + I_XO + I_GU + I_DN;
        for (int it = bx; it < 2 * I_LAYER; it += G) {
            const int l = it / I_LAYER; int r = it % I_LAYER;
            unsigned char* wl = ws + WS_W + (size_t)l * W_LAYER;
            if (r < I_IN) { conv_block_item(a.in[3] + (size_t)l * 1024 * 3474, nullptr, 3474, 1024, 1, a.in[2] + l * 1024, (bf16*)(wl + OW_IN), tile, r / 14, r % 14, tid); continue; } r -= I_IN;
            if (r < I_OUT) { conv_block_item(a.in[9] + (size_t)l * 1024 * 1024, nullptr, 1024, 1024, 0, nullptr, (bf16*)(wl + OW_OUT), tile, r / 4, r % 4, tid); continue; } r -= I_OUT;
            if (r < I_XQ) { conv_block_item(a.in[12] + (size_t)l * 1024 * 512, nullptr, 512, 1024, 0, a.in[10] + l * 1024, (bf16*)(wl + OW_XQ), tile, r / 2, r % 2, tid); continue; } r -= I_XQ;
            if (r < I_XKV) { conv_block_item(a.in[13] + (size_t)l * 1024 * 1024, nullptr, 1024, 1024, 0, a.in[11] + l * 1024, (bf16*)(wl + OW_XKV), tile, r / 4, r % 4, tid); continue; } r -= I_XKV;
            if (r < I_XO) { conv_block_item(a.in[14] + (size_t)l * 512 * 1024, nullptr, 1024, 512, 0, nullptr, (bf16*)(wl + OW_XO), tile, r / 4, r % 4, tid); continue; } r -= I_XO;
            if (r < I_GU) { conv_block_item(a.in[16] + (size_t)l * 1024 * DFF, a.in[17] + (size_t)l * 1024 * DFF, DFF, 1024, 2, a.in[15] + l * 1024, (bf16*)(wl + OW_GU), tile, r / 22, r % 22, tid); continue; } r -= I_GU;
            conv_block_item(a.in[18] + (size_t)l * DFF * 1024, nullptr, 1024, DFF, 0, nullptr, (bf16*)(wl + OW_DN), tile, r / 4, r % 4, tid);
        }
        for (int m = gw; m < M; m += NGW) row_to_bf16_ssq(x + (size_t)m * D, hb + (size_t)m * D, ssq + (size_t)m * 16, lane);
        for (int m = gw; m < MROWS; m += NGW) row_to_bf16_ssq(mem + (size_t)m * D, memb + (size_t)m * D, ssqm + (size_t)m * 16, lane);
        { float* prm = (float*)(ws + WS_PRM);
          for (int i = bx * 512 + tid; i < 2 * 8192 + 1024; i += G * 512) {
              float v = 0.f;
              if (i >= 2 * 8192) v = a.in[19][i - 2 * 8192];
              else { const int l = i >> 13, o = i & 8191;
                  if (o < 6) v = a.in[4][l * 6 + o]; else if (o >= 8 && o < 14) v = a.in[6][l * 6 + o - 8]; else if (o >= 16 && o < 22) v = a.in[7][l * 6 + o - 16];
                  else if (o >= 64 && o < 448) v = a.in[8][l * 384 + o - 64]; else if (o >= 512 && o < 3584) v = a.in[5][l * 3072 + o - 512]; }
              prm[i] = v; } }
    }
#define XBAR() do { XcdBarrier xb_; xb_.bar = (unsigned*)(ws + WS_BAR); xb_.x = xb_xcc_id(); xb_.st = (volatile LAS unsigned*)(L + LDS_BARST); xcd_barrier(xb_); } while (0)
    { unsigned char* ws = a.ws; XBAR(); }
    for (int ph = 0; ph < 16; ++ph) {
        const int l = ph >> 3, k = ph & 7;
        size_t zoff = 0; asm volatile("" : "+s"(zoff)); unsigned char* ws = a.ws + zoff;
        const unsigned char* wl = ws + WS_W + (size_t)l * W_LAYER;
        float* ssq = (float*)(ws + WS_SSQP); float* ssqm = (float*)(ws + WS_SSQP + 7 * MiB);
        bf16* ub = (bf16*)(ws + WS_U); bf16* actb = (bf16*)(ws + WS_U); bf16* yb = (bf16*)(ws + WS_Y); bf16* qxb = (bf16*)(ws + WS_QX); bf16* oxb = (bf16*)(ws + WS_OX);
        bf16* hb = (bf16*)(ws + WS_HB); bf16* memb = (bf16*)(ws + WS_MEMB); bf16* kvb = (bf16*)(ws + WS_KV);
        int tid_p = threadIdx.x; asm volatile("" : "+v"(tid_p)); const int lane = tid_p & 63, wave = __builtin_amdgcn_readfirstlane(tid_p >> 6), gw = bx * 8 + wave;
        if (k == 0 || k == 3) {
            const int j0 = (ph == 0) ? 0 : 2;
            for (int j = j0; j < 3; ++j) {
                pg8::Gemm g; pg8::EpiScaleBf16 E; int off = 0;
                if (j < 2) { g = pg8::Gemm{memb, (const bf16*)(ws + WS_W + (size_t)j * W_LAYER + OW_XKV), MROWS, 1024, 1024}; E = pg8::EpiScaleBf16{kvb + (size_t)j * MROWS * 1024, 1024, ssqm}; off = 128 + 32 * j; }
                else if (k == 0) { g = pg8::Gemm{hb, (const bf16*)(wl + OW_IN), M, NU, 1024}; E = pg8::EpiScaleBf16{ub, NU, ssq + (size_t)(3 * l) * M * 16}; }
                else { g = pg8::Gemm{hb, (const bf16*)(wl + OW_XQ), M, DX, 1024}; E = pg8::EpiScaleBf16{qxb, DX, ssq + (size_t)(3 * l + 1) * M * 16}; }
                pg8::OffsetOrder Sc; Sc.init(g.M, g.N, G, bx, off);
                GEMM_PHASE(pg8::EpiScaleBf16, pg8::OffsetOrder, g, Sc, E);
            }
        } else if (k == 2 || k == 5 || k == 7) {
            pg8::Gemm g; pg8::EpiResid E;
            if (k == 2) { g = pg8::Gemm{yb, (const bf16*)(wl + OW_OUT), M, 1024, 1024}; E = pg8::EpiResid{hb, ssq + (size_t)(3 * l + 1) * M * 16}; }
            else if (k == 5) { g = pg8::Gemm{oxb, (const bf16*)(wl + OW_XO), M, 1024, DX}; E = pg8::EpiResid{hb, ssq + (size_t)(3 * l + 2) * M * 16}; }
            else { g = pg8::Gemm{actb, (const bf16*)(wl + OW_DN), M, 1024, DFF}; E = pg8::EpiResid{hb, ssq + (size_t)(3 * l + 3) * M * 16}; }
            pg8::StaticOrder Sc; Sc.init(g.M, g.N, G, bx);
            GEMM_PHASE(pg8::EpiResid, pg8::StaticOrder, g, Sc, E);
        } else if (k == 6) {
            pg8::Gemm g{hb, (const bf16*)(wl + OW_GU), M, 2 * DFF, 1024}; pg8::StaticOrder Sc; Sc.init(M, 2 * DFF, G, bx);
            pg8::EpiSwiglu E{actb, DFF, ssq + (size_t)(3 * l + 2) * M * 16};
            GEMM_PHASE(pg8::EpiSwiglu, pg8::StaticOrder, g, Sc, E);
        } else if (k == 1) {
            const float* prm = (const float*)(ws + WS_PRM) + l * 8192;
            float* mscr = out;
            float* fcl = out + 14 * MiB / 4; float* ftot = out + 15 * MiB / 4;
            const int xcd0 = (int)(xb_xcc_id() & 7u); unsigned okmask = 0u;
            for (int qi = 0; qi < 8; ++qi) {
            const int xcd = (xcd0 + qi) & 7;
            unsigned* ctr = (unsigned*)(ws + WS_BAR + 14336) + 16 * (l * 8 + xcd); unsigned* done = (unsigned*)(ws + WS_BAR + 15360) + 16 * (l * 8 + xcd);
            for (;;) {
                int it = 0; if (lane == 0) it = (int)atomicAdd(ctr, 1u); it = __builtin_amdgcn_readfirstlane(it);
                if (it >= 874) break;
                if (it < 138) {
                    if (it >= 48) mlstm_item<false>(ub, yb, mscr, prm + 512, prm + 8, prm + 16, prm + 64, L + wave * ML_WSTRIDE, xcd + 8 * ((it - 48) / 15), (it - 48) % 15, lane);
                    else fox_cumsum_item(ub, prm, fcl, ftot, (xcd + 8 * (it >> 3)) * 8 + (it & 7), lane);
                    asm volatile("s_waitcnt vmcnt(0)" ::: "memory");
                    if (lane == 0) atomicAdd(done + (it >= 48 ? 8 : 0), 1u);
                } else {
                    const bool isc = (it >= 266 && it < 362), issb = (it >= 362 && it < 618), isfox = !isc && !issb;
                    if (isfox && !((okmask >> xcd) & 1u)) { unsigned sp = 0u;
                        while (__hip_atomic_load(done, __ATOMIC_RELAXED, __HIP_MEMORY_SCOPE_AGENT) < 48u) { __builtin_amdgcn_s_sleep(4); if (++sp > (1u << 21)) break; }
                        __builtin_amdgcn_fence(__ATOMIC_ACQUIRE, "agent"); okmask |= 1u << xcd; }
                    if (isc && !((okmask >> (8 + xcd)) & 1u)) { unsigned sp = 0u;
                        while (__hip_atomic_load(done + 8, __ATOMIC_RELAXED, __HIP_MEMORY_SCOPE_AGENT) < 90u) { __builtin_amdgcn_s_sleep(4); if (++sp > (1u << 21)) break; }
                        __builtin_amdgcn_fence(__ATOMIC_ACQUIRE, "agent"); okmask |= 1u << (8 + xcd); }
                    if (isc) { const int ci = it - 266; mlstm_item<true>(ub, yb, mscr, prm + 512, prm + 8, prm + 16, prm + 64, L + wave * ML_WSTRIDE, xcd + 8 * (ci >> 4), 15 - (ci & 15), lane); }
                    else { int aitem; if (issb) { const int ai = it - 362; aitem = (ai >> 2) * 80 + 48 + xcd + 8 * (ai & 3); } else { const int ai = (it < 266) ? it - 138 : it - 490; aitem = (ai / 6) * 80 + xcd + 8 * (ai % 6); }
                        attn_mfma_item(ub, yb, fcl, ftot, L + wave * ML_WSTRIDE, aitem, lane); }
                }
            }
            }
        } else {
            for (int it = gw; it < 2048; it += NGW) xattn_mfma_item(qxb, kvb + (size_t)l * MROWS * 1024, oxb, L + wave * 16384, it, lane);
        }
        XBAR();
    }
    {
        int tid_f = threadIdx.x; asm volatile("" : "+v"(tid_f)); const int lane = tid_f & 63, gw = bx * 8 + __builtin_amdgcn_readfirstlane(tid_f >> 6);
        const float* fw = (const float*)(a.ws + WS_PRM) + 2 * 8192; const float* sq = (const float*)(a.ws + WS_SSQP) + (size_t)6 * M * 16;
        const bf16* hbf = (const bf16*)(a.ws + WS_HB);
        for (int m = gw; m < M; m += NGW) {
            float sm = 0.f; { const f32x4* qp = (const f32x4*)(sq + (size_t)m * 16); const f32x4 q0 = qp[0], q1 = qp[1], q2 = qp[2], q3 = qp[3];
              sm = ((((q0[0] + q0[1]) + (q0[2] + q0[3])) + ((q1[0] + q1[1]) + (q1[2] + q1[3]))) + (((q2[0] + q2[1]) + (q2[2] + q2[3])) + ((q3[0] + q3[1]) + (q3[2] + q3[3])))); }
            const float rs = rsqrtf(sm * (1.0f / 1024.0f) + 1e-6f);
            const unsigned long long* hp = (const unsigned long long*)(hbf + (size_t)m * D) + lane; f32x4* rp = (f32x4*)(out + (size_t)m * D) + lane; const f32x4* wp = (const f32x4*)fw + lane;
#pragma unroll
            for (int j = 0; j < 4; ++j) { const unsigned long long hw = hp[64 * j]; const unsigned h0 = (unsigned)hw, h1 = (unsigned)(hw >> 32); const f32x4 w = wp[64 * j];
                f32x4 v = {lo_f(h0), hi_f(h0), lo_f(h1), hi_f(h1)}; v = v * rs * w; rp[64 * j] = v; }
        }
    }
}

extern "C" void kernel_launch(void* const* d_in, const int* in_sizes, int n_in, void* d_out, int out_size, void* d_ws, size_t ws_size, hipStream_t stream) {
    static int grid = 0;
    if (grid == 0) {
        if (n_in != 20 || out_size != M * D || ws_size < WS_END) { fprintf(stderr, "kernel_launch: unexpected shapes (n_in %d out %d ws %zu)\n", n_in, out_size, ws_size); grid = -1; return; }
        int dev = 0, cus = 0, per_cu = 0;
        hipGetDevice(&dev); hipDeviceGetAttribute(&cus, hipDeviceAttributeMultiprocessorCount, dev);
        if (hipFuncSetAttribute((const void*)mega_fwd, hipFuncAttributeMaxDynamicSharedMemorySize, LDS_BYTES) != hipSuccess) { fprintf(stderr, "kernel_launch: hipFuncSetAttribute failed\n"); grid = -1; return; }
        if (hipOccupancyMaxActiveBlocksPerMultiprocessor(&per_cu, (const void*)mega_fwd, 512, LDS_BYTES) != hipSuccess || per_cu < 1) { fprintf(stderr, "kernel_launch: occupancy query says %d\n", per_cu); (void)hipGetLastError(); per_cu = 1; }
        grid = cus * per_cu;
    }
    if (grid < 0) return;
    Args a{};
    for (int i = 0; i < 20; ++i) a.in[i] = (const float*)d_in[i];
    a.out = (float*)d_out; a.ws = (unsigned char*)d_ws;
    if (hipMemsetAsync((char*)d_ws + WS_BAR, 0, BAR_BYTES, stream) != hipSuccess) { fprintf(stderr, "kernel_launch: memset of the barrier words failed\n"); return; }
    void* args[] = {&a};
    hipError_t e = hipLaunchCooperativeKernel((const void*)mega_fwd, dim3(grid), dim3(512), args, LDS_BYTES, stream);
    if (e != hipSuccess) fprintf(stderr, "kernel_launch: cooperative launch failed: %s (grid %d)\n", hipGetErrorString(e), grid);
}
```

```cpp
#include <hip/hip_runtime.h>
#include <hip/hip_cooperative_groups.h>
#include <cstdio>
#include <cstdint>
#include <cmath>
namespace cg = cooperative_groups;
namespace pg8 {
#define PG8_LAS __attribute__((address_space(3)))
typedef unsigned short bf16_t;
typedef short bf16x8 __attribute__((ext_vector_type(8)));
typedef float f32x4 __attribute__((ext_vector_type(4)));
typedef unsigned u32x4 __attribute__((ext_vector_type(4)));
constexpr int BM = 256, BK = 64, HALF = 128, HTB = HALF * BK * 2  , STAGE_BYTES = 8 * HTB, NXCD = 8, WGM = 4;

__host__ __device__ __forceinline__ int lds_byte(int r, int c) { const int st = (r >> 4) * 2 + (c >> 5), rr = r & 15, cc = c & 31, ob = rr * 64 + cc * 2; return st * 1024 + (ob ^ (((ob >> 9) & 1) << 5)); }
__host__ __device__ __forceinline__ void stage_rc(int b, int& R, int& C) { const int st = b / 1024, sb = b % 1024, swz = sb ^ (((sb >> 9) & 1) << 5); R = (st >> 1) * 16 + swz / 64; C = (st & 1) * 32 + (swz % 64) / 2; }
__host__ __device__ __forceinline__ int perm32(int rho) { const int n = rho >> 4, i = rho & 15; return 8 * (i >> 2) + 4 * n + (i & 3); }

struct Unit { int pm, pn; };
struct Gemm { const bf16_t* A; const bf16_t* Bt; int M, N, K; };

struct StaticOrder {
    int nM, nN, nwg, G, c;
    __host__ __device__ void init(int M, int N, int G_, int c_) { nM = M / BM; nN = N / BM; nwg = nM * nN; G = G_; c = c_; }
    __host__ __device__ bool next(int i, Unit& u) const {
        const long L = (long)i * G + c; if (L >= nwg) return false;
        int wgid = (int)L; { const int q = nwg / NXCD, r = nwg % NXCD, xcd = wgid % NXCD, off = wgid / NXCD; wgid = (xcd < r ? xcd * (q + 1) : r * (q + 1) + (xcd - r) * q) + off; }
        const int nig = WGM * nN, gid = wgid / nig, fm = gid * WGM, gsz = (nM - fm) < WGM ? (nM - fm) : WGM;
        u.pm = fm + ((wgid % nig) % gsz); u.pn = (wgid % nig) / gsz; return true;
    }
    __device__ __forceinline__ void a_ready(const Unit&) const {}
    __device__ __forceinline__ void done(const Unit&) const {}
};

__device__ __forceinline__ unsigned cvt_pk_bf16(float lo, float hi) { unsigned r; asm volatile("v_cvt_pk_bf16_f32 %0, %1, %2" : "=v"(r) : "v"(lo), "v"(hi)); return r; }
typedef float f32x2 __attribute__((ext_vector_type(2)));
struct OffsetOrder {
    StaticOrder b;
    __device__ void init(int M, int N, int G, int c, int off) { b.init(M, N, G, (c + G - (off % G)) % G); }
    __device__ bool next(int i, Unit& u) const { return b.next(i, u); }
    __device__ __forceinline__ void a_ready(const Unit&) const {}
    __device__ __forceinline__ void done(const Unit&) const {}
};
struct EpiScaleBf16 {
    static constexpr bool PERM = true, AFTER_DRAIN = false;
    bf16_t* O; int ldc; const float* ssq;
    __device__ __forceinline__ void operator()(const f32x4 (&acc)[2][2][4][2], const Unit& u, int wr, int wc, int fr, int fq) const {
        const int row0 = u.pm * BM + wr * 64 + fr, col0 = u.pn * BM + wc * 32 + 8 * fq;
#pragma unroll
        for (int ai = 0; ai < 2; ++ai)
#pragma unroll
            for (int m = 0; m < 4; ++m) { const int row = row0 + ai * HALF + m * 16; const f32x4 q0 = *(const f32x4*)(ssq + (size_t)row * 16), q1 = *(const f32x4*)(ssq + (size_t)row * 16 + 4), q2 = *(const f32x4*)(ssq + (size_t)row * 16 + 8), q3 = *(const f32x4*)(ssq + (size_t)row * 16 + 12);
                const float rs = rsqrtf(((((q0[0] + q0[1]) + (q0[2] + q0[3])) + ((q1[0] + q1[1]) + (q1[2] + q1[3]))) + (((q2[0] + q2[1]) + (q2[2] + q2[3])) + ((q3[0] + q3[1]) + (q3[2] + q3[3])))) * (1.0f / 1024.0f) + 1e-6f);
                bf16_t* rowp = O + (size_t)row * ldc + col0;
#pragma unroll
                for (int bj = 0; bj < 2; ++bj) { const f32x4 v0 = acc[ai][bj][m][0] * rs, v1 = acc[ai][bj][m][1] * rs;
                    u32x4 w; w.x = cvt_pk_bf16(v0[0], v0[1]); w.y = cvt_pk_bf16(v0[2], v0[3]); w.z = cvt_pk_bf16(v1[0], v1[1]); w.w = cvt_pk_bf16(v1[2], v1[3]);
                    *(u32x4*)(rowp + bj * HALF) = w; } }
    }
};
struct EpiResid {
    static constexpr bool PERM = true, AFTER_DRAIN = false;
    bf16_t* hb; float* ssq;
    __device__ __forceinline__ void operator()(const f32x4 (&acc)[2][2][4][2], const Unit& u, int wr, int wc, int fr, int fq) const {
        const int row0 = u.pm * BM + wr * 64 + fr, col0 = u.pn * BM + wc * 32 + 8 * fq;
#pragma unroll
        for (int ai = 0; ai < 2; ++ai)
#pragma unroll
            for (int m = 0; m < 4; ++m) { const int row = row0 + ai * HALF + m * 16; const size_t off = (size_t)row * 1024 + col0; float part = 0.f;
#pragma unroll
                for (int bj = 0; bj < 2; ++bj) { const u32x4 b = *(const u32x4*)(hb + off + bj * HALF);
                    f32x4 v0 = acc[ai][bj][m][0], v1 = acc[ai][bj][m][1];
                    v0[0] += __uint_as_float(b.x << 16); v0[1] += __uint_as_float(b.x & 0xffff0000u); v0[2] += __uint_as_float(b.y << 16); v0[3] += __uint_as_float(b.y & 0xffff0000u);
                    v1[0] += __uint_as_float(b.z << 16); v1[1] += __uint_as_float(b.z & 0xffff0000u); v1[2] += __uint_as_float(b.w << 16); v1[3] += __uint_as_float(b.w & 0xffff0000u);
                    u32x4 w; w.x = cvt_pk_bf16(v0[0], v0[1]); w.y = cvt_pk_bf16(v0[2], v0[3]); w.z = cvt_pk_bf16(v1[0], v1[1]); w.w = cvt_pk_bf16(v1[2], v1[3]);
                    *(u32x4*)(hb + off + bj * HALF) = w;
                    part += (v0[0] * v0[0] + v0[1] * v0[1]) + (v0[2] * v0[2] + v0[3] * v0[3]) + (v1[0] * v1[0] + v1[1] * v1[1]) + (v1[2] * v1[2] + v1[3] * v1[3]); }
                part += __shfl_xor(part, 16); part += __shfl_xor(part, 32);
                if (fq == 0) ssq[(size_t)row * 16 + u.pn * 4 + wc] = part; }
    }
};
struct EpiSwiglu {
    static constexpr bool PERM = true, AFTER_DRAIN = false;
    bf16_t* O; int ldc; const float* ssq;
    __device__ __forceinline__ void operator()(const f32x4 (&acc)[2][2][4][2], const Unit& u, int wr, int wc, int fr, int fq) const {
        const int row0 = u.pm * BM + wr * 64 + fr, col0 = u.pn * HALF + wc * 32 + 8 * fq;
#pragma unroll
        for (int ai = 0; ai < 2; ++ai)
#pragma unroll
            for (int m = 0; m < 4; ++m) { const int row = row0 + ai * HALF + m * 16; const f32x4 q0 = *(const f32x4*)(ssq + (size_t)row * 16), q1 = *(const f32x4*)(ssq + (size_t)row * 16 + 4), q2 = *(const f32x4*)(ssq + (size_t)row * 16 + 8), q3 = *(const f32x4*)(ssq + (size_t)row * 16 + 12);
                const float rs = rsqrtf(((((q0[0] + q0[1]) + (q0[2] + q0[3])) + ((q1[0] + q1[1]) + (q1[2] + q1[3]))) + (((q2[0] + q2[1]) + (q2[2] + q2[3])) + ((q3[0] + q3[1]) + (q3[2] + q3[3])))) * (1.0f / 1024.0f) + 1e-6f);
                float a[8];
#pragma unroll
                for (int n = 0; n < 2; ++n)
#pragma unroll
                    for (int j = 0; j < 4; ++j) { const float g = acc[ai][0][m][n][j] * rs, up = acc[ai][1][m][n][j] * rs; a[4 * n + j] = g * up * __builtin_amdgcn_rcpf(1.0f + __expf(-g)); }
                u32x4 w; w.x = cvt_pk_bf16(a[0], a[1]); w.y = cvt_pk_bf16(a[2], a[3]); w.z = cvt_pk_bf16(a[4], a[5]); w.w = cvt_pk_bf16(a[6], a[7]);
                *(u32x4*)(O + (size_t)row * ldc + col0) = w; }
    }
};
template <class Epi, class Sched, bool ALIGN_EPI = false, bool SP2 = false>
__device__ __forceinline__ void gemm_phase(PG8_LAS unsigned char* lds, const Gemm g, const Sched& S, const Epi& E) {
    int tid_l = threadIdx.x; asm volatile("" : "+v"(tid_l));
    const int tid = tid_l, wid = __builtin_amdgcn_readfirstlane(tid >> 6), lane = tid & 63, wr = wid >> 2, wc = wid & 3, fr = lane & 15, fq = lane >> 4;
    const int K = g.K, nt = K / BK;
    unsigned voffA[2], voffB[2];
#pragma unroll
    for (int i = 0; i < 2; ++i) { int R, C; stage_rc(tid * 16 + i * 8192, R, C); const int Rb = Epi::PERM ? ((R & ~31) + perm32(R & 31)) : R;
        voffA[i] = (unsigned)(R * K + C) * 2u; voffB[i] = (unsigned)(Rb * K + C) * 2u; }
    const size_t kstep = (size_t)(BK * 2);
    const size_t hstep = (size_t)HALF * K * 2;
    const size_t tstep = 2 * hstep;
    const unsigned ldsw = (unsigned)wid * 1024u;
    const int aoff = lds_byte(wr * 64 + fr, fq * 8), boff = lds_byte(wc * 32 + fr, fq * 8);
#define PG8_SA(b, h) (((b) * 2 + (h)) * HTB)
#define PG8_SB(b, h) ((4 + (b) * 2 + (h)) * HTB)
#define PG8_STAGE(bufoff, gbase, voff) do { _Pragma("unroll") for (int _i = 0; _i < 2; ++_i) \
        __builtin_amdgcn_global_load_lds((const unsigned*)((const char*)(gbase) + (voff)[_i]), (PG8_LAS unsigned*)(lds + (bufoff) + ldsw + _i * 8192), 16, 0, 0); } while (0)
#define PG8_LDA(dst, b, h) do { _Pragma("unroll") for (int m = 0; m < 4; ++m) _Pragma("unroll") for (int k = 0; k < 2; ++k) dst[m][k] = *(const PG8_LAS bf16x8*)(lds + PG8_SA(b, h) + aoff + m * 2048 + k * 1024); } while (0)
#define PG8_LDB(dst, b, h) do { _Pragma("unroll") for (int n = 0; n < 2; ++n) _Pragma("unroll") for (int k = 0; k < 2; ++k) dst[n][k] = *(const PG8_LAS bf16x8*)(lds + PG8_SB(b, h) + boff + n * 2048 + k * 1024); } while (0)
#define PG8_MMA(ai, bj, At, Bt) do { __builtin_amdgcn_s_setprio(1); _Pragma("unroll") for (int m = 0; m < 4; ++m) _Pragma("unroll") for (int n = 0; n < 2; ++n) _Pragma("unroll") for (int k = 0; k < 2; ++k) \
        acc[ai][bj][m][n] = __builtin_amdgcn_mfma_f32_16x16x32_bf16(Bt[n][k], At[m][k], acc[ai][bj][m][n], 0, 0, 0); __builtin_amdgcn_s_setprio(0); } while (0)
#define PG8_WAIT_V(n) asm volatile("s_waitcnt vmcnt(" #n ")" ::: "memory")
#define PG8_WAIT_L(n) asm volatile("s_waitcnt lgkmcnt(" #n ")" ::: "memory")
#define PG8_BAR __builtin_amdgcn_s_barrier()
#define PG8_SCHED __builtin_amdgcn_sched_barrier(0)
    Unit cur, nxt; int ui = 0;
    if (!S.next(0, cur)) return;
    f32x4 acc[2][2][4][2];
#pragma unroll
    for (int a = 0; a < 2; ++a)
#pragma unroll
        for (int b = 0; b < 2; ++b)
#pragma unroll
            for (int m = 0; m < 4; ++m)
#pragma unroll
                for (int n = 0; n < 2; ++n) acc[a][b][m][n] = (f32x4){0.f, 0.f, 0.f, 0.f};
    bf16x8 At[4][2], B0[2][2], B1[2][2];
    const char* cA = (const char*)g.A + (size_t)cur.pm * tstep; const char* cB = (const char*)g.Bt + (size_t)cur.pn * tstep;
    S.a_ready(cur);
    if constexpr (SP2) {
        PG8_STAGE(PG8_SB(0, 0), cB, voffB); PG8_STAGE(PG8_SB(0, 1), cB + hstep, voffB); PG8_STAGE(PG8_SA(0, 0), cA, voffA); PG8_STAGE(PG8_SA(0, 1), cA + hstep, voffA);
        if (wr == 1) PG8_BAR;
        PG8_WAIT_V(2); PG8_BAR;
        PG8_STAGE(PG8_SB(1, 0), cB + kstep, voffB); PG8_STAGE(PG8_SA(1, 0), cA + kstep, voffA); PG8_STAGE(PG8_SB(1, 1), cB + hstep + kstep, voffB);
        PG8_WAIT_V(6); PG8_BAR;
    } else {
        PG8_STAGE(PG8_SB(0, 0), cB, voffB); PG8_STAGE(PG8_SA(0, 0), cA, voffA); PG8_STAGE(PG8_SB(0, 1), cB + hstep, voffB); PG8_STAGE(PG8_SA(0, 1), cA + hstep, voffA);
        if (wr == 1) PG8_BAR;
        PG8_WAIT_V(4); PG8_BAR;
        PG8_STAGE(PG8_SB(1, 0), cB + kstep, voffB); PG8_STAGE(PG8_SA(1, 0), cA + kstep, voffA); PG8_STAGE(PG8_SB(1, 1), cB + hstep + kstep, voffB);
        PG8_WAIT_V(6); PG8_BAR;
    }
    for (;;) {
        const bool has_next = S.next(ui + 1, nxt);
        const char* nA = has_next ? (const char*)g.A + (size_t)nxt.pm * tstep : cA; const char* nB = has_next ? (const char*)g.Bt + (size_t)nxt.pn * tstep : cB;
        for (int t = 0; t < nt; t += 2) {
            const bool last = (t == nt - 2);
            const char* a1 = cA + (size_t)(t + 1) * kstep;
            const char* a2 = last ? nA : cA + (size_t)(t + 2) * kstep; const char* b2 = last ? nB : cB + (size_t)(t + 2) * kstep;
            const char* a3 = a2 + kstep; const char* b3 = b2 + kstep;
            if (last && has_next) S.a_ready(nxt);
            if constexpr (SP2) {
            PG8_LDB(B0, 0, 0); PG8_LDB(B1, 0, 1); PG8_SCHED; PG8_LDA(At, 0, 0); PG8_STAGE(PG8_SA(1, 1), a1 + hstep, voffA);
            PG8_WAIT_V(8); PG8_WAIT_L(0); PG8_BAR; PG8_MMA(0, 0, At, B0); PG8_MMA(0, 1, At, B1); PG8_BAR; PG8_SCHED;
            PG8_LDA(At, 0, 1); PG8_STAGE(PG8_SB(0, 0), b2, voffB); PG8_STAGE(PG8_SB(0, 1), b2 + hstep, voffB); PG8_STAGE(PG8_SA(0, 0), a2, voffA);
            PG8_WAIT_V(8); PG8_WAIT_L(0); PG8_BAR; PG8_MMA(1, 0, At, B0); PG8_MMA(1, 1, At, B1); PG8_BAR; PG8_SCHED;
            PG8_LDB(B0, 1, 0); PG8_LDB(B1, 1, 1); PG8_SCHED; PG8_LDA(At, 1, 0); PG8_STAGE(PG8_SA(0, 1), a2 + hstep, voffA);
            PG8_WAIT_V(8); PG8_WAIT_L(0); PG8_BAR; PG8_MMA(0, 0, At, B0); PG8_MMA(0, 1, At, B1); PG8_BAR; PG8_SCHED;
            PG8_LDA(At, 1, 1); PG8_STAGE(PG8_SB(1, 0), b3, voffB); PG8_STAGE(PG8_SB(1, 1), b3 + hstep, voffB); PG8_STAGE(PG8_SA(1, 0), a3, voffA);
            PG8_WAIT_V(8); PG8_WAIT_L(0); PG8_BAR; PG8_MMA(1, 0, At, B0); PG8_MMA(1, 1, At, B1); PG8_BAR; PG8_SCHED;
            } else {
            PG8_LDB(B0, 0, 0); PG8_SCHED; PG8_LDA(At, 0, 0); PG8_STAGE(PG8_SA(1, 1), a1 + hstep, voffA);
            PG8_WAIT_L(8); PG8_BAR; PG8_WAIT_L(0); PG8_MMA(0, 0, At, B0); PG8_BAR; PG8_SCHED;
            PG8_LDB(B1, 0, 1); PG8_STAGE(PG8_SB(0, 0), b2, voffB);
            PG8_BAR; PG8_WAIT_L(0); PG8_MMA(0, 1, At, B1); PG8_BAR;
            PG8_LDA(At, 0, 1); PG8_STAGE(PG8_SA(0, 0), a2, voffA);
            PG8_BAR; PG8_WAIT_L(0); PG8_MMA(1, 0, At, B0); PG8_BAR; PG8_SCHED;
            PG8_STAGE(PG8_SB(0, 1), b2 + hstep, voffB);
            PG8_WAIT_V(6); PG8_BAR; PG8_MMA(1, 1, At, B1); PG8_BAR;
            PG8_LDB(B0, 1, 0); PG8_SCHED; PG8_LDA(At, 1, 0); PG8_STAGE(PG8_SA(0, 1), a2 + hstep, voffA);
            PG8_WAIT_L(8); PG8_BAR; PG8_WAIT_L(0); PG8_MMA(0, 0, At, B0); PG8_BAR; PG8_SCHED;
            PG8_LDB(B1, 1, 1); PG8_STAGE(PG8_SB(1, 0), b3, voffB);
            PG8_BAR; PG8_WAIT_L(0); PG8_MMA(0, 1, At, B1); PG8_BAR;
            PG8_LDA(At, 1, 1); PG8_STAGE(PG8_SA(1, 0), a3, voffA);
            PG8_BAR; PG8_WAIT_L(0); PG8_MMA(1, 0, At, B0); PG8_BAR; PG8_SCHED;
            PG8_STAGE(PG8_SB(1, 1), b3 + hstep, voffB);
            PG8_WAIT_V(6); PG8_BAR; PG8_MMA(1, 1, At, B1); PG8_BAR;
            }
        }
        if constexpr (ALIGN_EPI) { if (wr == 0) PG8_BAR; }
        if constexpr (!Epi::AFTER_DRAIN) { E(acc, cur, wr, wc, fr, fq); S.done(cur); }
        if (!has_next) break;
#pragma unroll
        for (int a = 0; a < 2; ++a)
#pragma unroll
            for (int b = 0; b < 2; ++b)
#pragma unroll
                for (int m = 0; m < 4; ++m)
#pragma unroll
                    for (int n = 0; n < 2; ++n) acc[a][b][m][n] = (f32x4){0.f, 0.f, 0.f, 0.f};
        cur = nxt; cA = nA; cB = nB; ++ui;
        if constexpr (ALIGN_EPI) { if (wr == 1) PG8_BAR; }
    }
    PG8_WAIT_V(0);
    if constexpr (!ALIGN_EPI) { if (wr == 0) PG8_BAR; }
    PG8_BAR;
    if constexpr (Epi::AFTER_DRAIN) { E.fused(acc, cur, wr, wc, fr, fq, lds, wid, lane); S.done(cur); }
#undef PG8_SA
#undef PG8_SB
#undef PG8_STAGE
#undef PG8_LDA
#undef PG8_LDB
#undef PG8_MMA
#undef PG8_WAIT_V
#undef PG8_WAIT_L
#undef PG8_BAR
#undef PG8_SCHED
}
}
#define LAS __attribute__((address_space(3)))
typedef unsigned short bf16;
typedef unsigned v4u __attribute__((ext_vector_type(4)));
typedef float f32x4 __attribute__((ext_vector_type(4)));

constexpr int NB = 8, S = 2048, D = 1024, M = NB * S, NU = 3584, DFF = 2816, MEML = 256, MROWS = NB * MEML, DX = 512;
constexpr size_t MiB = 1u << 20;
constexpr size_t WS_SSQ = 0;
constexpr size_t WS_SSQM = 512 * 1024;
constexpr size_t WS_BAR = 768 * 1024, BAR_BYTES = 32768;
constexpr int LDS_BARST = 147392;
constexpr size_t WS_PRM = 800 * 1024;
constexpr size_t WS_W = 1 * MiB, W_LAYER = 29 * MiB + MiB / 2;
constexpr size_t OW_IN = 0, OW_OUT = 7 * MiB, OW_XQ = 9 * MiB, OW_XKV = 10 * MiB, OW_XO = 12 * MiB, OW_GU = 13 * MiB, OW_DN = 24 * MiB;
constexpr size_t WS_U = 60 * MiB;
constexpr size_t WS_Y = 172 * MiB;
constexpr size_t WS_QX = 172 * MiB, WS_OX = 188 * MiB;
constexpr size_t WS_HB = 204 * MiB;
constexpr size_t WS_MEMB = 236 * MiB;
constexpr size_t WS_KV = 240 * MiB;
constexpr size_t WS_SSQP = 248 * MiB;
constexpr size_t WS_END = 256 * MiB;
constexpr int LDS_BYTES = 147456;

__device__ __forceinline__ unsigned f2bf(float f) { unsigned u = __builtin_bit_cast(unsigned, f); return (u + 0x7fffu + ((u >> 16) & 1u)) >> 16; }
__device__ __forceinline__ unsigned pk2(float lo, float hi) { return f2bf(lo) | (f2bf(hi) << 16); }
__device__ __forceinline__ float bf2f(unsigned short v) { return __uint_as_float(((unsigned)v) << 16); }
__device__ __forceinline__ float lo_f(unsigned w) { return __uint_as_float(w << 16); }
__device__ __forceinline__ float hi_f(unsigned w) { return __uint_as_float(w & 0xffff0000u); }
__device__ __forceinline__ float log_sigmoid_f(float x) { return fminf(x, 0.f) - __logf(1.0f + __expf(-fabsf(x))); }
__device__ __forceinline__ float sigmoid_f(float x) { return __builtin_amdgcn_rcpf(1.0f + __expf(-x)); }
__device__ __forceinline__ float wave_sum(float v) {
#pragma unroll
    for (int o = 1; o < 64; o <<= 1) v += __shfl_xor(v, o);
    return v;
}

#define XB_TMO      128
#define XB_XCNT(j)  (256  + 64 * (j))
#define XB_XSUB(j)  (1280 + 64 * (j))
#define XB_XGEN(j)  (2304 + 64 * (j))
#define XB_TOP      3328
#define XB_TOPGEN   3392
#define XCD_BAR_WORDS 3456
#define XB_SPIN_CAP (1u << 18)

__device__ __forceinline__ unsigned xb_ld(unsigned* p)              { return __hip_atomic_load(p, __ATOMIC_RELAXED, __HIP_MEMORY_SCOPE_AGENT); }
__device__ __forceinline__ unsigned xb_add(unsigned* p, unsigned v) { return __hip_atomic_fetch_add(p, v, __ATOMIC_RELAXED, __HIP_MEMORY_SCOPE_AGENT); }
__device__ __forceinline__ unsigned xb_xcc_id() { return (unsigned)__builtin_amdgcn_s_getreg((3 << 11) | 20) & 0xFu; }
#define XB_SPIN(cond, bar) do { unsigned _sp = 0; while (cond) { __builtin_amdgcn_s_sleep(1); \
    if ((++_sp & 255u) == 0u) { if (xb_ld(&(bar)[XB_TMO])) break; if (_sp > XB_SPIN_CAP) { atomicAdd(&(bar)[XB_TMO], 1u); break; } } } } while (0)

struct XcdBarrier {
    unsigned* bar; unsigned x;
    volatile LAS unsigned* st;
};

__device__ __forceinline__ XcdBarrier xcd_barrier_post(unsigned* bar, volatile LAS unsigned* st) {
    XcdBarrier b; b.bar = bar; b.x = xb_xcc_id(); b.st = st;
    if (threadIdx.x == 0) (void)xb_add(&bar[XB_XCNT(b.x)], 1u);
    return b;
}
__device__ __forceinline__ void xcd_barrier_complete(unsigned* bar, unsigned x, unsigned& nloc, unsigned& nx) {
    const unsigned G = gridDim.x * gridDim.y * gridDim.z;
    unsigned sum, cnt, mine, sp = 0u;
    for (;;) {
        sum = 0u; cnt = 0u; mine = 0u;
#pragma unroll
        for (unsigned j = 0; j < 16; ++j) { const unsigned c = xb_ld(&bar[XB_XCNT(j)]); sum += c; cnt += (c > 0u) ? 1u : 0u; mine = (j == x) ? c : mine; }
        if (sum == G) break;
        __builtin_amdgcn_s_sleep(1);
        if ((++sp & 255u) == 0u) { if (xb_ld(&bar[XB_TMO])) break; if (sp > XB_SPIN_CAP) { atomicAdd(&bar[XB_TMO], 1u); break; } }
    }
    nloc = mine > 0u ? mine : 1u; nx = cnt > 0u ? cnt : 1u;
}

__device__ __forceinline__ void xcd_barrier(const XcdBarrier& b) {
    asm volatile("s_waitcnt vmcnt(0)" ::: "memory");
    __syncthreads();
    if (threadIdx.x == 0) {
        unsigned* bar = b.bar;
        __builtin_amdgcn_s_waitcnt(0);
        unsigned nloc = b.st[0], nx = b.st[1];
        if (nloc == 0u) { xcd_barrier_complete(bar, b.x, nloc, nx); b.st[0] = nloc; b.st[1] = nx; }
        const unsigned old = xb_add(&bar[XB_XSUB(b.x)], 1u);
        const unsigned gen = old / nloc;
        if (old + 1u == (gen + 1u) * nloc) {
            __builtin_amdgcn_fence(__ATOMIC_RELEASE, "agent");
            asm volatile("s_waitcnt vmcnt(0)" ::: "memory");
            const unsigned og = xb_add(&bar[XB_TOP], 1u);
            const unsigned tg = og / nx;
            if (og + 1u == (tg + 1u) * nx) xb_add(&bar[XB_TOPGEN], 1u);
            else XB_SPIN(xb_ld(&bar[XB_TOPGEN]) == tg, bar);
            __builtin_amdgcn_fence(__ATOMIC_ACQUIRE, "agent");
            xb_add(&bar[XB_XGEN(b.x)], 1u);
            asm volatile("s_waitcnt vmcnt(0)" ::: "memory");
        } else {
            XB_SPIN(xb_ld(&bar[XB_XGEN(b.x)]) == gen, bar);
            __builtin_amdgcn_fence(__ATOMIC_ACQUIRE, "agent");
            asm volatile("s_waitcnt vmcnt(0)" ::: "memory");
        }
    }
    __syncthreads();
}

__device__ __forceinline__ void conv_item(const float* W0, const float* W1, int pitch, int K, int mode, const float* rowscale, bf16* WT, LAS float* scr, int item, int nblk, int lane) {
    const int kb = item / nblk, nb = item % nblk, k0 = 64 * kb, n0 = 32 * nb;
    const int n = n0 + (lane & 31);
    const float* src = nullptr;
    if (mode == 0) src = W0 + n;
    else if (mode == 1) { if (n < 1152) src = W0 + n; else if (n < 3456) src = W0 + n + 6; else if (n < 3462) src = W0 + 1152 + (n - 3456); else if (n < 3474) src = W0 + n; }
    else { const int t = n >> 8, j = n & 255; src = (j < 128) ? (W0 + 128 * t + j) : (W1 + 128 * t + (j - 128)); }
#pragma unroll
    for (int i = 0; i < 32; ++i) { const int kk = 2 * i + (lane >> 5); float v = src ? src[(size_t)(k0 + kk) * pitch] : 0.f; if (rowscale) v *= rowscale[k0 + kk]; scr[kk * 33 + (lane & 31)] = v; }
    asm volatile("s_waitcnt lgkmcnt(0)" ::: "memory");
    const int c = lane & 7;
#pragma unroll
    for (int j = 0; j < 4; ++j) { const int nn = (lane >> 3) + 8 * j; const LAS float* s = scr + (8 * c) * 33 + nn;
        v4u o; o.x = pk2(s[0 * 33], s[1 * 33]); o.y = pk2(s[2 * 33], s[3 * 33]); o.z = pk2(s[4 * 33], s[5 * 33]); o.w = pk2(s[6 * 33], s[7 * 33]);
        *(v4u*)(WT + (size_t)(n0 + nn) * K + k0 + 8 * c) = o; }
    asm volatile("s_waitcnt lgkmcnt(0)" ::: "memory");
}
__device__ __forceinline__ void conv_block_item(const float* W0, const float* W1, int pitch, int K, int mode, const float* rowscale, bf16* WT, LAS float* tile, int kb, int nb, int tid) {
    const int k0 = 64 * kb, n0 = 256 * nb, c4 = (tid & 63) * 4;
#pragma unroll
    for (int i = 0; i < 8; ++i) { const int row = 8 * i + (tid >> 6); f32x4 v = {0.f, 0.f, 0.f, 0.f};
        const float* rp = W0 + (size_t)(k0 + row) * pitch;
        if (mode == 0) v = *(const f32x4*)(rp + n0 + c4);
        else if (mode == 2) { const float* rq = (c4 < 128 ? rp : W1 + (size_t)(k0 + row) * pitch) + 128 * nb + (c4 & 127); v = *(const f32x4*)rq; }
        else {
#pragma unroll
            for (int j = 0; j < 4; ++j) { const int n = n0 + c4 + j; int sc = -1;
                if (n < 1152) sc = n; else if (n < 3456) sc = n + 6; else if (n < 3462) sc = 1152 + (n - 3456); else if (n < 3474) sc = n;
                v[j] = sc >= 0 ? rp[sc] : 0.f; } }
        if (rowscale) v = v * rowscale[k0 + row];
        LAS float* d = tile + row * 257 + c4; d[0] = v[0]; d[1] = v[1]; d[2] = v[2]; d[3] = v[3]; }
    __syncthreads();
    const int q = tid & 7;
#pragma unroll
    for (int pass = 0; pass < 4; ++pass) { const int nl = (tid >> 3) + 64 * pass; const LAS float* sp = tile + (8 * q) * 257 + nl;
        v4u o; o.x = pk2(sp[0], sp[257]); o.y = pk2(sp[2 * 257], sp[3 * 257]); o.z = pk2(sp[4 * 257], sp[5 * 257]); o.w = pk2(sp[6 * 257], sp[7 * 257]);
        *(v4u*)(WT + (size_t)(n0 + nl) * K + k0 + 8 * q) = o; }
    __syncthreads();
}
__device__ __forceinline__ void row_to_bf16_ssq(const float* xrow, bf16* orow, float* ssq_out, int lane) {
    const f32x4* xr = (const f32x4*)xrow + lane; f32x4 v[4]; float s2 = 0.f;
#pragma unroll
    for (int j = 0; j < 4; ++j) { v[j] = xr[64 * j]; s2 += (v[j].x * v[j].x + v[j].y * v[j].y) + (v[j].z * v[j].z + v[j].w * v[j].w); }
    s2 = wave_sum(s2);
    unsigned long long* o8 = (unsigned long long*)orow + lane;
#pragma unroll
    for (int j = 0; j < 4; ++j) o8[64 * j] = (unsigned long long)pk2(v[j].x, v[j].y) | ((unsigned long long)pk2(v[j].z, v[j].w) << 32);
    if (lane < 16) ssq_out[lane] = lane == 0 ? s2 : 0.f;
}

typedef short s16x8 __attribute__((ext_vector_type(8)));
typedef short s16x4 __attribute__((ext_vector_type(4)));
typedef float f32x16 __attribute__((ext_vector_type(16)));
__device__ __forceinline__ s16x4 tr_read(LAS const unsigned char* p) { return __builtin_bit_cast(s16x4, __builtin_amdgcn_ds_read_tr16_b64_v4i16((LAS s16x4*)p)); }
__device__ __forceinline__ s16x8 cat8(s16x4 a, s16x4 b) { return (s16x8){a[0], a[1], a[2], a[3], b[0], b[1], b[2], b[3]}; }
__device__ __forceinline__ unsigned cvtpk(float lo, float hi) { return pg8::cvt_pk_bf16(lo, hi); }
__device__ __forceinline__ s16x8 pack8(float a0, float a1, float a2, float a3, float a4, float a5, float a6, float a7) {
    v4u w; w.x = cvtpk(a0, a1); w.y = cvtpk(a2, a3); w.z = cvtpk(a4, a5); w.w = cvtpk(a6, a7); return __builtin_bit_cast(s16x8, w); }
#define MFMA32(a, b, c) __builtin_amdgcn_mfma_f32_32x32x16_bf16(a, b, c, 0, 0, 0)
__device__ __forceinline__ float xh_sum(float x) { auto rr = __builtin_amdgcn_permlane32_swap(__float_as_uint(x), __float_as_uint(x), false, false); return __uint_as_float(rr[0]) + __uint_as_float(rr[1]); }
__device__ __forceinline__ float xh_max(float x) { auto rr = __builtin_amdgcn_permlane32_swap(__float_as_uint(x), __float_as_uint(x), false, false); return fmaxf(__uint_as_float(rr[0]), __uint_as_float(rr[1])); }
__device__ __forceinline__ float xh_prod(float x) { auto rr = __builtin_amdgcn_permlane32_swap(__float_as_uint(x), __float_as_uint(x), false, false); return __uint_as_float(rr[0]) * __uint_as_float(rr[1]); }
__device__ __forceinline__ float xh_other(float x) { auto rr = __builtin_amdgcn_permlane32_swap(__float_as_uint(x), __float_as_uint(x), false, false); return __uint_as_float(rr[0] == __float_as_uint(x) ? rr[1] : rr[0]); }
__device__ __forceinline__ void st_wt64(float* p, float a, float b) { __hip_atomic_store((unsigned long long*)p, ((unsigned long long)__float_as_uint(b) << 32) | (unsigned long long)__float_as_uint(a), __ATOMIC_RELAXED, __HIP_MEMORY_SCOPE_AGENT); }
__device__ __forceinline__ void st_wt32(float* p, float a) { __hip_atomic_store((unsigned*)p, __float_as_uint(a), __ATOMIC_RELAXED, __HIP_MEMORY_SCOPE_AGENT); }
__device__ __forceinline__ void fox_cumsum_item(const bf16* u, const float* foxb, float* cl, float* tot, int item, int lane) {
    const int bhf = item >> 3, seg = item & 7, b = bhf / 6, h = bhf % 6;
    const float fb = foxb[h];
    const bf16* p = u + ((size_t)b * S + seg * 256 + 4 * lane) * NU + 3456 + h;
    const float L2E = 1.4426950408889634f;
    float l0 = L2E * log_sigmoid_f(bf2f(p[0]) + fb), l1 = L2E * log_sigmoid_f(bf2f(p[NU]) + fb), l2 = L2E * log_sigmoid_f(bf2f(p[2 * NU]) + fb), l3 = L2E * log_sigmoid_f(bf2f(p[3 * NU]) + fb);
    l1 += l0; l2 += l1; l3 += l2;
    float inc = l3;
#pragma unroll
    for (int o = 1; o < 64; o <<= 1) { const float v = __shfl_up(inc, o, 64); if (lane >= o) inc += v; }
    const float ex = inc - l3;
    { float* d = cl + (size_t)bhf * S + seg * 256 + 4 * lane; st_wt64(d, ex + l0, ex + l1); st_wt64(d + 2, ex + l2, ex + l3); }
    if (lane == 63) st_wt32(tot + bhf * 8 + seg, inc);
}
constexpr int PV64 = 144;
__device__ __forceinline__ void attn_mfma_item(const bf16* u, bf16* y, const float* cl, const float* tot, LAS unsigned char* wl, int item, int lane) {
    const int bh = item % 80, qb = 63 - item / 80;
    const bool fox = bh < 48;
    int b, h, qoff, koff, voff, yoff;
    if (fox) { b = bh / 6; h = bh % 6; qoff = h * 64; koff = 384 + h * 64; voff = 768 + h * 64; yoff = h * 64; }
    else { const int rr = bh - 48; b = rr / 4; h = rr % 4; qoff = 1152 + h * 64; koff = 1408 + h * 64; voff = 1664 + h * 64; yoff = 384 + h * 64; }
    const int r = lane & 31, hi = lane >> 5;
    const char* ubc = (const char*)(u + (size_t)b * S * NU);
    const int t = qb * 32 + r;
    const float* clh = cl + (size_t)(fox ? bh : 0) * S;
    s16x8 Qf[4];
    { const unsigned qo = (unsigned)(t * NU + qoff + 8 * hi) * 2u;
#pragma unroll
      for (int d0 = 0; d0 < 4; ++d0) Qf[d0] = *(const s16x8*)(ubc + qo + 32 * d0);
      if (!fox) {
          const float qs = -0.125f * 1.4426950408889634f;
#pragma unroll
          for (int d0 = 0; d0 < 4; ++d0) { const v4u w = __builtin_bit_cast(v4u, Qf[d0]);
              Qf[d0] = pack8(lo_f(w.x) * qs, hi_f(w.x) * qs, lo_f(w.y) * qs, hi_f(w.y) * qs, lo_f(w.z) * qs, hi_f(w.z) * qs, lo_f(w.w) * qs, hi_f(w.w) * qs); } } }
    f32x16 O0, O1;
#pragma unroll
    for (int i = 0; i < 16; ++i) { O0[i] = 0.f; O1[i] = 0.f; }
    float mrun = -1e30f, lsum = 0.f, Rsb = 1.f, Doff = 0.f;
    const float clt = fox ? clh[t] : 0.f;
    LAS float* gl = (LAS float*)(wl + 4608);
    const int trbase = (4 * hi + ((lane >> 2) & 3)) * PV64 + (16 * ((lane >> 4) & 1) + 4 * (lane & 3)) * 2;
    const unsigned lane_off = (unsigned)((lane >> 3) * NU + 8 * (lane & 7)) * 2u;
    v4u kn[4], vn[4]; float gn = 0.f;
    { const char* tb = ubc + (size_t)(qb * 32) * NU * 2;
#pragma unroll
      for (int i = 0; i < 4; ++i) { kn[i] = *(const v4u*)(tb + (size_t)(8 * i * NU + koff) * 2 + lane_off); vn[i] = *(const v4u*)(tb + (size_t)(8 * i * NU + voff) * 2 + lane_off); }
      if (fox) gn = clh[qb * 32 + r]; }
    LAS unsigned char* kl = wl + 4736;
    const int kfoff = r * PV64 + 16 * hi;
    const float SC2 = 0.125f * 1.4426950408889634f;
    { LAS unsigned char* z = wl + 9344 + (lane >> 3) * PV64 + 16 * (lane & 7);
#pragma unroll
      for (int i = 0; i < 4; ++i) *(LAS v4u*)(z + 8 * i * PV64) = (v4u){0u, 0u, 0u, 0u}; }
    s16x8 Pp0 = {0, 0, 0, 0, 0, 0, 0, 0}, Pp1 = {0, 0, 0, 0, 0, 0, 0, 0};
    int vlast = 0;
    for (int jt = qb; jt >= 0; --jt) {
        const bool diag = (jt == qb);
        const int vcur = ((qb - jt) & 1) ? 9344 : 0, vprev = 9344 - vcur; vlast = vcur;
        { LAS unsigned char* dk = kl + (lane >> 3) * PV64 + 16 * (lane & 7); LAS unsigned char* dv = wl + vcur + (lane >> 3) * PV64 + 16 * (lane & 7);
#pragma unroll
          for (int i = 0; i < 4; ++i) { *(LAS v4u*)(dk + 8 * i * PV64) = kn[i]; *(LAS v4u*)(dv + 8 * i * PV64) = vn[i]; } }
        if (fox) gl[r] = -gn;
        if (jt > 0) { const char* tb = ubc + (size_t)((jt - 1) * 32) * NU * 2;
#pragma unroll
          for (int i = 0; i < 4; ++i) { kn[i] = *(const v4u*)(tb + (size_t)(8 * i * NU + koff) * 2 + lane_off); vn[i] = *(const v4u*)(tb + (size_t)(8 * i * NU + voff) * 2 + lane_off); }
          if (fox) gn = clh[(jt - 1) * 32 + r]; }
        s16x8 Kf[4];
#pragma unroll
        for (int d0 = 0; d0 < 4; ++d0) Kf[d0] = *(LAS const s16x8*)(kl + kfoff + 32 * d0);
        LAS const unsigned char* vb = wl + vprev + trbase;
        const s16x8 V00 = cat8(tr_read(vb), tr_read(vb + 8 * PV64)), V01 = cat8(tr_read(vb + 16 * PV64), tr_read(vb + 24 * PV64));
        const s16x8 V10 = cat8(tr_read(vb + 64), tr_read(vb + 8 * PV64 + 64)), V11 = cat8(tr_read(vb + 16 * PV64 + 64), tr_read(vb + 24 * PV64 + 64));
        f32x16 Sx;
#pragma unroll
        for (int i = 0; i < 16; ++i) Sx[i] = 0.f;
        Sx = MFMA32(Kf[0], Qf[0], Sx); O0 = MFMA32(V00, Pp0, O0);
        Sx = MFMA32(Kf[1], Qf[1], Sx); O1 = MFMA32(V10, Pp0, O1);
        Sx = MFMA32(Kf[2], Qf[2], Sx); O0 = MFMA32(V01, Pp1, O0);
        Sx = MFMA32(Kf[3], Qf[3], Sx); O1 = MFMA32(V11, Pp1, O1);
        float P[16];
        if (fox) {
            const float off = clt + Doff;
            float tmax = -1e30f;
#pragma unroll
            for (int g = 0; g < 4; ++g) { const f32x4 ncs = *(LAS const f32x4*)(gl + 8 * g + 4 * hi);
#pragma unroll
                for (int e = 0; e < 4; ++e) P[4 * g + e] = fmaf(SC2, Sx[4 * g + e], ncs[e]); }
            if (diag) {
#pragma unroll
                for (int i = 0; i < 16; ++i) { const int sl = 8 * (i >> 2) + 4 * hi + (i & 3); if (sl > r) P[i] = -1e30f; } }
#pragma unroll
            for (int i = 0; i < 16; ++i) tmax = fmaxf(tmax, P[i]);
            tmax = xh_max(tmax) + off;
            if (__any(tmax > mrun)) {
                const float mnew = fmaxf(mrun, tmax), alpha = __builtin_amdgcn_exp2f(mrun - mnew); lsum *= alpha; mrun = mnew;
#pragma unroll
                for (int i = 0; i < 16; ++i) { O0[i] *= alpha; O1[i] *= alpha; } }
            const float msh = mrun - off; float ps = 0.f;
#pragma unroll
            for (int i = 0; i < 16; ++i) { P[i] = __builtin_amdgcn_exp2f(P[i] - msh); ps += P[i]; }
            lsum += ps;
            if (jt > 0 && ((jt - 1) >> 3) != (jt >> 3)) Doff += tot[bh * 8 + ((jt - 1) >> 3)];
        } else {
            float kp[16], gs[4], go[4]; float T = 1.f;
#pragma unroll
            for (int i = 0; i < 16; ++i) { const float ee = __builtin_amdgcn_exp2f(Sx[i]); const float sig = __builtin_amdgcn_rcpf(1.0f + ee); P[i] = sig; kp[i] = 1.0f - sig; }
            if (diag) {
#pragma unroll
                for (int i = 0; i < 16; ++i) { const int sl = 8 * (i >> 2) + 4 * hi + (i & 3); if (sl >= r) { P[i] = 0.f; kp[i] = 1.f; } } }
#pragma unroll
            for (int g = 0; g < 4; ++g) { gs[g] = (kp[4 * g] * kp[4 * g + 1]) * (kp[4 * g + 2] * kp[4 * g + 3]); T *= gs[g]; }
#pragma unroll
            for (int g = 0; g < 4; ++g) go[g] = xh_other(gs[g]);
            float above = Rsb;
#pragma unroll
            for (int g = 3; g >= 0; --g) {
                float suf = hi == 0 ? above * go[g] : above;
#pragma unroll
                for (int e = 3; e >= 0; --e) { const float a = P[4 * g + e] * suf; suf *= kp[4 * g + e]; P[4 * g + e] = a; }
                above *= gs[g] * go[g];
            }
            Rsb *= xh_prod(T);
        }
        Pp0 = pack8(P[0], P[1], P[2], P[3], P[4], P[5], P[6], P[7]); Pp1 = pack8(P[8], P[9], P[10], P[11], P[12], P[13], P[14], P[15]);
        if (!fox && __all(Rsb == 0.0f)) break;
    }
    { LAS const unsigned char* vb = wl + vlast + trbase;
      const s16x8 V00 = cat8(tr_read(vb), tr_read(vb + 8 * PV64)), V01 = cat8(tr_read(vb + 16 * PV64), tr_read(vb + 24 * PV64));
      const s16x8 V10 = cat8(tr_read(vb + 64), tr_read(vb + 8 * PV64 + 64)), V11 = cat8(tr_read(vb + 16 * PV64 + 64), tr_read(vb + 24 * PV64 + 64));
      O0 = MFMA32(V00, Pp0, O0); O1 = MFMA32(V10, Pp0, O1); O0 = MFMA32(V01, Pp1, O0); O1 = MFMA32(V11, Pp1, O1); }
    float inv = 1.0f;
    if (fox) { lsum = xh_sum(lsum); inv = __builtin_amdgcn_rcpf(lsum); }
    char* yb0 = (char*)(y + (size_t)b * S * D); const unsigned yo = (unsigned)(t * D + yoff + 4 * hi) * 2u;
#pragma unroll
    for (int g = 0; g < 4; ++g) {
        unsigned long long w0 = (unsigned long long)cvtpk(O0[4 * g] * inv, O0[4 * g + 1] * inv) | ((unsigned long long)cvtpk(O0[4 * g + 2] * inv, O0[4 * g + 3] * inv) << 32);
        unsigned long long w1 = (unsigned long long)cvtpk(O1[4 * g] * inv, O1[4 * g + 1] * inv) | ((unsigned long long)cvtpk(O1[4 * g + 2] * inv, O1[4 * g + 3] * inv) << 32);
        *(unsigned long long*)(yb0 + yo + 16 * g) = w0; *(unsigned long long*)(yb0 + yo + 64 + 16 * g) = w1; }
}
constexpr int PV128 = 272;
__device__ __forceinline__ void xattn_mfma_item(const bf16* qx, const bf16* kv, bf16* ox, LAS unsigned char* wl, int item, int lane) {
    const int head = item & 3, qblk = item >> 2;
    const int r = lane & 31, hi = lane >> 5;
    const int token = qblk * 32 + r, b = (qblk * 32) / S;
    s16x8 Qf[8];
    { const char* qb_ = (const char*)qx; const unsigned qo = (unsigned)(token * DX + head * 128 + 8 * hi) * 2u;
#pragma unroll
      for (int d0 = 0; d0 < 8; ++d0) Qf[d0] = *(const s16x8*)(qb_ + qo + 32 * d0); }
    f32x16 O[4];
#pragma unroll
    for (int k = 0; k < 4; ++k)
#pragma unroll
        for (int i = 0; i < 16; ++i) O[k][i] = 0.f;
    float mrun = -1e30f, lsum = 0.f;
    const int trbase = (4 * hi + ((lane >> 2) & 3)) * PV128 + (16 * ((lane >> 4) & 1) + 4 * (lane & 3)) * 2;
    const char* kvc = (const char*)(kv + (size_t)b * MEML * 1024);
    const unsigned kfo = (unsigned)(r * 1024 + head * 128 + 8 * hi) * 2u;
    const unsigned vlo = (unsigned)((lane >> 4) * 1024 + 512 + head * 128 + 8 * (lane & 15)) * 2u;
    s16x8 Kn[8]; v4u vn[8];
#pragma unroll
    for (int d0 = 0; d0 < 8; ++d0) Kn[d0] = *(const s16x8*)(kvc + kfo + 32 * d0);
#pragma unroll
    for (int i = 0; i < 8; ++i) vn[i] = *(const v4u*)(kvc + vlo + (size_t)(4 * i) * 2048);
    const float SCX = 0.08838834764831845f * 1.4426950408889634f;
    for (int jt = 0; jt < 8; ++jt) {
        f32x16 Sx;
#pragma unroll
        for (int i = 0; i < 16; ++i) Sx[i] = 0.f;
#pragma unroll
        for (int d0 = 0; d0 < 8; ++d0) Sx = MFMA32(Kn[d0], Qf[d0], Sx);
        { LAS unsigned char* dst = wl + (lane >> 4) * PV128 + 16 * (lane & 15);
#pragma unroll
          for (int i = 0; i < 8; ++i) *(LAS v4u*)(dst + 4 * i * PV128) = vn[i]; }
        if (jt < 7) { const char* tb = kvc + (size_t)((jt + 1) * 32) * 2048;
#pragma unroll
            for (int d0 = 0; d0 < 8; ++d0) Kn[d0] = *(const s16x8*)(tb + kfo + 32 * d0);
#pragma unroll
            for (int i = 0; i < 8; ++i) vn[i] = *(const v4u*)(tb + vlo + (size_t)(4 * i) * 2048); }
        float P[16]; float tmax = -1e30f;
#pragma unroll
        for (int i = 0; i < 16; ++i) { P[i] = Sx[i] * SCX; tmax = fmaxf(tmax, P[i]); }
        tmax = xh_max(tmax);
        if (__any(tmax > mrun)) { const float mnew = fmaxf(mrun, tmax), alpha = __builtin_amdgcn_exp2f(mrun - mnew); lsum *= alpha; mrun = mnew;
#pragma unroll
            for (int k = 0; k < 4; ++k)
#pragma unroll
                for (int i = 0; i < 16; ++i) O[k][i] *= alpha; }
        float ps = 0.f;
#pragma unroll
        for (int i = 0; i < 16; ++i) { P[i] = __builtin_amdgcn_exp2f(P[i] - mrun); ps += P[i]; }
        lsum += ps;
        const s16x8 Pf0 = pack8(P[0], P[1], P[2], P[3], P[4], P[5], P[6], P[7]), Pf1 = pack8(P[8], P[9], P[10], P[11], P[12], P[13], P[14], P[15]);
        LAS const unsigned char* vb = wl + trbase;
#pragma unroll
        for (int k = 0; k < 4; ++k) {
            const s16x8 Va = cat8(tr_read(vb + 64 * k), tr_read(vb + 8 * PV128 + 64 * k)), Vb = cat8(tr_read(vb + 16 * PV128 + 64 * k), tr_read(vb + 24 * PV128 + 64 * k));
            O[k] = MFMA32(Va, Pf0, O[k]); O[k] = MFMA32(Vb, Pf1, O[k]); }
    }
    lsum = xh_sum(lsum); const float inv = __builtin_amdgcn_rcpf(lsum);
    char* oc = (char*)ox; const unsigned oo = (unsigned)(token * DX + head * 128 + 4 * hi) * 2u;
#pragma unroll
    for (int k = 0; k < 4; ++k)
#pragma unroll
        for (int g = 0; g < 4; ++g) {
            const unsigned long long w0 = (unsigned long long)cvtpk(O[k][4 * g] * inv, O[k][4 * g + 1] * inv) | ((unsigned long long)cvtpk(O[k][4 * g + 2] * inv, O[k][4 * g + 3] * inv) << 32);
            *(unsigned long long*)(oc + oo + 64 * k + 16 * g) = w0; }
}

constexpr int ML_WSTRIDE = 18432, ML_RAWK = 0, ML_RAWQ = 5056, ML_WK = 5056, ML_V = 10112, ML_CW = 14720, ML_EB = 16768, ML_NL = 16896, ML_NW = 17152, ML_ITEM_F = 4224;
template <bool OUT>
__device__ __forceinline__ void mlstm_item(const bf16* u, bf16* y, float* scratch, const float* convw, const float* ib, const float* fbias, const float* normw, LAS unsigned char* wl, int bh, int c, int lane) {
    const int b = bh / 6, h = bh % 6, r = lane & 31, hi = lane >> 5;
    const bf16* ub = u + (size_t)b * S * NU;
    LAS float* cw = (LAS float*)(wl + ML_CW); LAS float* eb = (LAS float*)(wl + ML_EB); LAS float* nl = (LAS float*)(wl + ML_NL); LAS float* nwl = (LAS float*)(wl + ML_NW);
    for (int i = lane; i < 512; i += 64) { const int tap = i >> 7, ch = i & 127; cw[i] = convw[tap * 768 + (ch < 64 ? (64 * h + ch) : (384 + 64 * h + (ch - 64)))]; }
    if (OUT) nwl[lane] = normw[h * 64 + lane];
    const float ibh = ib[h], fbh = fbias[h];
    f32x16 X[2][2];
#pragma unroll
    for (int a = 0; a < 2; ++a)
#pragma unroll
        for (int bb = 0; bb < 2; ++bb)
#pragma unroll
            for (int i = 0; i < 16; ++i) X[a][bb][i] = 0.f;
    float nk = 0.f, Gsum = 0.f;
    if (OUT) {
        float dec = 1.f;
        for (int cp = c - 1; cp >= 0; --cp) {
            const float* s0 = scratch + (size_t)(bh * 16 + cp) * ML_ITEM_F;
            f32x16 v0[4];
#pragma unroll
            for (int blk = 0; blk < 4; ++blk) v0[blk] = *(const f32x16*)(s0 + blk * 1024 + lane * 16);
            const float n0 = s0[4096 + lane], g0 = s0[4160];
#pragma unroll
            for (int blk = 0; blk < 4; ++blk) X[blk >> 1][blk & 1] += v0[blk] * dec;
            nk += dec * n0;
            dec *= __expf(g0);
        }
    }
    nl[lane] = nk;
    const int trP = (4 * hi + ((lane >> 2) & 3)) * 144 + (16 * ((lane >> 4) & 1) + 4 * (lane & 3)) * 2;
    const int trN = (8 * hi + ((lane >> 2) & 3)) * 144 + (16 * ((lane >> 4) & 1) + 4 * (lane & 3)) * 2;
    for (int j = 0; j < 4; ++j) {
        const int t0 = c * 128 + j * 32, t = t0 + r;
        const bf16* trow = ub + (size_t)t * NU;
        const unsigned short gfr = trow[3468 + h], gir = trow[3462 + h];
        v4u vv[4], rk[5], rq[5];
        { const bf16* vrow = ub + (size_t)(t0 + (lane >> 3)) * NU + 2688 + 64 * h + 8 * (lane & 7);
#pragma unroll
          for (int i = 0; i < 4; ++i) vv[i] = *(const v4u*)(vrow + (size_t)(8 * i) * NU); }
#pragma unroll
        for (int i = 0; i < 5; ++i) { const int p = lane + 64 * i, row = p >> 3, ch8 = p & 7, tt = t0 - 3 + row; const bool ok = (p < 280) && (tt >= 0);
            const bf16* src = ub + (size_t)(ok ? tt : 0) * NU + 1920 + 64 * h + 8 * ch8;
            rk[i] = ok ? *(const v4u*)(src + 384) : (v4u){0u, 0u, 0u, 0u};
            if (OUT) rq[i] = ok ? *(const v4u*)(src) : (v4u){0u, 0u, 0u, 0u}; }
#pragma unroll
        for (int i = 0; i < 5; ++i) { const int p = lane + 64 * i, row = p >> 3, ch8 = p & 7;
            if (p < 280) { *(LAS v4u*)(wl + ML_RAWK + row * 144 + 16 * ch8) = rk[i]; if (OUT) *(LAS v4u*)(wl + ML_RAWQ + row * 144 + 16 * ch8) = rq[i]; } }
        { LAS unsigned char* dst = wl + ML_V + (lane >> 3) * 144 + 16 * (lane & 7);
#pragma unroll
          for (int i = 0; i < 4; ++i) *(LAS v4u*)(dst + 8 * i * 144) = vv[i]; }
        float bl = log_sigmoid_f(bf2f(gfr) + fbh); const float ii = bf2f(gir) + ibh;
#pragma unroll
        for (int o = 1; o < 32; o <<= 1) { const float v = __shfl_up(bl, o, 32); if (r >= o) bl += v; }
        const float g = __shfl(bl, 31, 32), es = ii - bl;
        eb[r] = es; Gsum += g;
        s16x8 Kf[4], Qf[4]; float dq = 0.f;
#pragma unroll
        for (int part = (OUT ? 0 : 1); part < 2; ++part) {
            LAS unsigned char* raw = wl + (part ? ML_RAWK : ML_RAWQ);
            const float w0 = cw[part * 64 + lane], w1 = cw[128 + part * 64 + lane], w2 = cw[256 + part * 64 + lane], w3 = cw[384 + part * 64 + lane];
            const float sc = part ? 0.125f : 1.0f;
            float xv[35];
#pragma unroll
            for (int i = 0; i < 35; ++i) xv[i] = bf2f(*(LAS const unsigned short*)(raw + i * 144 + 2 * lane));
#pragma unroll
            for (int i = 0; i < 16; ++i) {
                const float a0 = w0 * xv[2 * i] + w1 * xv[2 * i + 1] + w2 * xv[2 * i + 2] + w3 * xv[2 * i + 3];
                const float a1 = w0 * xv[2 * i + 1] + w1 * xv[2 * i + 2] + w2 * xv[2 * i + 3] + w3 * xv[2 * i + 4];
                const unsigned pk = cvtpk(a0 * sc * __builtin_amdgcn_rcpf(1.0f + __expf(-a0)), a1 * sc * __builtin_amdgcn_rcpf(1.0f + __expf(-a1)));
                *(LAS unsigned short*)(raw + (2 * i) * 144 + 2 * lane) = (unsigned short)pk; *(LAS unsigned short*)(raw + (2 * i + 1) * 144 + 2 * lane) = (unsigned short)(pk >> 16); }
#pragma unroll
            for (int f = 0; f < 4; ++f) {
                const unsigned long long p0 = *(LAS const unsigned long long*)(raw + r * 144 + (16 * f + 4 * hi) * 2), p1 = *(LAS const unsigned long long*)(raw + r * 144 + (16 * f + 8 + 4 * hi) * 2);
                const v4u fw = {(unsigned)p0, (unsigned)(p0 >> 32), (unsigned)p1, (unsigned)(p1 >> 32)};
                if (part) Kf[f] = __builtin_bit_cast(s16x8, fw); else Qf[f] = __builtin_bit_cast(s16x8, fw);
                if (OUT && part == 0) { const f32x4 n0 = *(LAS const f32x4*)(nl + 16 * f + 4 * hi), n1 = *(LAS const f32x4*)(nl + 16 * f + 8 + 4 * hi);
                    dq += (lo_f(fw.x) * n0[0] + hi_f(fw.x) * n0[1]) + (lo_f(fw.y) * n0[2] + hi_f(fw.y) * n0[3]) + (lo_f(fw.z) * n1[0] + hi_f(fw.z) * n1[1]) + (lo_f(fw.w) * n1[2] + hi_f(fw.w) * n1[3]); } }
        }
        if (OUT) {
            f32x16 Sx;
#pragma unroll
            for (int i = 0; i < 16; ++i) Sx[i] = 0.f;
#pragma unroll
            for (int f = 0; f < 4; ++f) Sx = MFMA32(Kf[f], Qf[f], Sx);
            float P[16]; float den = 0.f;
#pragma unroll
            for (int g4 = 0; g4 < 4; ++g4) { const f32x4 e4 = *(LAS const f32x4*)(eb + 8 * g4 + 4 * hi);
#pragma unroll
                for (int e = 0; e < 4; ++e) { const int sl = 8 * g4 + 4 * hi + e; const float d = (sl <= r) ? __expf(bl + e4[e]) : 0.f; P[4 * g4 + e] = Sx[4 * g4 + e] * d; den += P[4 * g4 + e]; } }
            den = xh_sum(den); dq = xh_sum(dq);
            const float ebt = __expf(bl);
            const float inv = 1.0f / fmaxf(fabsf(den + ebt * dq), 1.0f);
            const s16x8 Pf0 = pack8(P[0], P[1], P[2], P[3], P[4], P[5], P[6], P[7]), Pf1 = pack8(P[8], P[9], P[10], P[11], P[12], P[13], P[14], P[15]);
            unsigned long long ow[8];
#pragma unroll
            for (int vb = 0; vb < 2; ++vb)
#pragma unroll
                for (int g4 = 0; g4 < 4; ++g4) ow[4 * vb + g4] = *(const unsigned long long*)(trow + 3072 + 64 * h + 32 * vb + 8 * g4 + 4 * hi);
            f32x16 H[2]; float ms = 0.f;
#pragma unroll
            for (int vb = 0; vb < 2; ++vb) {
                LAS const unsigned char* vp = wl + ML_V + trP + 64 * vb;
                f32x16 Zi, Zx;
#pragma unroll
                for (int i = 0; i < 16; ++i) { Zi[i] = 0.f; Zx[i] = 0.f; }
                Zi = MFMA32(cat8(tr_read(vp), tr_read(vp + 8 * 144)), Pf0, Zi); Zi = MFMA32(cat8(tr_read(vp + 16 * 144), tr_read(vp + 24 * 144)), Pf1, Zi);
#pragma unroll
                for (int kb = 0; kb < 2; ++kb)
#pragma unroll
                    for (int sp = 0; sp < 2; ++sp) { const f32x16& xx = X[kb][vb];
                        const s16x8 xa = pack8(xx[8 * sp], xx[8 * sp + 1], xx[8 * sp + 2], xx[8 * sp + 3], xx[8 * sp + 4], xx[8 * sp + 5], xx[8 * sp + 6], xx[8 * sp + 7]);
                        Zx = MFMA32(xa, Qf[2 * kb + sp], Zx); }
#pragma unroll
                for (int i = 0; i < 16; ++i) { const float hv = (Zi[i] + ebt * Zx[i]) * inv; H[vb][i] = hv; ms += hv * hv; }
            }
            ms = xh_sum(ms);
            const float rs = rsqrtf(ms * (1.0f / 64.0f) + 1e-6f);
            bf16* yrow = y + ((size_t)b * S + t) * D + 640 + 64 * h;
#pragma unroll
            for (int vb = 0; vb < 2; ++vb)
#pragma unroll
                for (int g4 = 0; g4 < 4; ++g4) { const int v = 32 * vb + 8 * g4 + 4 * hi;
                    const unsigned o0 = (unsigned)ow[4 * vb + g4], o1 = (unsigned)(ow[4 * vb + g4] >> 32);
                    const f32x4 w4 = *(LAS const f32x4*)(nwl + v);
                    const float y0 = H[vb][4 * g4] * rs * w4[0] * sigmoid_f(lo_f(o0)), y1 = H[vb][4 * g4 + 1] * rs * w4[1] * sigmoid_f(hi_f(o0));
                    const float y2 = H[vb][4 * g4 + 2] * rs * w4[2] * sigmoid_f(lo_f(o1)), y3 = H[vb][4 * g4 + 3] * rs * w4[3] * sigmoid_f(hi_f(o1));
                    *(unsigned long long*)(yrow + v) = (unsigned long long)cvtpk(y0, y1) | ((unsigned long long)cvtpk(y2, y3) << 32); }
        }
        { const float wsc = __expf(g + es), eg = __expf(g);
#pragma unroll
          for (int f = 0; f < 4; ++f) { const v4u kw = __builtin_bit_cast(v4u, Kf[f]);
#pragma unroll
              for (int e = 0; e < 2; ++e) { const unsigned k0 = e ? kw.z : kw.x, k1 = e ? kw.w : kw.y; const int ch = 16 * f + 8 * e + 4 * hi;
                  *(LAS unsigned long long*)(wl + ML_WK + r * 144 + ch * 2) = (unsigned long long)cvtpk(lo_f(k0) * wsc, hi_f(k0) * wsc) | ((unsigned long long)cvtpk(lo_f(k1) * wsc, hi_f(k1) * wsc) << 32); } }
#pragma unroll
          for (int kb = 0; kb < 2; ++kb)
#pragma unroll
              for (int vb = 0; vb < 2; ++vb) { X[kb][vb] *= eg;
#pragma unroll
                  for (int sp = 0; sp < 2; ++sp) { LAS const unsigned char* kp = wl + ML_WK + trN + 16 * sp * 144 + 64 * kb; LAS const unsigned char* vp = wl + ML_V + trN + 16 * sp * 144 + 64 * vb;
                      X[kb][vb] = MFMA32(cat8(tr_read(kp), tr_read(kp + 4 * 144)), cat8(tr_read(vp), tr_read(vp + 4 * 144)), X[kb][vb]); } }
          float dn = 0.f;
#pragma unroll 8
          for (int s2 = 0; s2 < 32; ++s2) dn += bf2f(*(LAS const unsigned short*)(wl + ML_WK + s2 * 144 + 2 * lane));
          nk = eg * nk + dn; nl[lane] = nk; }
    }
    if (!OUT) {
        float* sp = scratch + (size_t)(bh * 16 + c) * ML_ITEM_F;
#pragma unroll
        for (int blk = 0; blk < 4; ++blk) {
#pragma unroll
            for (int i = 0; i < 8; ++i) st_wt64(sp + blk * 1024 + lane * 16 + 2 * i, X[blk >> 1][blk & 1][2 * i], X[blk >> 1][blk & 1][2 * i + 1]); }
        st_wt32(sp + 4096 + lane, nk);
        if (lane == 0) st_wt32(sp + 4160, Gsum);
    }
}

struct Args { const float* in[20]; float* out; unsigned char* ws; };
#define GEMM_PHASE(EpiT, SchedT, g, Sc, E) pg8::gemm_phase<EpiT, SchedT, true, true>(L, g, Sc, E)

__global__ void __launch_bounds__(512, 2) mega_fwd(Args a) {
    extern __shared__ __attribute__((aligned(16))) unsigned char lds[];
    LAS unsigned char* L = (LAS unsigned char*)lds;
    const int tid = threadIdx.x, lane = tid & 63, wave = __builtin_amdgcn_readfirstlane(tid >> 6);
    const int G = gridDim.x, bx = blockIdx.x;
    const int gw = bx * 8 + wave, NGW = G * 8;
    unsigned char* ws = a.ws;
    const float* x = a.in[0]; const float* mem = a.in[1];
    float* out = a.out;
    float* ssq = (float*)(ws + WS_SSQP); float* ssqm = (float*)(ws + WS_SSQP + 7 * MiB);
    bf16* ub = (bf16*)(ws + WS_U); bf16* actb = (bf16*)(ws + WS_U); bf16* yb = (bf16*)(ws + WS_Y); bf16* qxb = (bf16*)(ws + WS_QX); bf16* oxb = (bf16*)(ws + WS_OX);
    bf16* hb = (bf16*)(ws + WS_HB); bf16* memb = (bf16*)(ws + WS_MEMB); bf16* kvb = (bf16*)(ws + WS_KV);

    volatile LAS unsigned* bst = (volatile LAS unsigned*)(L + LDS_BARST); if (tid < 2) bst[tid] = 0u;
    __syncthreads();
    (void)xcd_barrier_post((unsigned*)(a.ws + WS_BAR), bst);
    {
        LAS float* tile = (LAS float*)L;
        constexpr int I_IN = 16 * 14, I_OUT = 16 * 4, I_XQ = 16 * 2, I_XKV = 16 * 4, I_XO = 8 * 4, I_GU = 16 * 22, I_DN = 44 * 4;
        constexpr int I_LAYER = I_IN + I_OUT + I_XQ + I_XKV + I_XO + I_GU + I_DN;
        for (int it = bx; it < 2 * I_LAYER; it += G) {
            const int l = it / I_LAYER; int r = it % I_LAYER;
            unsigned char* wl = ws + WS_W + (size_t)l * W_LAYER;
            if (r < I_IN) { conv_block_item(a.in[3] + (size_t)l * 1024 * 3474, nullptr, 3474, 1024, 1, a.in[2] + l * 1024, (bf16*)(wl + OW_IN), tile, r / 14, r % 14, tid); continue; } r -= I_IN;
            if (r < I_OUT) { conv_block_item(a.in[9] + (size_t)l * 1024 * 1024, nullptr, 1024, 1024, 0, nullptr, (bf16*)(wl + OW_OUT), tile, r / 4, r % 4, tid); continue; } r -= I_OUT;
            if (r < I_XQ) { conv_block_item(a.in[12] + (size_t)l * 1024 * 512, nullptr, 512, 1024, 0, a.in[10] + l * 1024, (bf16*)(wl + OW_XQ), tile, r / 2, r % 2, tid); continue; } r -= I_XQ;
            if (r < I_XKV) { conv_block_item(a.in[13] + (size_t)l * 1024 * 1024, nullptr, 1024, 1024, 0, a.in[11] + l * 1024, (bf16*)(wl + OW_XKV), tile, r / 4, r % 4, tid); continue; } r -= I_XKV;
            if (r < I_XO) { conv_block_item(a.in[14] + (size_t)l * 512 * 1024, nullptr, 1024, 512, 0, nullptr, (bf16*)(wl + OW_XO), tile, r / 4, r % 4, tid); continue; } r -= I_XO;
            if (r < I_GU) { conv_block_item(a.in[16] + (size_t)l * 1024 * DFF, a.in[17] + (size_t)l * 1024 * DFF, DFF, 1024, 2, a.in[15] + l * 1024, (bf16*)(wl + OW_GU), tile, r / 22, r % 22, tid); continue; } r -= I_GU;
            conv_block_item(a.in[18] + (size_t)l * DFF * 1024, nullptr, 1024, DFF, 0, nullptr, (bf16*)(wl + OW_DN), tile, r / 4, r % 4, tid);
        }
        for (int m = gw; m < M; m += NGW) row_to_bf16_ssq(x + (size_t)m * D, hb + (size_t)m * D, ssq + (size_t)m * 16, lane);
        for (int m = gw; m < MROWS; m += NGW) row_to_bf16_ssq(mem + (size_t)m * D, memb + (size_t)m * D, ssqm + (size_t)m * 16, lane);
        { float* prm = (float*)(ws + WS_PRM);
          for (int i = bx * 512 + tid; i < 2 * 8192 + 1024; i += G * 512) {
              float v = 0.f;
              if (i >= 2 * 8192) v = a.in[19][i - 2 * 8192];
              else { const int l = i >> 13, o = i & 8191;
                  if (o < 6) v = a.in[4][l * 6 + o]; else if (o >= 8 && o < 14) v = a.in[6][l * 6 + o - 8]; else if (o >= 16 && o < 22) v = a.in[7][l * 6 + o - 16];
                  else if (o >= 64 && o < 448) v = a.in[8][l * 384 + o - 64]; else if (o >= 512 && o < 3584) v = a.in[5][l * 3072 + o - 512]; }
              prm[i] = v; } }
    }
#define XBAR() do { XcdBarrier xb_; xb_.bar = (unsigned*)(ws + WS_BAR); xb_.x = xb_xcc_id(); xb_.st = (volatile LAS unsigned*)(L + LDS_BARST); xcd_barrier(xb_); } while (0)
    { unsigned char* ws = a.ws; XBAR(); }
    for (int ph = 0; ph < 16; ++ph) {
        const int l = ph >> 3, k = ph & 7;
        size_t zoff = 0; asm volatile("" : "+s"(zoff)); unsigned char* ws = a.ws + zoff;
        const unsigned char* wl = ws + WS_W + (size_t)l * W_LAYER;
        float* ssq = (float*)(ws + WS_SSQP); float* ssqm = (float*)(ws + WS_SSQP + 7 * MiB);
        bf16* ub = (bf16*)(ws + WS_U); bf16* actb = (bf16*)(ws + WS_U); bf16* yb = (bf16*)(ws + WS_Y); bf16* qxb = (bf16*)(ws + WS_QX); bf16* oxb = (bf16*)(ws + WS_OX);
        bf16* hb = (bf16*)(ws + WS_HB); bf16* memb = (bf16*)(ws + WS_MEMB); bf16* kvb = (bf16*)(ws + WS_KV);
        int tid_p = threadIdx.x; asm volatile("" : "+v"(tid_p)); const int lane = tid_p & 63, wave = __builtin_amdgcn_readfirstlane(tid_p >> 6), gw = bx * 8 + wave;
        if (k == 0 || k == 3) {
            const int j0 = (ph == 0) ? 0 : 2;
            for (int j = j0; j < 3; ++j) {
                pg8::Gemm g; pg8::EpiScaleBf16 E; int off = 0;
                if (j < 2) { g = pg8::Gemm{memb, (const bf16*)(ws + WS_W + (size_t)j * W_LAYER + OW_XKV), MROWS, 1024, 1024}; E = pg8::EpiScaleBf16{kvb + (size_t)j * MROWS * 1024, 1024, ssqm}; off = 128 + 32 * j; }
                else if (k == 0) { g = pg8::Gemm{hb, (const bf16*)(wl + OW_IN), M, NU, 1024}; E = pg8::EpiScaleBf16{ub, NU, ssq + (size_t)(3 * l) * M * 16}; }
                else { g = pg8::Gemm{hb, (const bf16*)(wl + OW_XQ), M, DX, 1024}; E = pg8::EpiScaleBf16{qxb, DX, ssq + (size_t)(3 * l + 1) * M * 16}; }
                pg8::OffsetOrder Sc; Sc.init(g.M, g.N, G, bx, off);
                GEMM_PHASE(pg8::EpiScaleBf16, pg8::OffsetOrder, g, Sc, E);
            }
        } else if (k == 2 || k == 5 || k == 7) {
            pg8::Gemm g; pg8::EpiResid E;
            if (k == 2) { g = pg8::Gemm{yb, (const bf16*)(wl + OW_OUT), M, 1024, 1024}; E = pg8::EpiResid{hb, ssq + (size_t)(3 * l + 1) * M * 16}; }
            else if (k == 5) { g = pg8::Gemm{oxb, (const bf16*)(wl + OW_XO), M, 1024, DX}; E = pg8::EpiResid{hb, ssq + (size_t)(3 * l + 2) * M * 16}; }
            else { g = pg8::Gemm{actb, (const bf16*)(wl + OW_DN), M, 1024, DFF}; E = pg8::EpiResid{hb, ssq + (size_t)(3 * l + 3) * M * 16}; }
            pg8::StaticOrder Sc; Sc.init(g.M, g.N, G, bx);
            GEMM_PHASE(pg8::EpiResid, pg8::StaticOrder, g, Sc, E);
        } else if (k == 6) {
            pg8::Gemm g{hb, (const bf16*)(wl + OW_GU), M, 2 * DFF, 1024}; pg8::StaticOrder Sc; Sc.init(M, 2 * DFF, G, bx);
            pg8::EpiSwiglu E{actb, DFF, ssq + (size_t)(3 * l + 2) * M * 16};
            GEMM_PHASE(pg8::EpiSwiglu, pg8::StaticOrder, g, Sc, E);
        } else if (k == 1) {
            const float* prm = (const float*)(ws + WS_PRM) + l * 8192;
            float* mscr = out;
            float* fcl = out + 14 * MiB / 4; float* ftot = out + 15 * MiB / 4;
            const int xcd0 = (int)(xb_xcc_id() & 7u); unsigned okmask = 0u;
            for (int qi = 0; qi < 8; ++qi) {
            const int xcd = (xcd0 + qi) & 7;
            unsigned* done = (unsigned*)(ws + WS_BAR + 15360) + 16 * (l * 8 + xcd);
            for (int sj = 0; sj < (qi == 0 ? 8 : 1); ++sj) {
            const int sq = (wave + sj) & 7;
            unsigned* ctr = (unsigned*)(ws + WS_BAR + 16384) + 16 * ((l * 8 + xcd) * 8 + sq);
            for (;;) {
                int it = 0; if (lane == 0) it = (int)atomicAdd(ctr, 1u); it = __builtin_amdgcn_readfirstlane(it) * 8 + sq;
                if (it >= 874) break;
                if (it < 138) {
                    if (it >= 48) mlstm_item<false>(ub, yb, mscr, prm + 512, prm + 8, prm + 16, prm + 64, L + wave * ML_WSTRIDE, xcd + 8 * ((it - 48) / 15), (it - 48) % 15, lane);
                    else fox_cumsum_item(ub, prm, fcl, ftot, (xcd + 8 * (it >> 3)) * 8 + (it & 7), lane);
                    asm volatile("s_waitcnt vmcnt(0)" ::: "memory");
                    if (lane == 0) atomicAdd(done + (it >= 48 ? 8 : 0), 1u);
                } else {
                    const bool isc = (it >= 266 && it < 362), issb = (it >= 362 && it < 618), isfox = !isc && !issb;
                    if (isfox && !((okmask >> xcd) & 1u)) { unsigned sp = 0u;
                        while (__hip_atomic_load(done, __ATOMIC_RELAXED, __HIP_MEMORY_SCOPE_AGENT) < 48u) { __builtin_amdgcn_s_sleep(4); if (++sp > (1u << 21)) break; }
                        __builtin_amdgcn_fence(__ATOMIC_ACQUIRE, "agent"); okmask |= 1u << xcd; }
                    if (isc && !((okmask >> (8 + xcd)) & 1u)) { unsigned sp = 0u;
                        while (__hip_atomic_load(done + 8, __ATOMIC_RELAXED, __HIP_MEMORY_SCOPE_AGENT) < 90u) { __builtin_amdgcn_s_sleep(4); if (++sp > (1u << 21)) break; }
                        __builtin_amdgcn_fence(__ATOMIC_ACQUIRE, "agent"); okmask |= 1u << (8 + xcd); }
                    if (isc) { const int ci = it - 266; mlstm_item<true>(ub, yb, mscr, prm + 512, prm + 8, prm + 16, prm + 64, L + wave * ML_WSTRIDE, xcd + 8 * (ci >> 4), 15 - (ci & 15), lane); }
                    else { int aitem; if (issb) { const int ai = it - 362; aitem = (ai >> 2) * 80 + 48 + xcd + 8 * (ai & 3); } else { const int ai = (it < 266) ? it - 138 : it - 490; aitem = (ai / 6) * 80 + xcd + 8 * (ai % 6); }
                        attn_mfma_item(ub, yb, fcl, ftot, L + wave * ML_WSTRIDE, aitem, lane); }
                }
            }
            }
            }
        } else {
            for (int it = gw; it < 2048; it += NGW) xattn_mfma_item(qxb, kvb + (size_t)l * MROWS * 1024, oxb, L + wave * 16384, it, lane);
        }
        XBAR();
    }
    {
        int tid_f = threadIdx.x; asm volatile("" : "+v"(tid_f)); const int lane = tid_f & 63, gw = bx * 8 + __builtin_amdgcn_readfirstlane(tid_f >> 6);
        const float* fw = (const float*)(a.ws + WS_PRM) + 2 * 8192; const float* sq = (const float*)(a.ws + WS_SSQP) + (size_t)6 * M * 16;
        const bf16* hbf = (const bf16*)(a.ws + WS_HB);
        for (int m = gw; m < M; m += NGW) {
            float sm = 0.f; { const f32x4* qp = (const f32x4*)(sq + (size_t)m * 16); const f32x4 q0 = qp[0], q1 = qp[1], q2 = qp[2], q3 = qp[3];
              sm = ((((q0[0] + q0[1]) + (q0[2] + q0[3])) + ((q1[0] + q1[1]) + (q1[2] + q1[3]))) + (((q2[0] + q2[1]) + (q2[2] + q2[3])) + ((q3[0] + q3[1]) + (q3[2] + q3[3])))); }
            const float rs = rsqrtf(sm * (1.0f / 1024.0f) + 1e-6f);
            const unsigned long long* hp = (const unsigned long long*)(hbf + (size_t)m * D) + lane; f32x4* rp = (f32x4*)(out + (size_t)m * D) + lane; const f32x4* wp = (const f32x4*)fw + lane;
#pragma unroll
            for (int j = 0; j < 4; ++j) { const unsigned long long hw = hp[64 * j]; const unsigned h0 = (unsigned)hw, h1 = (unsigned)(hw >> 32); const f32x4 w = wp[64 * j];
                f32x4 v = {lo_f(h0), hi_f(h0), lo_f(h1), hi_f(h1)}; v = v * rs * w; rp[64 * j] = v; }
        }
    }
}

extern "C" void kernel_launch(void* const* d_in, const int* in_sizes, int n_in, void* d_out, int out_size, void* d_ws, size_t ws_size, hipStream_t stream) {
    static int grid = 0;
    if (grid == 0) {
        if (n_in != 20 || out_size != M * D || ws_size < WS_END) { fprintf(stderr, "kernel_launch: unexpected shapes (n_in %d out %d ws %zu)\n", n_in, out_size, ws_size); grid = -1; return; }
        int dev = 0, cus = 0, per_cu = 0;
        hipGetDevice(&dev); hipDeviceGetAttribute(&cus, hipDeviceAttributeMultiprocessorCount, dev);
        if (hipFuncSetAttribute((const void*)mega_fwd, hipFuncAttributeMaxDynamicSharedMemorySize, LDS_BYTES) != hipSuccess) { fprintf(stderr, "kernel_launch: hipFuncSetAttribute failed\n"); grid = -1; return; }
        if (hipOccupancyMaxActiveBlocksPerMultiprocessor(&per_cu, (const void*)mega_fwd, 512, LDS_BYTES) != hipSuccess || per_cu < 1) { fprintf(stderr, "kernel_launch: occupancy query says %d\n", per_cu); (void)hipGetLastError(); per_cu = 1; }
        grid = cus * per_cu;
    }
    if (grid < 0) return;
    Args a{};
    for (int i = 0; i < 20; ++i) a.in[i] = (const float*)d_in[i];
    a.out = (float*)d_out; a.ws = (unsigned char*)d_ws;
    if (hipMemsetAsync((char*)d_ws + WS_BAR, 0, BAR_BYTES, stream) != hipSuccess) { fprintf(stderr, "kernel_launch: memset of the barrier words failed\n"); return; }
    void* args[] = {&a};
    hipError_t e = hipLaunchCooperativeKernel((const void*)mega_fwd, dim3(grid), dim3(512), args, LDS_BYTES, stream);
    if (e != hipSuccess) fprintf(stderr, "kernel_launch: cooperative launch failed: %s (grid %d)\n", hipGetErrorString(e), grid);
}
```

```cpp
#include <hip/hip_runtime.h>
#include <hip/hip_cooperative_groups.h>
#include <cstdio>
#include <cstdint>
#include <cmath>
namespace cg = cooperative_groups;
namespace pg8 {
#define PG8_LAS __attribute__((address_space(3)))
typedef unsigned short bf16_t;
typedef short bf16x8 __attribute__((ext_vector_type(8)));
typedef float f32x4 __attribute__((ext_vector_type(4)));
typedef unsigned u32x4 __attribute__((ext_vector_type(4)));
constexpr int BM = 256, BK = 64, HALF = 128, HTB = HALF * BK * 2  , STAGE_BYTES = 8 * HTB, NXCD = 8, WGM = 4;

__host__ __device__ __forceinline__ int lds_byte(int r, int c) { const int st = (r >> 4) * 2 + (c >> 5), rr = r & 15, cc = c & 31, ob = rr * 64 + cc * 2; return st * 1024 + (ob ^ (((ob >> 9) & 1) << 5)); }
__host__ __device__ __forceinline__ void stage_rc(int b, int& R, int& C) { const int st = b / 1024, sb = b % 1024, swz = sb ^ (((sb >> 9) & 1) << 5); R = (st >> 1) * 16 + swz / 64; C = (st & 1) * 32 + (swz % 64) / 2; }
__host__ __device__ __forceinline__ int perm32(int rho) { const int n = rho >> 4, i = rho & 15; return 8 * (i >> 2) + 4 * n + (i & 3); }

struct Unit { int pm, pn; };
struct Gemm { const bf16_t* A; const bf16_t* Bt; int M, N, K; };

struct StaticOrder {
    int nM, nN, nwg, G, c;
    __host__ __device__ void init(int M, int N, int G_, int c_) { nM = M / BM; nN = N / BM; nwg = nM * nN; G = G_; c = c_; }
    __host__ __device__ bool next(int i, Unit& u) const {
        const long L = (long)i * G + c; if (L >= nwg) return false;
        int wgid = (int)L; { const int q = nwg / NXCD, r = nwg % NXCD, xcd = wgid % NXCD, off = wgid / NXCD; wgid = (xcd < r ? xcd * (q + 1) : r * (q + 1) + (xcd - r) * q) + off; }
        const int nig = WGM * nN, gid = wgid / nig, fm = gid * WGM, gsz = (nM - fm) < WGM ? (nM - fm) : WGM;
        u.pm = fm + ((wgid % nig) % gsz); u.pn = (wgid % nig) / gsz; return true;
    }
    __device__ __forceinline__ void a_ready(const Unit&) const {}
    __device__ __forceinline__ void done(const Unit&) const {}
};

__device__ __forceinline__ unsigned cvt_pk_bf16(float lo, float hi) { unsigned r; asm volatile("v_cvt_pk_bf16_f32 %0, %1, %2" : "=v"(r) : "v"(lo), "v"(hi)); return r; }
typedef float f32x2 __attribute__((ext_vector_type(2)));
struct OffsetOrder {
    StaticOrder b;
    __device__ void init(int M, int N, int G, int c, int off) { b.init(M, N, G, (c + G - (off % G)) % G); }
    __device__ bool next(int i, Unit& u) const { return b.next(i, u); }
    __device__ __forceinline__ void a_ready(const Unit&) const {}
    __device__ __forceinline__ void done(const Unit&) const {}
};
struct EpiScaleBf16 {
    static constexpr bool PERM = true, AFTER_DRAIN = false;
    bf16_t* O; int ldc; const float* ssq;
    __device__ __forceinline__ void operator()(const f32x4 (&acc)[2][2][4][2], const Unit& u, int wr, int wc, int fr, int fq) const {
        const int row0 = u.pm * BM + wr * 64 + fr, col0 = u.pn * BM + wc * 32 + 8 * fq;
#pragma unroll
        for (int ai = 0; ai < 2; ++ai)
#pragma unroll
            for (int m = 0; m < 4; ++m) { const int row = row0 + ai * HALF + m * 16; const f32x4 q0 = *(const f32x4*)(ssq + (size_t)row * 16), q1 = *(const f32x4*)(ssq + (size_t)row * 16 + 4), q2 = *(const f32x4*)(ssq + (size_t)row * 16 + 8), q3 = *(const f32x4*)(ssq + (size_t)row * 16 + 12);
                const float rs = rsqrtf(((((q0[0] + q0[1]) + (q0[2] + q0[3])) + ((q1[0] + q1[1]) + (q1[2] + q1[3]))) + (((q2[0] + q2[1]) + (q2[2] + q2[3])) + ((q3[0] + q3[1]) + (q3[2] + q3[3])))) * (1.0f / 1024.0f) + 1e-6f);
                bf16_t* rowp = O + (size_t)row * ldc + col0;
#pragma unroll
                for (int bj = 0; bj < 2; ++bj) { const f32x4 v0 = acc[ai][bj][m][0] * rs, v1 = acc[ai][bj][m][1] * rs;
                    u32x4 w; w.x = cvt_pk_bf16(v0[0], v0[1]); w.y = cvt_pk_bf16(v0[2], v0[3]); w.z = cvt_pk_bf16(v1[0], v1[1]); w.w = cvt_pk_bf16(v1[2], v1[3]);
                    *(u32x4*)(rowp + bj * HALF) = w; } }
    }
};
struct EpiResid {
    static constexpr bool PERM = true, AFTER_DRAIN = false;
    bf16_t* hb; float* ssq;
    __device__ __forceinline__ void operator()(const f32x4 (&acc)[2][2][4][2], const Unit& u, int wr, int wc, int fr, int fq) const {
        const int row0 = u.pm * BM + wr * 64 + fr, col0 = u.pn * BM + wc * 32 + 8 * fq;
#pragma unroll
        for (int ai = 0; ai < 2; ++ai)
#pragma unroll
            for (int m = 0; m < 4; ++m) { const int row = row0 + ai * HALF + m * 16; const size_t off = (size_t)row * 1024 + col0; float part = 0.f;
#pragma unroll
                for (int bj = 0; bj < 2; ++bj) { const u32x4 b = *(const u32x4*)(hb + off + bj * HALF);
                    f32x4 v0 = acc[ai][bj][m][0], v1 = acc[ai][bj][m][1];
                    v0[0] += __uint_as_float(b.x << 16); v0[1] += __uint_as_float(b.x & 0xffff0000u); v0[2] += __uint_as_float(b.y << 16); v0[3] += __uint_as_float(b.y & 0xffff0000u);
                    v1[0] += __uint_as_float(b.z << 16); v1[1] += __uint_as_float(b.z & 0xffff0000u); v1[2] += __uint_as_float(b.w << 16); v1[3] += __uint_as_float(b.w & 0xffff0000u);
                    u32x4 w; w.x = cvt_pk_bf16(v0[0], v0[1]); w.y = cvt_pk_bf16(v0[2], v0[3]); w.z = cvt_pk_bf16(v1[0], v1[1]); w.w = cvt_pk_bf16(v1[2], v1[3]);
                    *(u32x4*)(hb + off + bj * HALF) = w;
                    part += (v0[0] * v0[0] + v0[1] * v0[1]) + (v0[2] * v0[2] + v0[3] * v0[3]) + (v1[0] * v1[0] + v1[1] * v1[1]) + (v1[2] * v1[2] + v1[3] * v1[3]); }
                part += __shfl_xor(part, 16); part += __shfl_xor(part, 32);
                if (fq == 0) ssq[(size_t)row * 16 + u.pn * 4 + wc] = part; }
    }
};
struct EpiSwiglu {
    static constexpr bool PERM = true, AFTER_DRAIN = false;
    bf16_t* O; int ldc; const float* ssq;
    __device__ __forceinline__ void operator()(const f32x4 (&acc)[2][2][4][2], const Unit& u, int wr, int wc, int fr, int fq) const {
        const int row0 = u.pm * BM + wr * 64 + fr, col0 = u.pn * HALF + wc * 32 + 8 * fq;
#pragma unroll
        for (int ai = 0; ai < 2; ++ai)
#pragma unroll
            for (int m = 0; m < 4; ++m) { const int row = row0 + ai * HALF + m * 16; const f32x4 q0 = *(const f32x4*)(ssq + (size_t)row * 16), q1 = *(const f32x4*)(ssq + (size_t)row * 16 + 4), q2 = *(const f32x4*)(ssq + (size_t)row * 16 + 8), q3 = *(const f32x4*)(ssq + (size_t)row * 16 + 12);
                const float rs = rsqrtf(((((q0[0] + q0[1]) + (q0[2] + q0[3])) + ((q1[0] + q1[1]) + (q1[2] + q1[3]))) + (((q2[0] + q2[1]) + (q2[2] + q2[3])) + ((q3[0] + q3[1]) + (q3[2] + q3[3])))) * (1.0f / 1024.0f) + 1e-6f);
                float a[8];
#pragma unroll
                for (int n = 0; n < 2; ++n)
#pragma unroll
                    for (int j = 0; j < 4; ++j) { const float g = acc[ai][0][m][n][j] * rs, up = acc[ai][1][m][n][j] * rs; a[4 * n + j] = g * up * __builtin_amdgcn_rcpf(1.0f + __expf(-g)); }
                u32x4 w; w.x = cvt_pk_bf16(a[0], a[1]); w.y = cvt_pk_bf16(a[2], a[3]); w.z = cvt_pk_bf16(a[4], a[5]); w.w = cvt_pk_bf16(a[6], a[7]);
                *(u32x4*)(O + (size_t)row * ldc + col0) = w; }
    }
};
template <class Epi, class Sched, bool ALIGN_EPI = false, bool SP2 = false>
__device__ __forceinline__ void gemm_phase(PG8_LAS unsigned char* lds, const Gemm g, const Sched& S, const Epi& E) {
    int tid_l = threadIdx.x; asm volatile("" : "+v"(tid_l));
    const int tid = tid_l, wid = __builtin_amdgcn_readfirstlane(tid >> 6), lane = tid & 63, wr = wid >> 2, wc = wid & 3, fr = lane & 15, fq = lane >> 4;
    const int K = g.K, nt = K / BK;
    unsigned voffA[2], voffB[2];
#pragma unroll
    for (int i = 0; i < 2; ++i) { int R, C; stage_rc(tid * 16 + i * 8192, R, C); const int Rb = Epi::PERM ? ((R & ~31) + perm32(R & 31)) : R;
        voffA[i] = (unsigned)(R * K + C) * 2u; voffB[i] = (unsigned)(Rb * K + C) * 2u; }
    const size_t kstep = (size_t)(BK * 2);
    const size_t hstep = (size_t)HALF * K * 2;
    const size_t tstep = 2 * hstep;
    const unsigned ldsw = (unsigned)wid * 1024u;
    const int aoff = lds_byte(wr * 64 + fr, fq * 8), boff = lds_byte(wc * 32 + fr, fq * 8);
#define PG8_SA(b, h) (((b) * 2 + (h)) * HTB)
#define PG8_SB(b, h) ((4 + (b) * 2 + (h)) * HTB)
#define PG8_STAGE(bufoff, gbase, voff) do { _Pragma("unroll") for (int _i = 0; _i < 2; ++_i) \
        __builtin_amdgcn_global_load_lds((const unsigned*)((const char*)(gbase) + (voff)[_i]), (PG8_LAS unsigned*)(lds + (bufoff) + ldsw + _i * 8192), 16, 0, 0); } while (0)
#define PG8_LDA(dst, b, h) do { _Pragma("unroll") for (int m = 0; m < 4; ++m) _Pragma("unroll") for (int k = 0; k < 2; ++k) dst[m][k] = *(const PG8_LAS bf16x8*)(lds + PG8_SA(b, h) + aoff + m * 2048 + k * 1024); } while (0)
#define PG8_LDB(dst, b, h) do { _Pragma("unroll") for (int n = 0; n < 2; ++n) _Pragma("unroll") for (int k = 0; k < 2; ++k) dst[n][k] = *(const PG8_LAS bf16x8*)(lds + PG8_SB(b, h) + boff + n * 2048 + k * 1024); } while (0)
#define PG8_MMA(ai, bj, At, Bt) do { __builtin_amdgcn_s_setprio(1); _Pragma("unroll") for (int m = 0; m < 4; ++m) _Pragma("unroll") for (int n = 0; n < 2; ++n) _Pragma("unroll") for (int k = 0; k < 2; ++k) \
        acc[ai][bj][m][n] = __builtin_amdgcn_mfma_f32_16x16x32_bf16(Bt[n][k], At[m][k], acc[ai][bj][m][n], 0, 0, 0); __builtin_amdgcn_s_setprio(0); } while (0)
#define PG8_WAIT_V(n) asm volatile("s_waitcnt vmcnt(" #n ")" ::: "memory")
#define PG8_WAIT_L(n) asm volatile("s_waitcnt lgkmcnt(" #n ")" ::: "memory")
#define PG8_BAR __builtin_amdgcn_s_barrier()
#define PG8_SCHED __builtin_amdgcn_sched_barrier(0)
    Unit cur, nxt; int ui = 0;
    if (!S.next(0, cur)) return;
    f32x4 acc[2][2][4][2];
#pragma unroll
    for (int a = 0; a < 2; ++a)
#pragma unroll
        for (int b = 0; b < 2; ++b)
#pragma unroll
            for (int m = 0; m < 4; ++m)
#pragma unroll
                for (int n = 0; n < 2; ++n) acc[a][b][m][n] = (f32x4){0.f, 0.f, 0.f, 0.f};
    bf16x8 At[4][2], B0[2][2], B1[2][2];
    const char* cA = (const char*)g.A + (size_t)cur.pm * tstep; const char* cB = (const char*)g.Bt + (size_t)cur.pn * tstep;
    S.a_ready(cur);
    if constexpr (SP2) {
        PG8_STAGE(PG8_SB(0, 0), cB, voffB); PG8_STAGE(PG8_SB(0, 1), cB + hstep, voffB); PG8_STAGE(PG8_SA(0, 0), cA, voffA); PG8_STAGE(PG8_SA(0, 1), cA + hstep, voffA);
        if (wr == 1) PG8_BAR;
        PG8_WAIT_V(2); PG8_BAR;
        PG8_STAGE(PG8_SB(1, 0), cB + kstep, voffB); PG8_STAGE(PG8_SA(1, 0), cA + kstep, voffA); PG8_STAGE(PG8_SB(1, 1), cB + hstep + kstep, voffB);
        PG8_WAIT_V(6); PG8_BAR;
    } else {
        PG8_STAGE(PG8_SB(0, 0), cB, voffB); PG8_STAGE(PG8_SA(0, 0), cA, voffA); PG8_STAGE(PG8_SB(0, 1), cB + hstep, voffB); PG8_STAGE(PG8_SA(0, 1), cA + hstep, voffA);
        if (wr == 1) PG8_BAR;
        PG8_WAIT_V(4); PG8_BAR;
        PG8_STAGE(PG8_SB(1, 0), cB + kstep, voffB); PG8_STAGE(PG8_SA(1, 0), cA + kstep, voffA); PG8_STAGE(PG8_SB(1, 1), cB + hstep + kstep, voffB);
        PG8_WAIT_V(6); PG8_BAR;
    }
    for (;;) {
        const bool has_next = S.next(ui + 1, nxt);
        const char* nA = has_next ? (const char*)g.A + (size_t)nxt.pm * tstep : cA; const char* nB = has_next ? (const char*)g.Bt + (size_t)nxt.pn * tstep : cB;
        for (int t = 0; t < nt; t += 2) {
            const bool last = (t == nt - 2);
            const char* a1 = cA + (size_t)(t + 1) * kstep;
            const char* a2 = last ? nA : cA + (size_t)(t + 2) * kstep; const char* b2 = last ? nB : cB + (size_t)(t + 2) * kstep;
            const char* a3 = a2 + kstep; const char* b3 = b2 + kstep;
            if (last && has_next) S.a_ready(nxt);
            if constexpr (SP2) {
            PG8_LDB(B0, 0, 0); PG8_LDB(B1, 0, 1); PG8_SCHED; PG8_LDA(At, 0, 0); PG8_STAGE(PG8_SA(1, 1), a1 + hstep, voffA);
            PG8_WAIT_V(8); PG8_WAIT_L(0); PG8_BAR; PG8_MMA(0, 0, At, B0); PG8_MMA(0, 1, At, B1); PG8_BAR; PG8_SCHED;
            PG8_LDA(At, 0, 1); PG8_STAGE(PG8_SB(0, 0), b2, voffB); PG8_STAGE(PG8_SB(0, 1), b2 + hstep, voffB); PG8_STAGE(PG8_SA(0, 0), a2, voffA);
            PG8_WAIT_V(8); PG8_WAIT_L(0); PG8_BAR; PG8_MMA(1, 0, At, B0); PG8_MMA(1, 1, At, B1); PG8_BAR; PG8_SCHED;
            PG8_LDB(B0, 1, 0); PG8_LDB(B1, 1, 1); PG8_SCHED; PG8_LDA(At, 1, 0); PG8_STAGE(PG8_SA(0, 1), a2 + hstep, voffA);
            PG8_WAIT_V(8); PG8_WAIT_L(0); PG8_BAR; PG8_MMA(0, 0, At, B0); PG8_MMA(0, 1, At, B1); PG8_BAR; PG8_SCHED;
            PG8_LDA(At, 1, 1); PG8_STAGE(PG8_SB(1, 0), b3, voffB); PG8_STAGE(PG8_SB(1, 1), b3 + hstep, voffB); PG8_STAGE(PG8_SA(1, 0), a3, voffA);
            PG8_WAIT_V(8); PG8_WAIT_L(0); PG8_BAR; PG8_MMA(1, 0, At, B0); PG8_MMA(1, 1, At, B1); PG8_BAR; PG8_SCHED;
            } else {
            PG8_LDB(B0, 0, 0); PG8_SCHED; PG8_LDA(At, 0, 0); PG8_STAGE(PG8_SA(1, 1), a1 + hstep, voffA);
            PG8_WAIT_L(8); PG8_BAR; PG8_WAIT_L(0); PG8_MMA(0, 0, At, B0); PG8_BAR; PG8_SCHED;
            PG8_LDB(B1, 0, 1); PG8_STAGE(PG8_SB(0, 0), b2, voffB);
            PG8_BAR; PG8_WAIT_L(0); PG8_MMA(0, 1, At, B1); PG8_BAR;
            PG8_LDA(At, 0, 1); PG8_STAGE(PG8_SA(0, 0), a2, voffA);
            PG8_BAR; PG8_WAIT_L(0); PG8_MMA(1, 0, At, B0); PG8_BAR; PG8_SCHED;
            PG8_STAGE(PG8_SB(0, 1), b2 + hstep, voffB);
            PG8_WAIT_V(6); PG8_BAR; PG8_MMA(1, 1, At, B1); PG8_BAR;
            PG8_LDB(B0, 1, 0); PG8_SCHED; PG8_LDA(At, 1, 0); PG8_STAGE(PG8_SA(0, 1), a2 + hstep, voffA);
            PG8_WAIT_L(8); PG8_BAR; PG8_WAIT_L(0); PG8_MMA(0, 0, At, B0); PG8_BAR; PG8_SCHED;
            PG8_LDB(B1, 1, 1); PG8_STAGE(PG8_SB(1, 0), b3, voffB);
            PG8_BAR; PG8_WAIT_L(0); PG8_MMA(0, 1, At, B1); PG8_BAR;
            PG8_LDA(At, 1, 1); PG8_STAGE(PG8_SA(1, 0), a3, voffA);
            PG8_BAR; PG8_WAIT_L(0); PG8_MMA(1, 0, At, B0); PG8_BAR; PG8_SCHED;
            PG8_STAGE(PG8_SB(1, 1), b3 + hstep, voffB);
            PG8_WAIT_V(6); PG8_BAR; PG8_MMA(1, 1, At, B1); PG8_BAR;
            }
        }
        if constexpr (ALIGN_EPI) { if (wr == 0) PG8_BAR; }
        if constexpr (!Epi::AFTER_DRAIN) { E(acc, cur, wr, wc, fr, fq); S.done(cur); }
        if (!has_next) break;
#pragma unroll
        for (int a = 0; a < 2; ++a)
#pragma unroll
            for (int b = 0; b < 2; ++b)
#pragma unroll
                for (int m = 0; m < 4; ++m)
#pragma unroll
                    for (int n = 0; n < 2; ++n) acc[a][b][m][n] = (f32x4){0.f, 0.f, 0.f, 0.f};
        cur = nxt; cA = nA; cB = nB; ++ui;
        if constexpr (ALIGN_EPI) { if (wr == 1) PG8_BAR; }
    }
    PG8_WAIT_V(0);
    if constexpr (!ALIGN_EPI) { if (wr == 0) PG8_BAR; }
    PG8_BAR;
    if constexpr (Epi::AFTER_DRAIN) { E.fused(acc, cur, wr, wc, fr, fq, lds, wid, lane); S.done(cur); }
#undef PG8_SA
#undef PG8_SB
#undef PG8_STAGE
#undef PG8_LDA
#undef PG8_LDB
#undef PG8_MMA
#undef PG8_WAIT_V
#undef PG8_WAIT_L
#undef PG8_BAR
#undef PG8_SCHED
}
}
#define LAS __attribute__((address_space(3)))
typedef unsigned short bf16;
typedef unsigned v4u __attribute__((ext_vector_type(4)));
typedef float f32x4 __attribute__((ext_vector_type(4)));

constexpr int NB = 8, S = 2048, D = 1024, M = NB * S, NU = 3584, DFF = 2816, MEML = 256, MROWS = NB * MEML, DX = 512;
constexpr size_t MiB = 1u << 20;
constexpr size_t WS_SSQ = 0;
constexpr size_t WS_SSQM = 512 * 1024;
constexpr size_t WS_BAR = 768 * 1024, BAR_BYTES = 32768;
constexpr int LDS_BARST = 147392;
constexpr size_t WS_PRM = 800 * 1024;
constexpr size_t WS_W = 1 * MiB, W_LAYER = 29 * MiB + MiB / 2;
constexpr size_t OW_IN = 0, OW_OUT = 7 * MiB, OW_XQ = 9 * MiB, OW_XKV = 10 * MiB, OW_XO = 12 * MiB, OW_GU = 13 * MiB, OW_DN = 24 * MiB;
constexpr size_t WS_U = 60 * MiB;
constexpr size_t WS_Y = 172 * MiB;
constexpr size_t WS_QX = 172 * MiB, WS_OX = 188 * MiB;
constexpr size_t WS_HB = 204 * MiB;
constexpr size_t WS_MEMB = 236 * MiB;
constexpr size_t WS_KV = 240 * MiB;
constexpr size_t WS_SSQP = 248 * MiB;
constexpr size_t WS_END = 256 * MiB;
constexpr int LDS_BYTES = 147456;

__device__ __forceinline__ unsigned f2bf(float f) { unsigned u = __builtin_bit_cast(unsigned, f); return (u + 0x7fffu + ((u >> 16) & 1u)) >> 16; }
__device__ __forceinline__ unsigned pk2(float lo, float hi) { return f2bf(lo) | (f2bf(hi) << 16); }
__device__ __forceinline__ float bf2f(unsigned short v) { return __uint_as_float(((unsigned)v) << 16); }
__device__ __forceinline__ float lo_f(unsigned w) { return __uint_as_float(w << 16); }
__device__ __forceinline__ float hi_f(unsigned w) { return __uint_as_float(w & 0xffff0000u); }
__device__ __forceinline__ float log_sigmoid_f(float x) { return fminf(x, 0.f) - __logf(1.0f + __expf(-fabsf(x))); }
__device__ __forceinline__ float sigmoid_f(float x) { return __builtin_amdgcn_rcpf(1.0f + __expf(-x)); }
__device__ __forceinline__ float wave_sum(float v) {
#pragma unroll
    for (int o = 1; o < 64; o <<= 1) v += __shfl_xor(v, o);
    return v;
}

#define XB_TMO      128
#define XB_XCNT(j)  (256  + 64 * (j))
#define XB_XSUB(j)  (1280 + 64 * (j))
#define XB_XGEN(j)  (2304 + 64 * (j))
#define XB_TOP      3328
#define XB_TOPGEN   3392
#define XCD_BAR_WORDS 3456
#define XB_SPIN_CAP (1u << 18)

__device__ __forceinline__ unsigned xb_ld(unsigned* p)              { return __hip_atomic_load(p, __ATOMIC_RELAXED, __HIP_MEMORY_SCOPE_AGENT); }
__device__ __forceinline__ unsigned xb_add(unsigned* p, unsigned v) { return __hip_atomic_fetch_add(p, v, __ATOMIC_RELAXED, __HIP_MEMORY_SCOPE_AGENT); }
__device__ __forceinline__ unsigned xb_xcc_id() { return (unsigned)__builtin_amdgcn_s_getreg((3 << 11) | 20) & 0xFu; }
#define XB_SPIN(cond, bar) do { unsigned _sp = 0; while (cond) { __builtin_amdgcn_s_sleep(1); \
    if ((++_sp & 255u) == 0u) { if (xb_ld(&(bar)[XB_TMO])) break; if (_sp > XB_SPIN_CAP) { atomicAdd(&(bar)[XB_TMO], 1u); break; } } } } while (0)

struct XcdBarrier {
    unsigned* bar; unsigned x;
    volatile LAS unsigned* st;
};

__device__ __forceinline__ XcdBarrier xcd_barrier_post(unsigned* bar, volatile LAS unsigned* st) {
    XcdBarrier b; b.bar = bar; b.x = xb_xcc_id(); b.st = st;
    if (threadIdx.x == 0) (void)xb_add(&bar[XB_XCNT(b.x)], 1u);
    return b;
}
__device__ __forceinline__ void xcd_barrier_complete(unsigned* bar, unsigned x, unsigned& nloc, unsigned& nx) {
    const unsigned G = gridDim.x * gridDim.y * gridDim.z;
    unsigned sum, cnt, mine, sp = 0u;
    for (;;) {
        sum = 0u; cnt = 0u; mine = 0u;
#pragma unroll
        for (unsigned j = 0; j < 16; ++j) { const unsigned c = xb_ld(&bar[XB_XCNT(j)]); sum += c; cnt += (c > 0u) ? 1u : 0u; mine = (j == x) ? c : mine; }
        if (sum == G) break;
        __builtin_amdgcn_s_sleep(1);
        if ((++sp & 255u) == 0u) { if (xb_ld(&bar[XB_TMO])) break; if (sp > XB_SPIN_CAP) { atomicAdd(&bar[XB_TMO], 1u); break; } }
    }
    nloc = mine > 0u ? mine : 1u; nx = cnt > 0u ? cnt : 1u;
}

__device__ __forceinline__ void xcd_barrier(const XcdBarrier& b) {
    asm volatile("s_waitcnt vmcnt(0)" ::: "memory");
    __syncthreads();
    if (threadIdx.x == 0) {
        unsigned* bar = b.bar;
        __builtin_amdgcn_s_waitcnt(0);
        unsigned nloc = b.st[0], nx = b.st[1];
        if (nloc == 0u) { xcd_barrier_complete(bar, b.x, nloc, nx); b.st[0] = nloc; b.st[1] = nx; }
        const unsigned old = xb_add(&bar[XB_XSUB(b.x)], 1u);
        const unsigned gen = old / nloc;
        if (old + 1u == (gen + 1u) * nloc) {
            __builtin_amdgcn_fence(__ATOMIC_RELEASE, "agent");
            asm volatile("s_waitcnt vmcnt(0)" ::: "memory");
            const unsigned og = xb_add(&bar[XB_TOP], 1u);
            const unsigned tg = og / nx;
            if (og + 1u == (tg + 1u) * nx) xb_add(&bar[XB_TOPGEN], 1u);
            else XB_SPIN(xb_ld(&bar[XB_TOPGEN]) == tg, bar);
            __builtin_amdgcn_fence(__ATOMIC_ACQUIRE, "agent");
            xb_add(&bar[XB_XGEN(b.x)], 1u);
            asm volatile("s_waitcnt vmcnt(0)" ::: "memory");
        } else {
            XB_SPIN(xb_ld(&bar[XB_XGEN(b.x)]) == gen, bar);
            __builtin_amdgcn_fence(__ATOMIC_ACQUIRE, "agent");
            asm volatile("s_waitcnt vmcnt(0)" ::: "memory");
        }
    }
    __syncthreads();
}

__device__ __forceinline__ void conv_item(const float* W0, const float* W1, int pitch, int K, int mode, const float* rowscale, bf16* WT, LAS float* scr, int item, int nblk, int lane) {
    const int kb = item / nblk, nb = item % nblk, k0 = 64 * kb, n0 = 32 * nb;
    const int n = n0 + (lane & 31);
    const float* src = nullptr;
    if (mode == 0) src = W0 + n;
    else if (mode == 1) { if (n < 1152) src = W0 + n; else if (n < 3456) src = W0 + n + 6; else if (n < 3462) src = W0 + 1152 + (n - 3456); else if (n < 3474) src = W0 + n; }
    else { const int t = n >> 8, j = n & 255; src = (j < 128) ? (W0 + 128 * t + j) : (W1 + 128 * t + (j - 128)); }
#pragma unroll
    for (int i = 0; i < 32; ++i) { const int kk = 2 * i + (lane >> 5); float v = src ? src[(size_t)(k0 + kk) * pitch] : 0.f; if (rowscale) v *= rowscale[k0 + kk]; scr[kk * 33 + (lane & 31)] = v; }
    asm volatile("s_waitcnt lgkmcnt(0)" ::: "memory");
    const int c = lane & 7;
#pragma unroll
    for (int j = 0; j < 4; ++j) { const int nn = (lane >> 3) + 8 * j; const LAS float* s = scr + (8 * c) * 33 + nn;
        v4u o; o.x = pk2(s[0 * 33], s[1 * 33]); o.y = pk2(s[2 * 33], s[3 * 33]); o.z = pk2(s[4 * 33], s[5 * 33]); o.w = pk2(s[6 * 33], s[7 * 33]);
        *(v4u*)(WT + (size_t)(n0 + nn) * K + k0 + 8 * c) = o; }
    asm volatile("s_waitcnt lgkmcnt(0)" ::: "memory");
}
__device__ __forceinline__ void conv_block_item(const float* W0, const float* W1, int pitch, int K, int mode, const float* rowscale, bf16* WT, LAS float* tile, int kb, int nb, int tid) {
    const int k0 = 64 * kb, n0 = 256 * nb, c4 = (tid & 63) * 4;
#pragma unroll
    for (int i = 0; i < 8; ++i) { const int row = 8 * i + (tid >> 6); f32x4 v = {0.f, 0.f, 0.f, 0.f};
        const float* rp = W0 + (size_t)(k0 + row) * pitch;
        if (mode == 0) v = *(const f32x4*)(rp + n0 + c4);
        else if (mode == 2) { const float* rq = (c4 < 128 ? rp : W1 + (size_t)(k0 + row) * pitch) + 128 * nb + (c4 & 127); v = *(const f32x4*)rq; }
        else {
#pragma unroll
            for (int j = 0; j < 4; ++j) { const int n = n0 + c4 + j; int sc = -1;
                if (n < 1152) sc = n; else if (n < 3456) sc = n + 6; else if (n < 3462) sc = 1152 + (n - 3456); else if (n < 3474) sc = n;
                v[j] = sc >= 0 ? rp[sc] : 0.f; } }
        if (rowscale) v = v * rowscale[k0 + row];
        LAS float* d = tile + row * 257 + c4; d[0] = v[0]; d[1] = v[1]; d[2] = v[2]; d[3] = v[3]; }
    __syncthreads();
    const int q = tid & 7;
#pragma unroll
    for (int pass = 0; pass < 4; ++pass) { const int nl = (tid >> 3) + 64 * pass; const LAS float* sp = tile + (8 * q) * 257 + nl;
        v4u o; o.x = pk2(sp[0], sp[257]); o.y = pk2(sp[2 * 257], sp[3 * 257]); o.z = pk2(sp[4 * 257], sp[5 * 257]); o.w = pk2(sp[6 * 257], sp[7 * 257]);
        *(v4u*)(WT + (size_t)(n0 + nl) * K + k0 + 8 * q) = o; }
    __syncthreads();
}
__device__ __forceinline__ void row_to_bf16_ssq(const float* xrow, bf16* orow, float* ssq_out, int lane) {
    const f32x4* xr = (const f32x4*)xrow + lane; f32x4 v[4]; float s2 = 0.f;
#pragma unroll
    for (int j = 0; j < 4; ++j) { v[j] = xr[64 * j]; s2 += (v[j].x * v[j].x + v[j].y * v[j].y) + (v[j].z * v[j].z + v[j].w * v[j].w); }
    s2 = wave_sum(s2);
    unsigned long long* o8 = (unsigned long long*)orow + lane;
#pragma unroll
    for (int j = 0; j < 4; ++j) o8[64 * j] = (unsigned long long)pk2(v[j].x, v[j].y) | ((unsigned long long)pk2(v[j].z, v[j].w) << 32);
    if (lane < 16) ssq_out[lane] = lane == 0 ? s2 : 0.f;
}

typedef short s16x8 __attribute__((ext_vector_type(8)));
typedef short s16x4 __attribute__((ext_vector_type(4)));
typedef float f32x16 __attribute__((ext_vector_type(16)));
__device__ __forceinline__ s16x4 tr_read(LAS const unsigned char* p) { return __builtin_bit_cast(s16x4, __builtin_amdgcn_ds_read_tr16_b64_v4i16((LAS s16x4*)p)); }
__device__ __forceinline__ s16x8 cat8(s16x4 a, s16x4 b) { return (s16x8){a[0], a[1], a[2], a[3], b[0], b[1], b[2], b[3]}; }
__device__ __forceinline__ unsigned cvtpk(float lo, float hi) { return pg8::cvt_pk_bf16(lo, hi); }
__device__ __forceinline__ s16x8 pack8(float a0, float a1, float a2, float a3, float a4, float a5, float a6, float a7) {
    v4u w; w.x = cvtpk(a0, a1); w.y = cvtpk(a2, a3); w.z = cvtpk(a4, a5); w.w = cvtpk(a6, a7); return __builtin_bit_cast(s16x8, w); }
#define MFMA32(a, b, c) __builtin_amdgcn_mfma_f32_32x32x16_bf16(a, b, c, 0, 0, 0)
__device__ __forceinline__ float xh_sum(float x) { auto rr = __builtin_amdgcn_permlane32_swap(__float_as_uint(x), __float_as_uint(x), false, false); return __uint_as_float(rr[0]) + __uint_as_float(rr[1]); }
__device__ __forceinline__ float xh_max(float x) { auto rr = __builtin_amdgcn_permlane32_swap(__float_as_uint(x), __float_as_uint(x), false, false); return fmaxf(__uint_as_float(rr[0]), __uint_as_float(rr[1])); }
__device__ __forceinline__ float xh_prod(float x) { auto rr = __builtin_amdgcn_permlane32_swap(__float_as_uint(x), __float_as_uint(x), false, false); return __uint_as_float(rr[0]) * __uint_as_float(rr[1]); }
__device__ __forceinline__ float xh_other(float x) { auto rr = __builtin_amdgcn_permlane32_swap(__float_as_uint(x), __float_as_uint(x), false, false); return __uint_as_float(rr[0] == __float_as_uint(x) ? rr[1] : rr[0]); }
__device__ __forceinline__ void st_wt64(float* p, float a, float b) { __hip_atomic_store((unsigned long long*)p, ((unsigned long long)__float_as_uint(b) << 32) | (unsigned long long)__float_as_uint(a), __ATOMIC_RELAXED, __HIP_MEMORY_SCOPE_AGENT); }
__device__ __forceinline__ void st_wt32(float* p, float a) { __hip_atomic_store((unsigned*)p, __float_as_uint(a), __ATOMIC_RELAXED, __HIP_MEMORY_SCOPE_AGENT); }
__device__ __forceinline__ void fox_cumsum_item(const bf16* u, const float* foxb, float* cl, float* tot, int item, int lane) {
    const int bhf = item >> 3, seg = item & 7, b = bhf / 6, h = bhf % 6;
    const float fb = foxb[h];
    const bf16* p = u + ((size_t)b * S + seg * 256 + 4 * lane) * NU + 3456 + h;
    const float L2E = 1.4426950408889634f;
    float l0 = L2E * log_sigmoid_f(bf2f(p[0]) + fb), l1 = L2E * log_sigmoid_f(bf2f(p[NU]) + fb), l2 = L2E * log_sigmoid_f(bf2f(p[2 * NU]) + fb), l3 = L2E * log_sigmoid_f(bf2f(p[3 * NU]) + fb);
    l1 += l0; l2 += l1; l3 += l2;
    float inc = l3;
#pragma unroll
    for (int o = 1; o < 64; o <<= 1) { const float v = __shfl_up(inc, o, 64); if (lane >= o) inc += v; }
    const float ex = inc - l3;
    { float* d = cl + (size_t)bhf * S + seg * 256 + 4 * lane; st_wt64(d, ex + l0, ex + l1); st_wt64(d + 2, ex + l2, ex + l3); }
    if (lane == 63) st_wt32(tot + bhf * 8 + seg, inc);
}
constexpr int PV64 = 144;
__device__ __forceinline__ void attn_mfma_item(const bf16* u, bf16* y, const float* cl, const float* tot, LAS unsigned char* wl, int item, int lane) {
    const int bh = item % 80, qb = 63 - item / 80;
    const bool fox = bh < 48;
    int b, h, qoff, koff, voff, yoff;
    if (fox) { b = bh / 6; h = bh % 6; qoff = h * 64; koff = 384 + h * 64; voff = 768 + h * 64; yoff = h * 64; }
    else { const int rr = bh - 48; b = rr / 4; h = rr % 4; qoff = 1152 + h * 64; koff = 1408 + h * 64; voff = 1664 + h * 64; yoff = 384 + h * 64; }
    const int r = lane & 31, hi = lane >> 5;
    const char* ubc = (const char*)(u + (size_t)b * S * NU);
    const int t = qb * 32 + r;
    const float* clh = cl + (size_t)(fox ? bh : 0) * S;
    s16x8 Qf[4];
    { const unsigned qo = (unsigned)(t * NU + qoff + 8 * hi) * 2u;
#pragma unroll
      for (int d0 = 0; d0 < 4; ++d0) Qf[d0] = *(const s16x8*)(ubc + qo + 32 * d0);
      if (!fox) {
          const float qs = -0.125f * 1.4426950408889634f;
#pragma unroll
          for (int d0 = 0; d0 < 4; ++d0) { const v4u w = __builtin_bit_cast(v4u, Qf[d0]);
              Qf[d0] = pack8(lo_f(w.x) * qs, hi_f(w.x) * qs, lo_f(w.y) * qs, hi_f(w.y) * qs, lo_f(w.z) * qs, hi_f(w.z) * qs, lo_f(w.w) * qs, hi_f(w.w) * qs); } } }
    f32x16 O0, O1;
#pragma unroll
    for (int i = 0; i < 16; ++i) { O0[i] = 0.f; O1[i] = 0.f; }
    float mrun = -1e30f, lsum = 0.f, Rsb = 1.f, Doff = 0.f;
    const float clt = fox ? clh[t] : 0.f;
    LAS float* gl = (LAS float*)(wl + 4608);
    const int trbase = (4 * hi + ((lane >> 2) & 3)) * PV64 + (16 * ((lane >> 4) & 1) + 4 * (lane & 3)) * 2;
    const unsigned lane_off = (unsigned)((lane >> 3) * NU + 8 * (lane & 7)) * 2u;
    v4u kn[4], vn[4]; float gn = 0.f;
    { const char* tb = ubc + (size_t)(qb * 32) * NU * 2;
#pragma unroll
      for (int i = 0; i < 4; ++i) { kn[i] = *(const v4u*)(tb + (size_t)(8 * i * NU + koff) * 2 + lane_off); vn[i] = *(const v4u*)(tb + (size_t)(8 * i * NU + voff) * 2 + lane_off); }
      if (fox) gn = clh[qb * 32 + r]; }
    LAS unsigned char* kl = wl + 4736;
    const int kfoff = r * PV64 + 16 * hi;
    const float SC2 = 0.125f * 1.4426950408889634f;
    { LAS unsigned char* z = wl + 9344 + (lane >> 3) * PV64 + 16 * (lane & 7);
#pragma unroll
      for (int i = 0; i < 4; ++i) *(LAS v4u*)(z + 8 * i * PV64) = (v4u){0u, 0u, 0u, 0u}; }
    s16x8 Pp0 = {0, 0, 0, 0, 0, 0, 0, 0}, Pp1 = {0, 0, 0, 0, 0, 0, 0, 0};
    int vlast = 0;
    for (int jt = qb; jt >= 0; --jt) {
        const bool diag = (jt == qb);
        const int vcur = ((qb - jt) & 1) ? 9344 : 0, vprev = 9344 - vcur; vlast = vcur;
        { LAS unsigned char* dk = kl + (lane >> 3) * PV64 + 16 * (lane & 7); LAS unsigned char* dv = wl + vcur + (lane >> 3) * PV64 + 16 * (lane & 7);
#pragma unroll
          for (int i = 0; i < 4; ++i) { *(LAS v4u*)(dk + 8 * i * PV64) = kn[i]; *(LAS v4u*)(dv + 8 * i * PV64) = vn[i]; } }
        if (fox) gl[r] = -gn;
        if (jt > 0) { const char* tb = ubc + (size_t)((jt - 1) * 32) * NU * 2;
#pragma unroll
          for (int i = 0; i < 4; ++i) { kn[i] = *(const v4u*)(tb + (size_t)(8 * i * NU + koff) * 2 + lane_off); vn[i] = *(const v4u*)(tb + (size_t)(8 * i * NU + voff) * 2 + lane_off); }
          if (fox) gn = clh[(jt - 1) * 32 + r]; }
        s16x8 Kf[4];
#pragma unroll
        for (int d0 = 0; d0 < 4; ++d0) Kf[d0] = *(LAS const s16x8*)(kl + kfoff + 32 * d0);
        LAS const unsigned char* vb = wl + vprev + trbase;
        const s16x8 V00 = cat8(tr_read(vb), tr_read(vb + 8 * PV64)), V01 = cat8(tr_read(vb + 16 * PV64), tr_read(vb + 24 * PV64));
        const s16x8 V10 = cat8(tr_read(vb + 64), tr_read(vb + 8 * PV64 + 64)), V11 = cat8(tr_read(vb + 16 * PV64 + 64), tr_read(vb + 24 * PV64 + 64));
        f32x16 Sx;
#pragma unroll
        for (int i = 0; i < 16; ++i) Sx[i] = 0.f;
        Sx = MFMA32(Kf[0], Qf[0], Sx); O0 = MFMA32(V00, Pp0, O0);
        Sx = MFMA32(Kf[1], Qf[1], Sx); O1 = MFMA32(V10, Pp0, O1);
        Sx = MFMA32(Kf[2], Qf[2], Sx); O0 = MFMA32(V01, Pp1, O0);
        Sx = MFMA32(Kf[3], Qf[3], Sx); O1 = MFMA32(V11, Pp1, O1);
        float P[16];
        if (fox) {
            const float off = clt + Doff;
            float tmax = -1e30f;
#pragma unroll
            for (int g = 0; g < 4; ++g) { const f32x4 ncs = *(LAS const f32x4*)(gl + 8 * g + 4 * hi);
#pragma unroll
                for (int e = 0; e < 4; ++e) P[4 * g + e] = fmaf(SC2, Sx[4 * g + e], ncs[e]); }
            if (diag) {
#pragma unroll
                for (int i = 0; i < 16; ++i) { const int sl = 8 * (i >> 2) + 4 * hi + (i & 3); if (sl > r) P[i] = -1e30f; } }
#pragma unroll
            for (int i = 0; i < 16; ++i) tmax = fmaxf(tmax, P[i]);
            tmax = xh_max(tmax) + off;
            if (__any(tmax > mrun)) {
                const float mnew = fmaxf(mrun, tmax), alpha = __builtin_amdgcn_exp2f(mrun - mnew); lsum *= alpha; mrun = mnew;
#pragma unroll
                for (int i = 0; i < 16; ++i) { O0[i] *= alpha; O1[i] *= alpha; } }
            const float msh = mrun - off; float ps = 0.f;
#pragma unroll
            for (int i = 0; i < 16; ++i) { P[i] = __builtin_amdgcn_exp2f(P[i] - msh); ps += P[i]; }
            lsum += ps;
            if (jt > 0 && ((jt - 1) >> 3) != (jt >> 3)) Doff += tot[bh * 8 + ((jt - 1) >> 3)];
        } else {
            float kp[16], gs[4], go[4]; float T = 1.f;
#pragma unroll
            for (int i = 0; i < 16; ++i) { const float ee = __builtin_amdgcn_exp2f(Sx[i]); const float sig = __builtin_amdgcn_rcpf(1.0f + ee); P[i] = sig; kp[i] = 1.0f - sig; }
            if (diag) {
#pragma unroll
                for (int i = 0; i < 16; ++i) { const int sl = 8 * (i >> 2) + 4 * hi + (i & 3); if (sl >= r) { P[i] = 0.f; kp[i] = 1.f; } } }
#pragma unroll
            for (int g = 0; g < 4; ++g) { gs[g] = (kp[4 * g] * kp[4 * g + 1]) * (kp[4 * g + 2] * kp[4 * g + 3]); T *= gs[g]; }
#pragma unroll
            for (int g = 0; g < 4; ++g) go[g] = xh_other(gs[g]);
            float above = Rsb;
#pragma unroll
            for (int g = 3; g >= 0; --g) {
                float suf = hi == 0 ? above * go[g] : above;
#pragma unroll
                for (int e = 3; e >= 0; --e) { const float a = P[4 * g + e] * suf; suf *= kp[4 * g + e]; P[4 * g + e] = a; }
                above *= gs[g] * go[g];
            }
            Rsb *= xh_prod(T);
        }
        Pp0 = pack8(P[0], P[1], P[2], P[3], P[4], P[5], P[6], P[7]); Pp1 = pack8(P[8], P[9], P[10], P[11], P[12], P[13], P[14], P[15]);
        if (!fox && __all(Rsb == 0.0f)) break;
    }
    { LAS const unsigned char* vb = wl + vlast + trbase;
      const s16x8 V00 = cat8(tr_read(vb), tr_read(vb + 8 * PV64)), V01 = cat8(tr_read(vb + 16 * PV64), tr_read(vb + 24 * PV64));
      const s16x8 V10 = cat8(tr_read(vb + 64), tr_read(vb + 8 * PV64 + 64)), V11 = cat8(tr_read(vb + 16 * PV64 + 64), tr_read(vb + 24 * PV64 + 64));
      O0 = MFMA32(V00, Pp0, O0); O1 = MFMA32(V10, Pp0, O1); O0 = MFMA32(V01, Pp1, O0); O1 = MFMA32(V11, Pp1, O1); }
    float inv = 1.0f;
    if (fox) { lsum = xh_sum(lsum); inv = __builtin_amdgcn_rcpf(lsum); }
    char* yb0 = (char*)(y + (size_t)b * S * D); const unsigned yo = (unsigned)(t * D + yoff + 4 * hi) * 2u;
#pragma unroll
    for (int g = 0; g < 4; ++g) {
        unsigned long long w0 = (unsigned long long)cvtpk(O0[4 * g] * inv, O0[4 * g + 1] * inv) | ((unsigned long long)cvtpk(O0[4 * g + 2] * inv, O0[4 * g + 3] * inv) << 32);
        unsigned long long w1 = (unsigned long long)cvtpk(O1[4 * g] * inv, O1[4 * g + 1] * inv) | ((unsigned long long)cvtpk(O1[4 * g + 2] * inv, O1[4 * g + 3] * inv) << 32);
        *(unsigned long long*)(yb0 + yo + 16 * g) = w0; *(unsigned long long*)(yb0 + yo + 64 + 16 * g) = w1; }
}
constexpr int PV128 = 272;
__device__ __forceinline__ void xattn_mfma_item(const bf16* qx, const bf16* kv, bf16* ox, LAS unsigned char* wl, int item, int lane) {
    const int head = item & 3, qblk = item >> 2;
    const int r = lane & 31, hi = lane >> 5;
    const int token = qblk * 32 + r, b = (qblk * 32) / S;
    s16x8 Qf[8];
    { const char* qb_ = (const char*)qx; const unsigned qo = (unsigned)(token * DX + head * 128 + 8 * hi) * 2u;
#pragma unroll
      for (int d0 = 0; d0 < 8; ++d0) Qf[d0] = *(const s16x8*)(qb_ + qo + 32 * d0); }
    f32x16 O[4];
#pragma unroll
    for (int k = 0; k < 4; ++k)
#pragma unroll
        for (int i = 0; i < 16; ++i) O[k][i] = 0.f;
    float mrun = -1e30f, lsum = 0.f;
    const int trbase = (4 * hi + ((lane >> 2) & 3)) * PV128 + (16 * ((lane >> 4) & 1) + 4 * (lane & 3)) * 2;
    const char* kvc = (const char*)(kv + (size_t)b * MEML * 1024);
    const unsigned kfo = (unsigned)(r * 1024 + head * 128 + 8 * hi) * 2u;
    const unsigned vlo = (unsigned)((lane >> 4) * 1024 + 512 + head * 128 + 8 * (lane & 15)) * 2u;
    s16x8 Kn[8]; v4u vn[8];
#pragma unroll
    for (int d0 = 0; d0 < 8; ++d0) Kn[d0] = *(const s16x8*)(kvc + kfo + 32 * d0);
#pragma unroll
    for (int i = 0; i < 8; ++i) vn[i] = *(const v4u*)(kvc + vlo + (size_t)(4 * i) * 2048);
    const float SCX = 0.08838834764831845f * 1.4426950408889634f;
    for (int jt = 0; jt < 8; ++jt) {
        f32x16 Sx;
#pragma unroll
        for (int i = 0; i < 16; ++i) Sx[i] = 0.f;
#pragma unroll
        for (int d0 = 0; d0 < 8; ++d0) Sx = MFMA32(Kn[d0], Qf[d0], Sx);
        { LAS unsigned char* dst = wl + (lane >> 4) * PV128 + 16 * (lane & 15);
#pragma unroll
          for (int i = 0; i < 8; ++i) *(LAS v4u*)(dst + 4 * i * PV128) = vn[i]; }
        if (jt < 7) { const char* tb = kvc + (size_t)((jt + 1) * 32) * 2048;
#pragma unroll
            for (int d0 = 0; d0 < 8; ++d0) Kn[d0] = *(const s16x8*)(tb + kfo + 32 * d0);
#pragma unroll
            for (int i = 0; i < 8; ++i) vn[i] = *(const v4u*)(tb + vlo + (size_t)(4 * i) * 2048); }
        float P[16]; float tmax = -1e30f;
#pragma unroll
        for (int i = 0; i < 16; ++i) { P[i] = Sx[i] * SCX; tmax = fmaxf(tmax, P[i]); }
        tmax = xh_max(tmax);
        if (__any(tmax > mrun)) { const float mnew = fmaxf(mrun, tmax), alpha = __builtin_amdgcn_exp2f(mrun - mnew); lsum *= alpha; mrun = mnew;
#pragma unroll
            for (int k = 0; k < 4; ++k)
#pragma unroll
                for (int i = 0; i < 16; ++i) O[k][i] *= alpha; }
        float ps = 0.f;
#pragma unroll
        for (int i = 0; i < 16; ++i) { P[i] = __builtin_amdgcn_exp2f(P[i] - mrun); ps += P[i]; }
        lsum += ps;
        const s16x8 Pf0 = pack8(P[0], P[1], P[2], P[3], P[4], P[5], P[6], P[7]), Pf1 = pack8(P[8], P[9], P[10], P[11], P[12], P[13], P[14], P[15]);
        LAS const unsigned char* vb = wl + trbase;
#pragma unroll
        for (int k = 0; k < 4; ++k) {
            const s16x8 Va = cat8(tr_read(vb + 64 * k), tr_read(vb + 8 * PV128 + 64 * k)), Vb = cat8(tr_read(vb + 16 * PV128 + 64 * k), tr_read(vb + 24 * PV128 + 64 * k));
            O[k] = MFMA32(Va, Pf0, O[k]); O[k] = MFMA32(Vb, Pf1, O[k]); }
    }
    lsum = xh_sum(lsum); const float inv = __builtin_amdgcn_rcpf(lsum);
    char* oc = (char*)ox; const unsigned oo = (unsigned)(token * DX + head * 128 + 4 * hi) * 2u;
#pragma unroll
    for (int k = 0; k < 4; ++k)
#pragma unroll
        for (int g = 0; g < 4; ++g) {
            const unsigned long long w0 = (unsigned long long)cvtpk(O[k][4 * g] * inv, O[k][4 * g + 1] * inv) | ((unsigned long long)cvtpk(O[k][4 * g + 2] * inv, O[k][4 * g + 3] * inv) << 32);
            *(unsigned long long*)(oc + oo + 64 * k + 16 * g) = w0; }
}

constexpr int ML_WSTRIDE = 18432, ML_RAWK = 0, ML_RAWQ = 5056, ML_WK = 5056, ML_V = 10112, ML_CW = 14720, ML_EB = 16768, ML_NL = 16896, ML_NW = 17152, ML_ITEM_F = 4224;
template <bool OUT>
__device__ __forceinline__ void mlstm_item(const bf16* u, bf16* y, float* scratch, const float* convw, const float* ib, const float* fbias, const float* normw, LAS unsigned char* wl, int bh, int c, int lane) {
    const int b = bh / 6, h = bh % 6, r = lane & 31, hi = lane >> 5;
    const bf16* ub = u + (size_t)b * S * NU;
    LAS float* cw = (LAS float*)(wl + ML_CW); LAS float* eb = (LAS float*)(wl + ML_EB); LAS float* nl = (LAS float*)(wl + ML_NL); LAS float* nwl = (LAS float*)(wl + ML_NW);
    for (int i = lane; i < 512; i += 64) { const int tap = i >> 7, ch = i & 127; cw[i] = convw[tap * 768 + (ch < 64 ? (64 * h + ch) : (384 + 64 * h + (ch - 64)))]; }
    if (OUT) nwl[lane] = normw[h * 64 + lane];
    const float ibh = ib[h], fbh = fbias[h];
    f32x16 X[2][2];
#pragma unroll
    for (int a = 0; a < 2; ++a)
#pragma unroll
        for (int bb = 0; bb < 2; ++bb)
#pragma unroll
            for (int i = 0; i < 16; ++i) X[a][bb][i] = 0.f;
    float nk = 0.f, Gsum = 0.f;
    if (OUT) {
        float dec = 1.f;
        for (int cp = c - 1; cp >= 0; --cp) {
            const float* s0 = scratch + (size_t)(bh * 16 + cp) * ML_ITEM_F;
            f32x16 v0[4];
#pragma unroll
            for (int blk = 0; blk < 4; ++blk) v0[blk] = *(const f32x16*)(s0 + blk * 1024 + lane * 16);
            const float n0 = s0[4096 + lane], g0 = s0[4160];
#pragma unroll
            for (int blk = 0; blk < 4; ++blk) X[blk >> 1][blk & 1] += v0[blk] * dec;
            nk += dec * n0;
            dec *= __expf(g0);
        }
    }
    nl[lane] = nk;
    const int trP = (4 * hi + ((lane >> 2) & 3)) * 144 + (16 * ((lane >> 4) & 1) + 4 * (lane & 3)) * 2;
    const int trN = (8 * hi + ((lane >> 2) & 3)) * 144 + (16 * ((lane >> 4) & 1) + 4 * (lane & 3)) * 2;
    for (int j = 0; j < 4; ++j) {
        const int t0 = c * 128 + j * 32, t = t0 + r;
        const bf16* trow = ub + (size_t)t * NU;
        const unsigned short gfr = trow[3468 + h], gir = trow[3462 + h];
        v4u vv[4], rk[5], rq[5];
        { const bf16* vrow = ub + (size_t)(t0 + (lane >> 3)) * NU + 2688 + 64 * h + 8 * (lane & 7);
#pragma unroll
          for (int i = 0; i < 4; ++i) vv[i] = *(const v4u*)(vrow + (size_t)(8 * i) * NU); }
#pragma unroll
        for (int i = 0; i < 5; ++i) { const int p = lane + 64 * i, row = p >> 3, ch8 = p & 7, tt = t0 - 3 + row; const bool ok = (p < 280) && (tt >= 0);
            const bf16* src = ub + (size_t)(ok ? tt : 0) * NU + 1920 + 64 * h + 8 * ch8;
            rk[i] = ok ? *(const v4u*)(src + 384) : (v4u){0u, 0u, 0u, 0u};
            if (OUT) rq[i] = ok ? *(const v4u*)(src) : (v4u){0u, 0u, 0u, 0u}; }
#pragma unroll
        for (int i = 0; i < 5; ++i) { const int p = lane + 64 * i, row = p >> 3, ch8 = p & 7;
            if (p < 280) { *(LAS v4u*)(wl + ML_RAWK + row * 144 + 16 * ch8) = rk[i]; if (OUT) *(LAS v4u*)(wl + ML_RAWQ + row * 144 + 16 * ch8) = rq[i]; } }
        { LAS unsigned char* dst = wl + ML_V + (lane >> 3) * 144 + 16 * (lane & 7);
#pragma unroll
          for (int i = 0; i < 4; ++i) *(LAS v4u*)(dst + 8 * i * 144) = vv[i]; }
        float bl = log_sigmoid_f(bf2f(gfr) + fbh); const float ii = bf2f(gir) + ibh;
#pragma unroll
        for (int o = 1; o < 32; o <<= 1) { const float v = __shfl_up(bl, o, 32); if (r >= o) bl += v; }
        const float g = __shfl(bl, 31, 32), es = ii - bl;
        eb[r] = es; Gsum += g;
        s16x8 Kf[4], Qf[4]; float dq = 0.f;
#pragma unroll
        for (int part = (OUT ? 0 : 1); part < 2; ++part) {
            LAS unsigned char* raw = wl + (part ? ML_RAWK : ML_RAWQ);
            const float w0 = cw[part * 64 + lane], w1 = cw[128 + part * 64 + lane], w2 = cw[256 + part * 64 + lane], w3 = cw[384 + part * 64 + lane];
            const float sc = part ? 0.125f : 1.0f;
            float xv[35];
#pragma unroll
            for (int i = 0; i < 35; ++i) xv[i] = bf2f(*(LAS const unsigned short*)(raw + i * 144 + 2 * lane));
#pragma unroll
            for (int i = 0; i < 16; ++i) {
                const float a0 = w0 * xv[2 * i] + w1 * xv[2 * i + 1] + w2 * xv[2 * i + 2] + w3 * xv[2 * i + 3];
                const float a1 = w0 * xv[2 * i + 1] + w1 * xv[2 * i + 2] + w2 * xv[2 * i + 3] + w3 * xv[2 * i + 4];
                const unsigned pk = cvtpk(a0 * sc * __builtin_amdgcn_rcpf(1.0f + __expf(-a0)), a1 * sc * __builtin_amdgcn_rcpf(1.0f + __expf(-a1)));
                *(LAS unsigned short*)(raw + (2 * i) * 144 + 2 * lane) = (unsigned short)pk; *(LAS unsigned short*)(raw + (2 * i + 1) * 144 + 2 * lane) = (unsigned short)(pk >> 16); }
#pragma unroll
            for (int f = 0; f < 4; ++f) {
                const unsigned long long p0 = *(LAS const unsigned long long*)(raw + r * 144 + (16 * f + 4 * hi) * 2), p1 = *(LAS const unsigned long long*)(raw + r * 144 + (16 * f + 8 + 4 * hi) * 2);
                const v4u fw = {(unsigned)p0, (unsigned)(p0 >> 32), (unsigned)p1, (unsigned)(p1 >> 32)};
                if (part) Kf[f] = __builtin_bit_cast(s16x8, fw); else Qf[f] = __builtin_bit_cast(s16x8, fw);
                if (OUT && part == 0) { const f32x4 n0 = *(LAS const f32x4*)(nl + 16 * f + 4 * hi), n1 = *(LAS const f32x4*)(nl + 16 * f + 8 + 4 * hi);
                    dq += (lo_f(fw.x) * n0[0] + hi_f(fw.x) * n0[1]) + (lo_f(fw.y) * n0[2] + hi_f(fw.y) * n0[3]) + (lo_f(fw.z) * n1[0] + hi_f(fw.z) * n1[1]) + (lo_f(fw.w) * n1[2] + hi_f(fw.w) * n1[3]); } }
        }
        if (OUT) {
            f32x16 Sx;
#pragma unroll
            for (int i = 0; i < 16; ++i) Sx[i] = 0.f;
#pragma unroll
            for (int f = 0; f < 4; ++f) Sx = MFMA32(Kf[f], Qf[f], Sx);
            float P[16]; float den = 0.f;
#pragma unroll
            for (int g4 = 0; g4 < 4; ++g4) { const f32x4 e4 = *(LAS const f32x4*)(eb + 8 * g4 + 4 * hi);
#pragma unroll
                for (int e = 0; e < 4; ++e) { const int sl = 8 * g4 + 4 * hi + e; const float d = (sl <= r) ? __expf(bl + e4[e]) : 0.f; P[4 * g4 + e] = Sx[4 * g4 + e] * d; den += P[4 * g4 + e]; } }
            den = xh_sum(den); dq = xh_sum(dq);
            const float ebt = __expf(bl);
            const float inv = 1.0f / fmaxf(fabsf(den + ebt * dq), 1.0f);
            const s16x8 Pf0 = pack8(P[0], P[1], P[2], P[3], P[4], P[5], P[6], P[7]), Pf1 = pack8(P[8], P[9], P[10], P[11], P[12], P[13], P[14], P[15]);
            unsigned long long ow[8];
#pragma unroll
            for (int vb = 0; vb < 2; ++vb)
#pragma unroll
                for (int g4 = 0; g4 < 4; ++g4) ow[4 * vb + g4] = *(const unsigned long long*)(trow + 3072 + 64 * h + 32 * vb + 8 * g4 + 4 * hi);
            f32x16 H[2]; float ms = 0.f;
#pragma unroll
            for (int vb = 0; vb < 2; ++vb) {
                LAS const unsigned char* vp = wl + ML_V + trP + 64 * vb;
                f32x16 Zi, Zx;
#pragma unroll
                for (int i = 0; i < 16; ++i) { Zi[i] = 0.f; Zx[i] = 0.f; }
                Zi = MFMA32(cat8(tr_read(vp), tr_read(vp + 8 * 144)), Pf0, Zi); Zi = MFMA32(cat8(tr_read(vp + 16 * 144), tr_read(vp + 24 * 144)), Pf1, Zi);
#pragma unroll
                for (int kb = 0; kb < 2; ++kb)
#pragma unroll
                    for (int sp = 0; sp < 2; ++sp) { const f32x16& xx = X[kb][vb];
                        const s16x8 xa = pack8(xx[8 * sp], xx[8 * sp + 1], xx[8 * sp + 2], xx[8 * sp + 3], xx[8 * sp + 4], xx[8 * sp + 5], xx[8 * sp + 6], xx[8 * sp + 7]);
                        Zx = MFMA32(xa, Qf[2 * kb + sp], Zx); }
#pragma unroll
                for (int i = 0; i < 16; ++i) { const float hv = (Zi[i] + ebt * Zx[i]) * inv; H[vb][i] = hv; ms += hv * hv; }
            }
            ms = xh_sum(ms);
            const float rs = rsqrtf(ms * (1.0f / 64.0f) + 1e-6f);
            bf16* yrow = y + ((size_t)b * S + t) * D + 640 + 64 * h;
#pragma unroll
            for (int vb = 0; vb < 2; ++vb)
#pragma unroll
                for (int g4 = 0; g4 < 4; ++g4) { const int v = 32 * vb + 8 * g4 + 4 * hi;
                    const unsigned o0 = (unsigned)ow[4 * vb + g4], o1 = (unsigned)(ow[4 * vb + g4] >> 32);
                    const f32x4 w4 = *(LAS const f32x4*)(nwl + v);
                    const float y0 = H[vb][4 * g4] * rs * w4[0] * sigmoid_f(lo_f(o0)), y1 = H[vb][4 * g4 + 1] * rs * w4[1] * sigmoid_f(hi_f(o0));
                    const float y2 = H[vb][4 * g4 + 2] * rs * w4[2] * sigmoid_f(lo_f(o1)), y3 = H[vb][4 * g4 + 3] * rs * w4[3] * sigmoid_f(hi_f(o1));
                    *(unsigned long long*)(yrow + v) = (unsigned long long)cvtpk(y0, y1) | ((unsigned long long)cvtpk(y2, y3) << 32); }
        }
        { const float wsc = __expf(g + es), eg = __expf(g);
#pragma unroll
          for (int f = 0; f < 4; ++f) { const v4u kw = __builtin_bit_cast(v4u, Kf[f]);
#pragma unroll
              for (int e = 0; e < 2; ++e) { const unsigned k0 = e ? kw.z : kw.x, k1 = e ? kw.w : kw.y; const int ch = 16 * f + 8 * e + 4 * hi;
                  *(LAS unsigned long long*)(wl + ML_WK + r * 144 + ch * 2) = (unsigned long long)cvtpk(lo_f(k0) * wsc, hi_f(k0) * wsc) | ((unsigned long long)cvtpk(lo_f(k1) * wsc, hi_f(k1) * wsc) << 32); } }
#pragma unroll
          for (int kb = 0; kb < 2; ++kb)
#pragma unroll
              for (int vb = 0; vb < 2; ++vb) { X[kb][vb] *= eg;
#pragma unroll
                  for (int sp = 0; sp < 2; ++sp) { LAS const unsigned char* kp = wl + ML_WK + trN + 16 * sp * 144 + 64 * kb; LAS const unsigned char* vp = wl + ML_V + trN + 16 * sp * 144 + 64 * vb;
                      X[kb][vb] = MFMA32(cat8(tr_read(kp), tr_read(kp + 4 * 144)), cat8(tr_read(vp), tr_read(vp + 4 * 144)), X[kb][vb]); } }
          float dn = 0.f;
#pragma unroll 8
          for (int s2 = 0; s2 < 32; ++s2) dn += bf2f(*(LAS const unsigned short*)(wl + ML_WK + s2 * 144 + 2 * lane));
          nk = eg * nk + dn; nl[lane] = nk; }
    }
    if (!OUT) {
        float* sp = scratch + (size_t)(bh * 16 + c) * ML_ITEM_F;
#pragma unroll
        for (int blk = 0; blk < 4; ++blk) {
#pragma unroll
            for (int i = 0; i < 8; ++i) st_wt64(sp + blk * 1024 + lane * 16 + 2 * i, X[blk >> 1][blk & 1][2 * i], X[blk >> 1][blk & 1][2 * i + 1]); }
        st_wt32(sp + 4096 + lane, nk);
        if (lane == 0) st_wt32(sp + 4160, Gsum);
    }
}

struct Args { const float* in[20]; float* out; unsigned char* ws; };
#define GEMM_PHASE(EpiT, SchedT, g, Sc, E) pg8::gemm_phase<EpiT, SchedT, true, true>(L, g, Sc, E)

__global__ void __launch_bounds__(512, 2) mega_fwd(Args a) {
    extern __shared__ __attribute__((aligned(16))) unsigned char lds[];
    LAS unsigned char* L = (LAS unsigned char*)lds;
    const int tid = threadIdx.x, lane = tid & 63, wave = __builtin_amdgcn_readfirstlane(tid >> 6);
    const int G = gridDim.x, bx = blockIdx.x;
    const int gw = bx * 8 + wave, NGW = G * 8;
    unsigned char* ws = a.ws;
    const float* x = a.in[0]; const float* mem = a.in[1];
    float* out = a.out;
    float* ssq = (float*)(ws + WS_SSQP); float* ssqm = (float*)(ws + WS_SSQP + 7 * MiB);
    bf16* ub = (bf16*)(ws + WS_U); bf16* actb = (bf16*)(ws + WS_U); bf16* yb = (bf16*)(ws + WS_Y); bf16* qxb = (bf16*)(ws + WS_QX); bf16* oxb = (bf16*)(ws + WS_OX);
    bf16* hb = (bf16*)(ws + WS_HB); bf16* memb = (bf16*)(ws + WS_MEMB); bf16* kvb = (bf16*)(ws + WS_KV);

    volatile LAS unsigned* bst = (volatile LAS unsigned*)(L + LDS_BARST); if (tid < 2) bst[tid] = 0u;
    __syncthreads();
    (void)xcd_barrier_post((unsigned*)(a.ws + WS_BAR), bst);
    {
        LAS float* tile = (LAS float*)L;
        constexpr int I_IN = 16 * 14, I_OUT = 16 * 4, I_XQ = 16 * 2, I_XKV = 16 * 4, I_XO = 8 * 4, I_GU = 16 * 22, I_DN = 44 * 4;
        constexpr int I_LAYER = I_IN + I_OUT + I_XQ + I_XKV + I_XO + I_GU + I_DN;
        for (int it = bx; it < 2 * I_LAYER; it += G) {
            const int l = it / I_LAYER; int r = it % I_LAYER;
            unsigned char* wl = ws + WS_W + (size_t)l * W_LAYER;
            if (r < I_IN) { conv_block_item(a.in[3] + (size_t)l * 1024 * 3474, nullptr, 3474, 1024, 1, a.in[2] + l * 1024, (bf16*)(wl + OW_IN), tile, r / 14, r % 14, tid); continue; } r -= I_IN;
            if (r < I_OUT) { conv_block_item(a.in[9] + (size_t)l * 1024 * 1024, nullptr, 1024, 1024, 0, nullptr, (bf16*)(wl + OW_OUT), tile, r / 4, r % 4, tid); continue; } r -= I_OUT;
            if (r < I_XQ) { conv_block_item(a.in[12] + (size_t)l * 1024 * 512, nullptr, 512, 1024, 0, a.in[10] + l * 1024, (bf16*)(wl + OW_XQ), tile, r / 2, r % 2, tid); continue; } r -= I_XQ;
            if (r < I_XKV) { conv_block_item(a.in[13] + (size_t)l * 1024 * 1024, nullptr, 1024, 1024, 0, a.in[11] + l * 1024, (bf16*)(wl + OW_XKV), tile, r / 4, r % 4, tid); continue; } r -= I_XKV;
            if (r < I_XO) { conv_block_item(a.in[14] + (size_t)l * 512 * 1024, nullptr, 1024, 512, 0, nullptr, (bf16*)(wl + OW_XO), tile, r / 4, r % 4, tid); continue; } r -= I_XO;
            if (r < I_GU) { conv_block_item(a.in[16] + (size_t)l * 1024 * DFF, a.in[17] + (size_t)l * 1024 * DFF, DFF, 1024, 2, a.in[15] + l * 1024, (bf16*)(wl + OW_GU), tile, r / 22, r % 22, tid); continue; } r -= I_GU;
            conv_block_item(a.in[18] + (size_t)l * DFF * 1024, nullptr, 1024, DFF, 0, nullptr, (bf16*)(wl + OW_DN), tile, r / 4, r % 4, tid);
        }
        for (int m = gw; m < M; m += NGW) row_to_bf16_ssq(x + (size_t)m * D, hb + (size_t)m * D, ssq + (size_t)m * 16, lane);
        for (int m = gw; m < MROWS; m += NGW) row_to_bf16_ssq(mem + (size_t)m * D, memb + (size_t)m * D, ssqm + (size_t)m * 16, lane);
        { float* prm = (float*)(ws + WS_PRM);
          for (int i = bx * 512 + tid; i < 2 * 8192 + 1024; i += G * 512) {
              float v = 0.f;
              if (i >= 2 * 8192) v = a.in[19][i - 2 * 8192];
              else { const int l = i >> 13, o = i & 8191;
                  if (o < 6) v = a.in[4][l * 6 + o]; else if (o >= 8 && o < 14) v = a.in[6][l * 6 + o - 8]; else if (o >= 16 && o < 22) v = a.in[7][l * 6 + o - 16];
                  else if (o >= 64 && o < 448) v = a.in[8][l * 384 + o - 64]; else if (o >= 512 && o < 3584) v = a.in[5][l * 3072 + o - 512]; }
              prm[i] = v; } }
    }
#define XBAR() do { XcdBarrier xb_; xb_.bar = (unsigned*)(ws + WS_BAR); xb_.x = xb_xcc_id(); xb_.st = (volatile LAS unsigned*)(L + LDS_BARST); xcd_barrier(xb_); } while (0)
    { unsigned char* ws = a.ws; XBAR(); }
    for (int ph = 0; ph < 16; ++ph) {
        const int l = ph >> 3, k = ph & 7;
        size_t zoff = 0; asm volatile("" : "+s"(zoff)); unsigned char* ws = a.ws + zoff;
        const unsigned char* wl = ws + WS_W + (size_t)l * W_LAYER;
        float* ssq = (float*)(ws + WS_SSQP); float* ssqm = (float*)(ws + WS_SSQP + 7 * MiB);
        bf16* ub = (bf16*)(ws + WS_U); bf16* actb = (bf16*)(ws + WS_U); bf16* yb = (bf16*)(ws + WS_Y); bf16* qxb = (bf16*)(ws + WS_QX); bf16* oxb = (bf16*)(ws + WS_OX);
        bf16* hb = (bf16*)(ws + WS_HB); bf16* memb = (bf16*)(ws + WS_MEMB); bf16* kvb = (bf16*)(ws + WS_KV);
        int tid_p = threadIdx.x; asm volatile("" : "+v"(tid_p)); const int lane = tid_p & 63, wave = __builtin_amdgcn_readfirstlane(tid_p >> 6), gw = bx * 8 + wave;
        if (k == 0 || k == 3) {
            const int j0 = (ph == 0) ? 0 : 2;
            for (int j = j0; j < 3; ++j) {
                pg8::Gemm g; pg8::EpiScaleBf16 E; int off = 0;
                if (j < 2) { g = pg8::Gemm{memb, (const bf16*)(ws + WS_W + (size_t)j * W_LAYER + OW_XKV), MROWS, 1024, 1024}; E = pg8::EpiScaleBf16{kvb + (size_t)j * MROWS * 1024, 1024, ssqm}; off = 128 + 32 * j; }
                else if (k == 0) { g = pg8::Gemm{hb, (const bf16*)(wl + OW_IN), M, NU, 1024}; E = pg8::EpiScaleBf16{ub, NU, ssq + (size_t)(3 * l) * M * 16}; }
                else { g = pg8::Gemm{hb, (const bf16*)(wl + OW_XQ), M, DX, 1024}; E = pg8::EpiScaleBf16{qxb, DX, ssq + (size_t)(3 * l + 1) * M * 16}; }
                pg8::OffsetOrder Sc; Sc.init(g.M, g.N, G, bx, off);
                GEMM_PHASE(pg8::EpiScaleBf16, pg8::OffsetOrder, g, Sc, E);
            }
        } else if (k == 2 || k == 5 || k == 7) {
            pg8::Gemm g; pg8::EpiResid E;
            if (k == 2) { g = pg8::Gemm{yb, (const bf16*)(wl + OW_OUT), M, 1024, 1024}; E = pg8::EpiResid{hb, ssq + (size_t)(3 * l + 1) * M * 16}; }
            else if (k == 5) { g = pg8::Gemm{oxb, (const bf16*)(wl + OW_XO), M, 1024, DX}; E = pg8::EpiResid{hb, ssq + (size_t)(3 * l + 2) * M * 16}; }
            else { g = pg8::Gemm{actb, (const bf16*)(wl + OW_DN), M, 1024, DFF}; E = pg8::EpiResid{hb, ssq + (size_t)(3 * l + 3) * M * 16}; }
            pg8::StaticOrder Sc; Sc.init(g.M, g.N, G, bx);
            GEMM_PHASE(pg8::EpiResid, pg8::StaticOrder, g, Sc, E);
        } else if (k == 6) {
            pg8::Gemm g{hb, (const bf16*)(wl + OW_GU), M, 2 * DFF, 1024}; pg8::StaticOrder Sc; Sc.init(M, 2 * DFF, G, bx);
            pg8::EpiSwiglu E{actb, DFF, ssq + (size_t)(3 * l + 2) * M * 16};
            GEMM_PHASE(pg8::EpiSwiglu, pg8::StaticOrder, g, Sc, E);
        } else if (k == 1) {
            const float* prm = (const float*)(ws + WS_PRM) + l * 8192;
            float* mscr = out;
            float* fcl = out + 14 * MiB / 4; float* ftot = out + 15 * MiB / 4;
            const int xcd0 = (int)(xb_xcc_id() & 7u); unsigned okmask = 0u;
            for (int qi = 0; qi < 3; ++qi) {
            const int xcd = (qi == 0) ? xcd0 : (qi == 1 ? (bx & 7) : ((xcd0 + 1) & 7));
            if (qi == 1 && xcd == xcd0) continue;
            unsigned* done = (unsigned*)(ws + WS_BAR + 15360) + 16 * (l * 8 + xcd);
            for (int sj = 0; sj < (qi == 2 ? 1 : 2); ++sj) {
            const int sq = (wave + sj) & 7;
            unsigned* ctr = (unsigned*)(ws + WS_BAR + 16384) + 16 * ((l * 8 + xcd) * 8 + sq);
            for (;;) {
                int it = 0; if (lane == 0) it = (int)atomicAdd(ctr, 1u); it = __builtin_amdgcn_readfirstlane(it) * 8 + sq;
                if (it >= 874) break;
                if (it < 138) {
                    if (it >= 48) mlstm_item<false>(ub, yb, mscr, prm + 512, prm + 8, prm + 16, prm + 64, L + wave * ML_WSTRIDE, xcd + 8 * ((it - 48) / 15), (it - 48) % 15, lane);
                    else fox_cumsum_item(ub, prm, fcl, ftot, (xcd + 8 * (it >> 3)) * 8 + (it & 7), lane);
                    asm volatile("s_waitcnt vmcnt(0)" ::: "memory");
                    if (lane == 0) atomicAdd(done + (it >= 48 ? 8 : 0), 1u);
                } else {
                    const bool isc = (it >= 266 && it < 362), issb = (it >= 362 && it < 618), isfox = !isc && !issb;
                    if (isfox && !((okmask >> xcd) & 1u)) { unsigned sp = 0u;
                        while (__hip_atomic_load(done, __ATOMIC_RELAXED, __HIP_MEMORY_SCOPE_AGENT) < 48u) { __builtin_amdgcn_s_sleep(4); if (++sp > (1u << 21)) break; }
                        __builtin_amdgcn_fence(__ATOMIC_ACQUIRE, "agent"); okmask |= 1u << xcd; }
                    if (isc && !((okmask >> (8 + xcd)) & 1u)) { unsigned sp = 0u;
                        while (__hip_atomic_load(done + 8, __ATOMIC_RELAXED, __HIP_MEMORY_SCOPE_AGENT) < 90u) { __builtin_amdgcn_s_sleep(4); if (++sp > (1u << 21)) break; }
                        __builtin_amdgcn_fence(__ATOMIC_ACQUIRE, "agent"); okmask |= 1u << (8 + xcd); }
                    if (isc) { const int ci = it - 266; mlstm_item<true>(ub, yb, mscr, prm + 512, prm + 8, prm + 16, prm + 64, L + wave * ML_WSTRIDE, xcd + 8 * (ci >> 4), 15 - (ci & 15), lane); }
                    else { int aitem; if (issb) { const int ai = it - 362; aitem = (ai >> 2) * 80 + 48 + xcd + 8 * (ai & 3); } else { const int ai = (it < 266) ? it - 138 : it - 490; aitem = (ai / 6) * 80 + xcd + 8 * (ai % 6); }
                        attn_mfma_item(ub, yb, fcl, ftot, L + wave * ML_WSTRIDE, aitem, lane); }
                }
            }
            }
            }
        } else {
            for (int it = gw; it < 2048; it += NGW) xattn_mfma_item(qxb, kvb + (size_t)l * MROWS * 1024, oxb, L + wave * 16384, it, lane);
        }
        XBAR();
    }
    {
        int tid_f = threadIdx.x; asm volatile("" : "+v"(tid_f)); const int lane = tid_f & 63, gw = bx * 8 + __builtin_amdgcn_readfirstlane(tid_f >> 6);
        const float* fw = (const float*)(a.ws + WS_PRM) + 2 * 8192; const float* sq = (const float*)(a.ws + WS_SSQP) + (size_t)6 * M * 16;
        const bf16* hbf = (const bf16*)(a.ws + WS_HB);
        for (int m = gw; m < M; m += NGW) {
            float sm = 0.f; { const f32x4* qp = (const f32x4*)(sq + (size_t)m * 16); const f32x4 q0 = qp[0], q1 = qp[1], q2 = qp[2], q3 = qp[3];
              sm = ((((q0[0] + q0[1]) + (q0[2] + q0[3])) + ((q1[0] + q1[1]) + (q1[2] + q1[3]))) + (((q2[0] + q2[1]) + (q2[2] + q2[3])) + ((q3[0] + q3[1]) + (q3[2] + q3[3])))); }
            const float rs = rsqrtf(sm * (1.0f / 1024.0f) + 1e-6f);
            const unsigned long long* hp = (const unsigned long long*)(hbf + (size_t)m * D) + lane; f32x4* rp = (f32x4*)(out + (size_t)m * D) + lane; const f32x4* wp = (const f32x4*)fw + lane;
#pragma unroll
            for (int j = 0; j < 4; ++j) { const unsigned long long hw = hp[64 * j]; const unsigned h0 = (unsigned)hw, h1 = (unsigned)(hw >> 32); const f32x4 w = wp[64 * j];
                f32x4 v = {lo_f(h0), hi_f(h0), lo_f(h1), hi_f(h1)}; v = v * rs * w; rp[64 * j] = v; }
        }
    }
}

extern "C" void kernel_launch(void* const* d_in, const int* in_sizes, int n_in, void* d_out, int out_size, void* d_ws, size_t ws_size, hipStream_t stream) {
    static int grid = 0;
    if (grid == 0) {
        if (n_in != 20 || out_size != M * D || ws_size < WS_END) { fprintf(stderr, "kernel_launch: unexpected shapes (n_in %d out %d ws %zu)\n", n_in, out_size, ws_size); grid = -1; return; }
        int dev = 0, cus = 0, per_cu = 0;
        hipGetDevice(&dev); hipDeviceGetAttribute(&cus, hipDeviceAttributeMultiprocessorCount, dev);
        if (hipFuncSetAttribute((const void*)mega_fwd, hipFuncAttributeMaxDynamicSharedMemorySize, LDS_BYTES) != hipSuccess) { fprintf(stderr, "kernel_launch: hipFuncSetAttribute failed\n"); grid = -1; return; }
        if (hipOccupancyMaxActiveBlocksPerMultiprocessor(&per_cu, (const void*)mega_fwd, 512, LDS_BYTES) != hipSuccess || per_cu < 1) { fprintf(stderr, "kernel_launch: occupancy query says %d\n", per_cu); (void)hipGetLastError(); per_cu = 1; }
        grid = cus * per_cu;
    }
    if (grid < 0) return;
    Args a{};
    for (int i = 0; i < 20; ++i) a.in[i] = (const float*)d_in[i];
    a.out = (float*)d_out; a.ws = (unsigned char*)d_ws;
    if (hipMemsetAsync((char*)d_ws + WS_BAR, 0, BAR_BYTES, stream) != hipSuccess) { fprintf(stderr, "kernel_launch: memset of the barrier words failed\n"); return; }
    void* args[] = {&a};
    hipError_t e = hipLaunchCooperativeKernel((const void*)mega_fwd, dim3(grid), dim3(512), args, LDS_BYTES, stream);
    if (e != hipSuccess) fprintf(stderr, "kernel_launch: cooperative launch failed: %s (grid %d)\n", hipGetErrorString(e), grid);
}
```

```cpp
#include <hip/hip_runtime.h>
#include <hip/hip_cooperative_groups.h>
#include <cstdio>
#include <cstdint>
#include <cmath>
namespace cg = cooperative_groups;
namespace pg8 {
#define PG8_LAS __attribute__((address_space(3)))
typedef unsigned short bf16_t;
typedef short bf16x8 __attribute__((ext_vector_type(8)));
typedef float f32x4 __attribute__((ext_vector_type(4)));
typedef unsigned u32x4 __attribute__((ext_vector_type(4)));
constexpr int BM = 256, BK = 64, HALF = 128, HTB = HALF * BK * 2  , STAGE_BYTES = 8 * HTB, NXCD = 8, WGM = 4;

__host__ __device__ __forceinline__ int lds_byte(int r, int c) { const int st = (r >> 4) * 2 + (c >> 5), rr = r & 15, cc = c & 31, ob = rr * 64 + cc * 2; return st * 1024 + (ob ^ (((ob >> 9) & 1) << 5)); }
__host__ __device__ __forceinline__ void stage_rc(int b, int& R, int& C) { const int st = b / 1024, sb = b % 1024, swz = sb ^ (((sb >> 9) & 1) << 5); R = (st >> 1) * 16 + swz / 64; C = (st & 1) * 32 + (swz % 64) / 2; }
__host__ __device__ __forceinline__ int perm32(int rho) { const int n = rho >> 4, i = rho & 15; return 8 * (i >> 2) + 4 * n + (i & 3); }

struct Unit { int pm, pn; };
struct Gemm { const bf16_t* A; const bf16_t* Bt; int M, N, K; };

struct StaticOrder {
    int nM, nN, nwg, G, c;
    __host__ __device__ void init(int M, int N, int G_, int c_) { nM = M / BM; nN = N / BM; nwg = nM * nN; G = G_; c = c_; }
    __host__ __device__ bool next(int i, Unit& u) const {
        const long L = (long)i * G + c; if (L >= nwg) return false;
        int wgid = (int)L; { const int q = nwg / NXCD, r = nwg % NXCD, xcd = wgid % NXCD, off = wgid / NXCD; wgid = (xcd < r ? xcd * (q + 1) : r * (q + 1) + (xcd - r) * q) + off; }
        const int nig = WGM * nN, gid = wgid / nig, fm = gid * WGM, gsz = (nM - fm) < WGM ? (nM - fm) : WGM;
        u.pm = fm + ((wgid % nig) % gsz); u.pn = (wgid % nig) / gsz; return true;
    }
    __device__ __forceinline__ void a_ready(const Unit&) const {}
    __device__ __forceinline__ void done(const Unit&) const {}
};

__device__ __forceinline__ unsigned cvt_pk_bf16(float lo, float hi) { unsigned r; asm volatile("v_cvt_pk_bf16_f32 %0, %1, %2" : "=v"(r) : "v"(lo), "v"(hi)); return r; }
typedef float f32x2 __attribute__((ext_vector_type(2)));
struct OffsetOrder {
    StaticOrder b;
    __device__ void init(int M, int N, int G, int c, int off) { b.init(M, N, G, (c + G - (off % G)) % G); }
    __device__ bool next(int i, Unit& u) const { return b.next(i, u); }
    __device__ __forceinline__ void a_ready(const Unit&) const {}
    __device__ __forceinline__ void done(const Unit&) const {}
};
struct EpiScaleBf16 {
    static constexpr bool PERM = true, AFTER_DRAIN = false;
    bf16_t* O; int ldc; const float* ssq;
    __device__ __forceinline__ void operator()(const f32x4 (&acc)[2][2][4][2], const Unit& u, int wr, int wc, int fr, int fq) const {
        const int row0 = u.pm * BM + wr * 64 + fr, col0 = u.pn * BM + wc * 32 + 8 * fq;
#pragma unroll
        for (int ai = 0; ai < 2; ++ai)
#pragma unroll
            for (int m = 0; m < 4; ++m) { const int row = row0 + ai * HALF + m * 16; const f32x4 q0 = *(const f32x4*)(ssq + (size_t)row * 16), q1 = *(const f32x4*)(ssq + (size_t)row * 16 + 4), q2 = *(const f32x4*)(ssq + (size_t)row * 16 + 8), q3 = *(const f32x4*)(ssq + (size_t)row * 16 + 12);
                const float rs = rsqrtf(((((q0[0] + q0[1]) + (q0[2] + q0[3])) + ((q1[0] + q1[1]) + (q1[2] + q1[3]))) + (((q2[0] + q2[1]) + (q2[2] + q2[3])) + ((q3[0] + q3[1]) + (q3[2] + q3[3])))) * (1.0f / 1024.0f) + 1e-6f);
                bf16_t* rowp = O + (size_t)row * ldc + col0;
#pragma unroll
                for (int bj = 0; bj < 2; ++bj) { const f32x4 v0 = acc[ai][bj][m][0] * rs, v1 = acc[ai][bj][m][1] * rs;
                    u32x4 w; w.x = cvt_pk_bf16(v0[0], v0[1]); w.y = cvt_pk_bf16(v0[2], v0[3]); w.z = cvt_pk_bf16(v1[0], v1[1]); w.w = cvt_pk_bf16(v1[2], v1[3]);
                    *(u32x4*)(rowp + bj * HALF) = w; } }
    }
};
struct EpiResid {
    static constexpr bool PERM = true, AFTER_DRAIN = false;
    bf16_t* hb; float* ssq;
    __device__ __forceinline__ void operator()(const f32x4 (&acc)[2][2][4][2], const Unit& u, int wr, int wc, int fr, int fq) const {
        const int row0 = u.pm * BM + wr * 64 + fr, col0 = u.pn * BM + wc * 32 + 8 * fq;
#pragma unroll
        for (int ai = 0; ai < 2; ++ai)
#pragma unroll
            for (int m = 0; m < 4; ++m) { const int row = row0 + ai * HALF + m * 16; const size_t off = (size_t)row * 1024 + col0; float part = 0.f;
#pragma unroll
                for (int bj = 0; bj < 2; ++bj) { const u32x4 b = *(const u32x4*)(hb + off + bj * HALF);
                    f32x4 v0 = acc[ai][bj][m][0], v1 = acc[ai][bj][m][1];
                    v0[0] += __uint_as_float(b.x << 16); v0[1] += __uint_as_float(b.x & 0xffff0000u); v0[2] += __uint_as_float(b.y << 16); v0[3] += __uint_as_float(b.y & 0xffff0000u);
                    v1[0] += __uint_as_float(b.z << 16); v1[1] += __uint_as_float(b.z & 0xffff0000u); v1[2] += __uint_as_float(b.w << 16); v1[3] += __uint_as_float(b.w & 0xffff0000u);
                    u32x4 w; w.x = cvt_pk_bf16(v0[0], v0[1]); w.y = cvt_pk_bf16(v0[2], v0[3]); w.z = cvt_pk_bf16(v1[0], v1[1]); w.w = cvt_pk_bf16(v1[2], v1[3]);
                    *(u32x4*)(hb + off + bj * HALF) = w;
                    part += (v0[0] * v0[0] + v0[1] * v0[1]) + (v0[2] * v0[2] + v0[3] * v0[3]) + (v1[0] * v1[0] + v1[1] * v1[1]) + (v1[2] * v1[2] + v1[3] * v1[3]); }
                part += __shfl_xor(part, 16); part += __shfl_xor(part, 32);
                if (fq == 0) ssq[(size_t)row * 16 + u.pn * 4 + wc] = part; }
    }
};
struct EpiSwiglu {
    static constexpr bool PERM = true, AFTER_DRAIN = false;
    bf16_t* O; int ldc; const float* ssq;
    __device__ __forceinline__ void operator()(const f32x4 (&acc)[2][2][4][2], const Unit& u, int wr, int wc, int fr, int fq) const {
        const int row0 = u.pm * BM + wr * 64 + fr, col0 = u.pn * HALF + wc * 32 + 8 * fq;
#pragma unroll
        for (int ai = 0; ai < 2; ++ai)
#pragma unroll
            for (int m = 0; m < 4; ++m) { const int row = row0 + ai * HALF + m * 16; const f32x4 q0 = *(const f32x4*)(ssq + (size_t)row * 16), q1 = *(const f32x4*)(ssq + (size_t)row * 16 + 4), q2 = *(const f32x4*)(ssq + (size_t)row * 16 + 8), q3 = *(const f32x4*)(ssq + (size_t)row * 16 + 12);
                const float rs = rsqrtf(((((q0[0] + q0[1]) + (q0[2] + q0[3])) + ((q1[0] + q1[1]) + (q1[2] + q1[3]))) + (((q2[0] + q2[1]) + (q2[2] + q2[3])) + ((q3[0] + q3[1]) + (q3[2] + q3[3])))) * (1.0f / 1024.0f) + 1e-6f);
                float a[8];
#pragma unroll
                for (int n = 0; n < 2; ++n)
#pragma unroll
                    for (int j = 0; j < 4; ++j) { const float g = acc[ai][0][m][n][j] * rs, up = acc[ai][1][m][n][j] * rs; a[4 * n + j] = g * up * __builtin_amdgcn_rcpf(1.0f + __expf(-g)); }
                u32x4 w; w.x = cvt_pk_bf16(a[0], a[1]); w.y = cvt_pk_bf16(a[2], a[3]); w.z = cvt_pk_bf16(a[4], a[5]); w.w = cvt_pk_bf16(a[6], a[7]);
                *(u32x4*)(O + (size_t)row * ldc + col0) = w; }
    }
};
template <class Epi, class Sched, bool ALIGN_EPI = false, bool SP2 = false>
__device__ __forceinline__ void gemm_phase(PG8_LAS unsigned char* lds, const Gemm g, const Sched& S, const Epi& E) {
    int tid_l = threadIdx.x; asm volatile("" : "+v"(tid_l));
    const int tid = tid_l, wid = __builtin_amdgcn_readfirstlane(tid >> 6), lane = tid & 63, wr = wid >> 2, wc = wid & 3, fr = lane & 15, fq = lane >> 4;
    const int K = g.K, nt = K / BK;
    unsigned voffA[2], voffB[2];
#pragma unroll
    for (int i = 0; i < 2; ++i) { int R, C; stage_rc(tid * 16 + i * 8192, R, C); const int Rb = Epi::PERM ? ((R & ~31) + perm32(R & 31)) : R;
        voffA[i] = (unsigned)(R * K + C) * 2u; voffB[i] = (unsigned)(Rb * K + C) * 2u; }
    const size_t kstep = (size_t)(BK * 2);
    const size_t hstep = (size_t)HALF * K * 2;
    const size_t tstep = 2 * hstep;
    const unsigned ldsw = (unsigned)wid * 1024u;
    const int aoff = lds_byte(wr * 64 + fr, fq * 8), boff = lds_byte(wc * 32 + fr, fq * 8);
#define PG8_SA(b, h) (((b) * 2 + (h)) * HTB)
#define PG8_SB(b, h) ((4 + (b) * 2 + (h)) * HTB)
#define PG8_STAGE(bufoff, gbase, voff) do { _Pragma("unroll") for (int _i = 0; _i < 2; ++_i) \
        __builtin_amdgcn_global_load_lds((const unsigned*)((const char*)(gbase) + (voff)[_i]), (PG8_LAS unsigned*)(lds + (bufoff) + ldsw + _i * 8192), 16, 0, 0); } while (0)
#define PG8_LDA(dst, b, h) do { _Pragma("unroll") for (int m = 0; m < 4; ++m) _Pragma("unroll") for (int k = 0; k < 2; ++k) dst[m][k] = *(const PG8_LAS bf16x8*)(lds + PG8_SA(b, h) + aoff + m * 2048 + k * 1024); } while (0)
#define PG8_LDB(dst, b, h) do { _Pragma("unroll") for (int n = 0; n < 2; ++n) _Pragma("unroll") for (int k = 0; k < 2; ++k) dst[n][k] = *(const PG8_LAS bf16x8*)(lds + PG8_SB(b, h) + boff + n * 2048 + k * 1024); } while (0)
#define PG8_MMA(ai, bj, At, Bt) do { __builtin_amdgcn_s_setprio(1); _Pragma("unroll") for (int m = 0; m < 4; ++m) _Pragma("unroll") for (int n = 0; n < 2; ++n) _Pragma("unroll") for (int k = 0; k < 2; ++k) \
        acc[ai][bj][m][n] = __builtin_amdgcn_mfma_f32_16x16x32_bf16(Bt[n][k], At[m][k], acc[ai][bj][m][n], 0, 0, 0); __builtin_amdgcn_s_setprio(0); } while (0)
#define PG8_WAIT_V(n) asm volatile("s_waitcnt vmcnt(" #n ")" ::: "memory")
#define PG8_WAIT_L(n) asm volatile("s_waitcnt lgkmcnt(" #n ")" ::: "memory")
#define PG8_BAR __builtin_amdgcn_s_barrier()
#define PG8_SCHED __builtin_amdgcn_sched_barrier(0)
    Unit cur, nxt; int ui = 0;
    if (!S.next(0, cur)) return;
    f32x4 acc[2][2][4][2];
#pragma unroll
    for (int a = 0; a < 2; ++a)
#pragma unroll
        for (int b = 0; b < 2; ++b)
#pragma unroll
            for (int m = 0; m < 4; ++m)
#pragma unroll
                for (int n = 0; n < 2; ++n) acc[a][b][m][n] = (f32x4){0.f, 0.f, 0.f, 0.f};
    bf16x8 At[4][2], B0[2][2], B1[2][2];
    const char* cA = (const char*)g.A + (size_t)cur.pm * tstep; const char* cB = (const char*)g.Bt + (size_t)cur.pn * tstep;
    S.a_ready(cur);
    if constexpr (SP2) {
        PG8_STAGE(PG8_SB(0, 0), cB, voffB); PG8_STAGE(PG8_SB(0, 1), cB + hstep, voffB); PG8_STAGE(PG8_SA(0, 0), cA, voffA); PG8_STAGE(PG8_SA(0, 1), cA + hstep, voffA);
        if (wr == 1) PG8_BAR;
        PG8_WAIT_V(2); PG8_BAR;
        PG8_STAGE(PG8_SB(1, 0), cB + kstep, voffB); PG8_STAGE(PG8_SA(1, 0), cA + kstep, voffA); PG8_STAGE(PG8_SB(1, 1), cB + hstep + kstep, voffB);
        PG8_WAIT_V(6); PG8_BAR;
    } else {
        PG8_STAGE(PG8_SB(0, 0), cB, voffB); PG8_STAGE(PG8_SA(0, 0), cA, voffA); PG8_STAGE(PG8_SB(0, 1), cB + hstep, voffB); PG8_STAGE(PG8_SA(0, 1), cA + hstep, voffA);
        if (wr == 1) PG8_BAR;
        PG8_WAIT_V(4); PG8_BAR;
        PG8_STAGE(PG8_SB(1, 0), cB + kstep, voffB); PG8_STAGE(PG8_SA(1, 0), cA + kstep, voffA); PG8_STAGE(PG8_SB(1, 1), cB + hstep + kstep, voffB);
        PG8_WAIT_V(6); PG8_BAR;
    }
    for (;;) {
        const bool has_next = S.next(ui + 1, nxt);
        const char* nA = has_next ? (const char*)g.A + (size_t)nxt.pm * tstep : cA; const char* nB = has_next ? (const char*)g.Bt + (size_t)nxt.pn * tstep : cB;
        for (int t = 0; t < nt; t += 2) {
            const bool last = (t == nt - 2);
            const char* a1 = cA + (size_t)(t + 1) * kstep;
            const char* a2 = last ? nA : cA + (size_t)(t + 2) * kstep; const char* b2 = last ? nB : cB + (size_t)(t + 2) * kstep;
            const char* a3 = a2 + kstep; const char* b3 = b2 + kstep;
            if (last && has_next) S.a_ready(nxt);
            if constexpr (SP2) {
            PG8_LDB(B0, 0, 0); PG8_LDB(B1, 0, 1); PG8_SCHED; PG8_LDA(At, 0, 0); PG8_STAGE(PG8_SA(1, 1), a1 + hstep, voffA);
            PG8_WAIT_V(8); PG8_WAIT_L(0); PG8_BAR; PG8_MMA(0, 0, At, B0); PG8_MMA(0, 1, At, B1); PG8_BAR; PG8_SCHED;
            PG8_LDA(At, 0, 1); PG8_STAGE(PG8_SB(0, 0), b2, voffB); PG8_STAGE(PG8_SB(0, 1), b2 + hstep, voffB); PG8_STAGE(PG8_SA(0, 0), a2, voffA);
            PG8_WAIT_V(8); PG8_WAIT_L(0); PG8_BAR; PG8_MMA(1, 0, At, B0); PG8_MMA(1, 1, At, B1); PG8_BAR; PG8_SCHED;
            PG8_LDB(B0, 1, 0); PG8_LDB(B1, 1, 1); PG8_SCHED; PG8_LDA(At, 1, 0); PG8_STAGE(PG8_SA(0, 1), a2 + hstep, voffA);
            PG8_WAIT_V(8); PG8_WAIT_L(0); PG8_BAR; PG8_MMA(0, 0, At, B0); PG8_MMA(0, 1, At, B1); PG8_BAR; PG8_SCHED;
            PG8_LDA(At, 1, 1); PG8_STAGE(PG8_SB(1, 0), b3, voffB); PG8_STAGE(PG8_SB(1, 1), b3 + hstep, voffB); PG8_STAGE(PG8_SA(1, 0), a3, voffA);
            PG8_WAIT_V(8); PG8_WAIT_L(0); PG8_BAR; PG8_MMA(1, 0, At, B0); PG8_MMA(1, 1, At, B1); PG8_BAR; PG8_SCHED;
            } else {
            PG8_LDB(B0, 0, 0); PG8_SCHED; PG8_LDA(At, 0, 0); PG8_STAGE(PG8_SA(1, 1), a1 + hstep, voffA);
            PG8_WAIT_L(8); PG8_BAR; PG8_WAIT_L(0); PG8_MMA(0, 0, At, B0); PG8_BAR; PG8_SCHED;
            PG8_LDB(B1, 0, 1); PG8_STAGE(PG8_SB(0, 0), b2, voffB);
            PG8_BAR; PG8_WAIT_L(0); PG8_MMA(0, 1, At, B1); PG8_BAR;
            PG8_LDA(At, 0, 1); PG8_STAGE(PG8_SA(0, 0), a2, voffA);
            PG8_BAR; PG8_WAIT_L(0); PG8_MMA(1, 0, At, B0); PG8_BAR; PG8_SCHED;
            PG8_STAGE(PG8_SB(0, 1), b2 + hstep, voffB);
            PG8_WAIT_V(6); PG8_BAR; PG8_MMA(1, 1, At, B1); PG8_BAR;
            PG8_LDB(B0, 1, 0); PG8_SCHED; PG8_LDA(At, 1, 0); PG8_STAGE(PG8_SA(0, 1), a2 + hstep, voffA);
            PG8_WAIT_L(8); PG8_BAR; PG8_WAIT_L(0); PG8_MMA(0, 0, At, B0); PG8_BAR; PG8_SCHED;
            PG8_LDB(B1, 1, 1); PG8_STAGE(PG8_SB(1, 0), b3, voffB);
            PG8_BAR; PG8_WAIT_L(0); PG8_MMA(0, 1, At, B1); PG8_BAR;
            PG8_LDA(At, 1, 1); PG8_STAGE(PG8_SA(1, 0), a3, voffA);
            PG8_BAR; PG8_WAIT_L(0); PG8_MMA(1, 0, At, B0); PG8_BAR; PG8_SCHED;
            PG8_STAGE(PG8_SB(1, 1), b3 + hstep, voffB);
            PG8_WAIT_V(6); PG8_BAR; PG8_MMA(1, 1, At, B1); PG8_BAR;
            }
        }
        if constexpr (ALIGN_EPI) { if (wr == 0) PG8_BAR; }
        if constexpr (!Epi::AFTER_DRAIN) { E(acc, cur, wr, wc, fr, fq); S.done(cur); }
        if (!has_next) break;
#pragma unroll
        for (int a = 0; a < 2; ++a)
#pragma unroll
            for (int b = 0; b < 2; ++b)
#pragma unroll
                for (int m = 0; m < 4; ++m)
#pragma unroll
                    for (int n = 0; n < 2; ++n) acc[a][b][m][n] = (f32x4){0.f, 0.f, 0.f, 0.f};
        cur = nxt; cA = nA; cB = nB; ++ui;
        if constexpr (ALIGN_EPI) { if (wr == 1) PG8_BAR; }
    }
    PG8_WAIT_V(0);
    if constexpr (!ALIGN_EPI) { if (wr == 0) PG8_BAR; }
    PG8_BAR;
    if constexpr (Epi::AFTER_DRAIN) { E.fused(acc, cur, wr, wc, fr, fq, lds, wid, lane); S.done(cur); }
#undef PG8_SA
#undef PG8_SB
#undef PG8_STAGE
#undef PG8_LDA
#undef PG8_LDB
#undef PG8_MMA
#undef PG8_WAIT_V
#undef PG8_WAIT_L
#undef PG8_BAR
#undef PG8_SCHED
}
}
#define LAS __attribute__((address_space(3)))
typedef unsigned short bf16;
typedef unsigned v4u __attribute__((ext_vector_type(4)));
typedef float f32x4 __attribute__((ext_vector_type(4)));

constexpr int NB = 8, S = 2048, D = 1024, M = NB * S, NU = 3584, DFF = 2816, MEML = 256, MROWS = NB * MEML, DX = 512;
constexpr size_t MiB = 1u << 20;
constexpr size_t WS_SSQ = 0;
constexpr size_t WS_SSQM = 512 * 1024;
constexpr size_t WS_BAR = 768 * 1024, BAR_BYTES = 32768;
constexpr int LDS_BARST = 147392;
constexpr size_t WS_PRM = 800 * 1024;
constexpr size_t WS_W = 1 * MiB, W_LAYER = 29 * MiB + MiB / 2;
constexpr size_t OW_IN = 0, OW_OUT = 7 * MiB, OW_XQ = 9 * MiB, OW_XKV = 10 * MiB, OW_XO = 12 * MiB, OW_GU = 13 * MiB, OW_DN = 24 * MiB;
constexpr size_t WS_U = 60 * MiB;
constexpr size_t WS_Y = 172 * MiB;
constexpr size_t WS_QX = 172 * MiB, WS_OX = 188 * MiB;
constexpr size_t WS_HB = 204 * MiB;
constexpr size_t WS_MEMB = 236 * MiB;
constexpr size_t WS_KV = 240 * MiB;
constexpr size_t WS_SSQP = 248 * MiB;
constexpr size_t WS_END = 256 * MiB;
constexpr int LDS_BYTES = 147456;

__device__ __forceinline__ unsigned f2bf(float f) { unsigned u = __builtin_bit_cast(unsigned, f); return (u + 0x7fffu + ((u >> 16) & 1u)) >> 16; }
__device__ __forceinline__ unsigned pk2(float lo, float hi) { return f2bf(lo) | (f2bf(hi) << 16); }
__device__ __forceinline__ float bf2f(unsigned short v) { return __uint_as_float(((unsigned)v) << 16); }
__device__ __forceinline__ float lo_f(unsigned w) { return __uint_as_float(w << 16); }
__device__ __forceinline__ float hi_f(unsigned w) { return __uint_as_float(w & 0xffff0000u); }
__device__ __forceinline__ float log_sigmoid_f(float x) { return fminf(x, 0.f) - __logf(1.0f + __expf(-fabsf(x))); }
__device__ __forceinline__ float sigmoid_f(float x) { return __builtin_amdgcn_rcpf(1.0f + __expf(-x)); }
__device__ __forceinline__ float wave_sum(float v) {
#pragma unroll
    for (int o = 1; o < 64; o <<= 1) v += __shfl_xor(v, o);
    return v;
}

#define XB_TMO      128
#define XB_XCNT(j)  (256  + 64 * (j))
#define XB_XSUB(j)  (1280 + 64 * (j))
#define XB_XGEN(j)  (2304 + 64 * (j))
#define XB_TOP      3328
#define XB_TOPGEN   3392
#define XCD_BAR_WORDS 3456
#define XB_SPIN_CAP (1u << 18)

__device__ __forceinline__ unsigned xb_ld(unsigned* p)              { return __hip_atomic_load(p, __ATOMIC_RELAXED, __HIP_MEMORY_SCOPE_AGENT); }
__device__ __forceinline__ unsigned xb_add(unsigned* p, unsigned v) { return __hip_atomic_fetch_add(p, v, __ATOMIC_RELAXED, __HIP_MEMORY_SCOPE_AGENT); }
__device__ __forceinline__ unsigned xb_xcc_id() { return (unsigned)__builtin_amdgcn_s_getreg((3 << 11) | 20) & 0xFu; }
#define XB_SPIN(cond, bar) do { unsigned _sp = 0; while (cond) { __builtin_amdgcn_s_sleep(1); \
    if ((++_sp & 255u) == 0u) { if (xb_ld(&(bar)[XB_TMO])) break; if (_sp > XB_SPIN_CAP) { atomicAdd(&(bar)[XB_TMO], 1u); break; } } } } while (0)

struct XcdBarrier {
    unsigned* bar; unsigned x;
    volatile LAS unsigned* st;
};

__device__ __forceinline__ XcdBarrier xcd_barrier_post(unsigned* bar, volatile LAS unsigned* st) {
    XcdBarrier b; b.bar = bar; b.x = xb_xcc_id(); b.st = st;
    if (threadIdx.x == 0) (void)xb_add(&bar[XB_XCNT(b.x)], 1u);
    return b;
}
__device__ __forceinline__ void xcd_barrier_complete(unsigned* bar, unsigned x, unsigned& nloc, unsigned& nx) {
    const unsigned G = gridDim.x * gridDim.y * gridDim.z;
    unsigned sum, cnt, mine, sp = 0u;
    for (;;) {
        sum = 0u; cnt = 0u; mine = 0u;
#pragma unroll
        for (unsigned j = 0; j < 16; ++j) { const unsigned c = xb_ld(&bar[XB_XCNT(j)]); sum += c; cnt += (c > 0u) ? 1u : 0u; mine = (j == x) ? c : mine; }
        if (sum == G) break;
        __builtin_amdgcn_s_sleep(1);
        if ((++sp & 255u) == 0u) { if (xb_ld(&bar[XB_TMO])) break; if (sp > XB_SPIN_CAP) { atomicAdd(&bar[XB_TMO], 1u); break; } }
    }
    nloc = mine > 0u ? mine : 1u; nx = cnt > 0u ? cnt : 1u;
}

__device__ __forceinline__ void xcd_barrier(const XcdBarrier& b) {
    asm volatile("s_waitcnt vmcnt(0)" ::: "memory");
    __syncthreads();
    if (threadIdx.x == 0) {
        unsigned* bar = b.bar;
        __builtin_amdgcn_s_waitcnt(0);
        unsigned nloc = b.st[0], nx = b.st[1];
        if (nloc == 0u) { xcd_barrier_complete(bar, b.x, nloc, nx); b.st[0] = nloc; b.st[1] = nx; }
        const unsigned old = xb_add(&bar[XB_XSUB(b.x)], 1u);
        const unsigned gen = old / nloc;
        if (old + 1u == (gen + 1u) * nloc) {
            __builtin_amdgcn_fence(__ATOMIC_RELEASE, "agent");
            asm volatile("s_waitcnt vmcnt(0)" ::: "memory");
            const unsigned og = xb_add(&bar[XB_TOP], 1u);
            const unsigned tg = og / nx;
            if (og + 1u == (tg + 1u) * nx) xb_add(&bar[XB_TOPGEN], 1u);
            else XB_SPIN(xb_ld(&bar[XB_TOPGEN]) == tg, bar);
            __builtin_amdgcn_fence(__ATOMIC_ACQUIRE, "agent");
            xb_add(&bar[XB_XGEN(b.x)], 1u);
            asm volatile("s_waitcnt vmcnt(0)" ::: "memory");
        } else {
            XB_SPIN(xb_ld(&bar[XB_XGEN(b.x)]) == gen, bar);
            __builtin_amdgcn_fence(__ATOMIC_ACQUIRE, "agent");
            asm volatile("s_waitcnt vmcnt(0)" ::: "memory");
        }
    }
    __syncthreads();
}

__device__ __forceinline__ void conv_item(const float* W0, const float* W1, int pitch, int K, int mode, const float* rowscale, bf16* WT, LAS float* scr, int item, int nblk, int lane) {
    const int kb = item / nblk, nb = item % nblk, k0 = 64 * kb, n0 = 32 * nb;
    const int n = n0 + (lane & 31);
    const float* src = nullptr;
    if (mode == 0) src = W0 + n;
    else if (mode == 1) { if (n < 1152) src = W0 + n; else if (n < 3456) src = W0 + n + 6; else if (n < 3462) src = W0 + 1152 + (n - 3456); else if (n < 3474) src = W0 + n; }
    else { const int t = n >> 8, j = n & 255; src = (j < 128) ? (W0 + 128 * t + j) : (W1 + 128 * t + (j - 128)); }
#pragma unroll
    for (int i = 0; i < 32; ++i) { const int kk = 2 * i + (lane >> 5); float v = src ? src[(size_t)(k0 + kk) * pitch] : 0.f; if (rowscale) v *= rowscale[k0 + kk]; scr[kk * 33 + (lane & 31)] = v; }
    asm volatile("s_waitcnt lgkmcnt(0)" ::: "memory");
    const int c = lane & 7;
#pragma unroll
    for (int j = 0; j < 4; ++j) { const int nn = (lane >> 3) + 8 * j; const LAS float* s = scr + (8 * c) * 33 + nn;
        v4u o; o.x = pk2(s[0 * 33], s[1 * 33]); o.y = pk2(s[2 * 33], s[3 * 33]); o.z = pk2(s[4 * 33], s[5 * 33]); o.w = pk2(s[6 * 33], s[7 * 33]);
        *(v4u*)(WT + (size_t)(n0 + nn) * K + k0 + 8 * c) = o; }
    asm volatile("s_waitcnt lgkmcnt(0)" ::: "memory");
}
__device__ __forceinline__ void conv_block_item(const float* W0, const float* W1, int pitch, int K, int mode, const float* rowscale, bf16* WT, LAS float* tile, int kb, int nb, int tid) {
    const int k0 = 64 * kb, n0 = 256 * nb, c4 = (tid & 63) * 4;
#pragma unroll
    for (int i = 0; i < 8; ++i) { const int row = 8 * i + (tid >> 6); f32x4 v = {0.f, 0.f, 0.f, 0.f};
        const float* rp = W0 + (size_t)(k0 + row) * pitch;
        if (mode == 0) v = *(const f32x4*)(rp + n0 + c4);
        else if (mode == 2) { const float* rq = (c4 < 128 ? rp : W1 + (size_t)(k0 + row) * pitch) + 128 * nb + (c4 & 127); v = *(const f32x4*)rq; }
        else {
#pragma unroll
            for (int j = 0; j < 4; ++j) { const int n = n0 + c4 + j; int sc = -1;
                if (n < 1152) sc = n; else if (n < 3456) sc = n + 6; else if (n < 3462) sc = 1152 + (n - 3456); else if (n < 3474) sc = n;
                v[j] = sc >= 0 ? rp[sc] : 0.f; } }
        if (rowscale) v = v * rowscale[k0 + row];
        LAS float* d = tile + row * 257 + c4; d[0] = v[0]; d[1] = v[1]; d[2] = v[2]; d[3] = v[3]; }
    __syncthreads();
    const int q = tid & 7;
#pragma unroll
    for (int pass = 0; pass < 4; ++pass) { const int nl = (tid >> 3) + 64 * pass; const LAS float* sp = tile + (8 * q) * 257 + nl;
        v4u o; o.x = pk2(sp[0], sp[257]); o.y = pk2(sp[2 * 257], sp[3 * 257]); o.z = pk2(sp[4 * 257], sp[5 * 257]); o.w = pk2(sp[6 * 257], sp[7 * 257]);
        *(v4u*)(WT + (size_t)(n0 + nl) * K + k0 + 8 * q) = o; }
    __syncthreads();
}
__device__ __forceinline__ void row_to_bf16_ssq(const float* xrow, bf16* orow, float* ssq_out, int lane) {
    const f32x4* xr = (const f32x4*)xrow + lane; f32x4 v[4]; float s2 = 0.f;
#pragma unroll
    for (int j = 0; j < 4; ++j) { v[j] = xr[64 * j]; s2 += (v[j].x * v[j].x + v[j].y * v[j].y) + (v[j].z * v[j].z + v[j].w * v[j].w); }
    s2 = wave_sum(s2);
    unsigned long long* o8 = (unsigned long long*)orow + lane;
#pragma unroll
    for (int j = 0; j < 4; ++j) o8[64 * j] = (unsigned long long)pk2(v[j].x, v[j].y) | ((unsigned long long)pk2(v[j].z, v[j].w) << 32);
    if (lane < 16) ssq_out[lane] = lane == 0 ? s2 : 0.f;
}

typedef short s16x8 __attribute__((ext_vector_type(8)));
typedef short s16x4 __attribute__((ext_vector_type(4)));
typedef float f32x16 __attribute__((ext_vector_type(16)));
__device__ __forceinline__ s16x4 tr_read(LAS const unsigned char* p) { return __builtin_bit_cast(s16x4, __builtin_amdgcn_ds_read_tr16_b64_v4i16((LAS s16x4*)p)); }
__device__ __forceinline__ s16x8 cat8(s16x4 a, s16x4 b) { return (s16x8){a[0], a[1], a[2], a[3], b[0], b[1], b[2], b[3]}; }
__device__ __forceinline__ unsigned cvtpk(float lo, float hi) { return pg8::cvt_pk_bf16(lo, hi); }
__device__ __forceinline__ s16x8 pack8(float a0, float a1, float a2, float a3, float a4, float a5, float a6, float a7) {
    v4u w; w.x = cvtpk(a0, a1); w.y = cvtpk(a2, a3); w.z = cvtpk(a4, a5); w.w = cvtpk(a6, a7); return __builtin_bit_cast(s16x8, w); }
#define MFMA32(a, b, c) __builtin_amdgcn_mfma_f32_32x32x16_bf16(a, b, c, 0, 0, 0)
__device__ __forceinline__ float xh_sum(float x) { auto rr = __builtin_amdgcn_permlane32_swap(__float_as_uint(x), __float_as_uint(x), false, false); return __uint_as_float(rr[0]) + __uint_as_float(rr[1]); }
__device__ __forceinline__ float xh_max(float x) { auto rr = __builtin_amdgcn_permlane32_swap(__float_as_uint(x), __float_as_uint(x), false, false); return fmaxf(__uint_as_float(rr[0]), __uint_as_float(rr[1])); }
__device__ __forceinline__ float xh_prod(float x) { auto rr = __builtin_amdgcn_permlane32_swap(__float_as_uint(x), __float_as_uint(x), false, false); return __uint_as_float(rr[0]) * __uint_as_float(rr[1]); }
__device__ __forceinline__ float xh_other(float x) { auto rr = __builtin_amdgcn_permlane32_swap(__float_as_uint(x), __float_as_uint(x), false, false); return __uint_as_float(rr[0] == __float_as_uint(x) ? rr[1] : rr[0]); }
__device__ __forceinline__ void st_wt64(float* p, float a, float b) { __hip_atomic_store((unsigned long long*)p, ((unsigned long long)__float_as_uint(b) << 32) | (unsigned long long)__float_as_uint(a), __ATOMIC_RELAXED, __HIP_MEMORY_SCOPE_AGENT); }
__device__ __forceinline__ void st_wt32(float* p, float a) { __hip_atomic_store((unsigned*)p, __float_as_uint(a), __ATOMIC_RELAXED, __HIP_MEMORY_SCOPE_AGENT); }
__device__ __forceinline__ void fox_cumsum_item(const bf16* u, const float* foxb, float* cl, float* tot, int item, int lane) {
    const int bhf = item >> 3, seg = item & 7, b = bhf / 6, h = bhf % 6;
    const float fb = foxb[h];
    const bf16* p = u + ((size_t)b * S + seg * 256 + 4 * lane) * NU + 3456 + h;
    const float L2E = 1.4426950408889634f;
    float l0 = L2E * log_sigmoid_f(bf2f(p[0]) + fb), l1 = L2E * log_sigmoid_f(bf2f(p[NU]) + fb), l2 = L2E * log_sigmoid_f(bf2f(p[2 * NU]) + fb), l3 = L2E * log_sigmoid_f(bf2f(p[3 * NU]) + fb);
    l1 += l0; l2 += l1; l3 += l2;
    float inc = l3;
#pragma unroll
    for (int o = 1; o < 64; o <<= 1) { const float v = __shfl_up(inc, o, 64); if (lane >= o) inc += v; }
    const float ex = inc - l3;
    { float* d = cl + (size_t)bhf * S + seg * 256 + 4 * lane; st_wt64(d, ex + l0, ex + l1); st_wt64(d + 2, ex + l2, ex + l3); }
    if (lane == 63) st_wt32(tot + bhf * 8 + seg, inc);
}
constexpr int PV64 = 144;
__device__ __forceinline__ void attn_mfma_item(const bf16* u, bf16* y, const float* cl, const float* tot, LAS unsigned char* wl, int item, int lane) {
    const int bh = item % 80, qb = 63 - item / 80;
    const bool fox = bh < 48;
    int b, h, qoff, koff, voff, yoff;
    if (fox) { b = bh / 6; h = bh % 6; qoff = h * 64; koff = 384 + h * 64; voff = 768 + h * 64; yoff = h * 64; }
    else { const int rr = bh - 48; b = rr / 4; h = rr % 4; qoff = 1152 + h * 64; koff = 1408 + h * 64; voff = 1664 + h * 64; yoff = 384 + h * 64; }
    const int r = lane & 31, hi = lane >> 5;
    const char* ubc = (const char*)(u + (size_t)b * S * NU);
    const int t = qb * 32 + r;
    const float* clh = cl + (size_t)(fox ? bh : 0) * S;
    s16x8 Qf[4];
    { const unsigned qo = (unsigned)(t * NU + qoff + 8 * hi) * 2u;
#pragma unroll
      for (int d0 = 0; d0 < 4; ++d0) Qf[d0] = *(const s16x8*)(ubc + qo + 32 * d0);
      if (!fox) {
          const float qs = -0.125f * 1.4426950408889634f;
#pragma unroll
          for (int d0 = 0; d0 < 4; ++d0) { const v4u w = __builtin_bit_cast(v4u, Qf[d0]);
              Qf[d0] = pack8(lo_f(w.x) * qs, hi_f(w.x) * qs, lo_f(w.y) * qs, hi_f(w.y) * qs, lo_f(w.z) * qs, hi_f(w.z) * qs, lo_f(w.w) * qs, hi_f(w.w) * qs); } } }
    f32x16 O0, O1;
#pragma unroll
    for (int i = 0; i < 16; ++i) { O0[i] = 0.f; O1[i] = 0.f; }
    float mrun = -1e30f, lsum = 0.f, Rsb = 1.f, Doff = 0.f;
    const float clt = fox ? clh[t] : 0.f;
    LAS float* gl = (LAS float*)(wl + 4608);
    const int trbase = (4 * hi + ((lane >> 2) & 3)) * PV64 + (16 * ((lane >> 4) & 1) + 4 * (lane & 3)) * 2;
    const unsigned lane_off = (unsigned)((lane >> 3) * NU + 8 * (lane & 7)) * 2u;
    v4u kn[4], vn[4]; float gn = 0.f;
    { const char* tb = ubc + (size_t)(qb * 32) * NU * 2;
#pragma unroll
      for (int i = 0; i < 4; ++i) { kn[i] = *(const v4u*)(tb + (size_t)(8 * i * NU + koff) * 2 + lane_off); vn[i] = *(const v4u*)(tb + (size_t)(8 * i * NU + voff) * 2 + lane_off); }
      if (fox) gn = clh[qb * 32 + r]; }
    LAS unsigned char* kl = wl + 4736;
    const int kfoff = r * PV64 + 16 * hi;
    const float SC2 = 0.125f * 1.4426950408889634f;
    { LAS unsigned char* z = wl + 9344 + (lane >> 3) * PV64 + 16 * (lane & 7);
#pragma unroll
      for (int i = 0; i < 4; ++i) *(LAS v4u*)(z + 8 * i * PV64) = (v4u){0u, 0u, 0u, 0u}; }
    s16x8 Pp0 = {0, 0, 0, 0, 0, 0, 0, 0}, Pp1 = {0, 0, 0, 0, 0, 0, 0, 0};
    int vlast = 0;
    for (int jt = qb; jt >= 0; --jt) {
        const bool diag = (jt == qb);
        const int vcur = ((qb - jt) & 1) ? 9344 : 0, vprev = 9344 - vcur; vlast = vcur;
        { LAS unsigned char* dk = kl + (lane >> 3) * PV64 + 16 * (lane & 7); LAS unsigned char* dv = wl + vcur + (lane >> 3) * PV64 + 16 * (lane & 7);
#pragma unroll
          for (int i = 0; i < 4; ++i) { *(LAS v4u*)(dk + 8 * i * PV64) = kn[i]; *(LAS v4u*)(dv + 8 * i * PV64) = vn[i]; } }
        if (fox) gl[r] = -gn;
        if (jt > 0) { const char* tb = ubc + (size_t)((jt - 1) * 32) * NU * 2;
#pragma unroll
          for (int i = 0; i < 4; ++i) { kn[i] = *(const v4u*)(tb + (size_t)(8 * i * NU + koff) * 2 + lane_off); vn[i] = *(const v4u*)(tb + (size_t)(8 * i * NU + voff) * 2 + lane_off); }
          if (fox) gn = clh[(jt - 1) * 32 + r]; }
        s16x8 Kf[4];
#pragma unroll
        for (int d0 = 0; d0 < 4; ++d0) Kf[d0] = *(LAS const s16x8*)(kl + kfoff + 32 * d0);
        LAS const unsigned char* vb = wl + vprev + trbase;
        const s16x8 V00 = cat8(tr_read(vb), tr_read(vb + 8 * PV64)), V01 = cat8(tr_read(vb + 16 * PV64), tr_read(vb + 24 * PV64));
        const s16x8 V10 = cat8(tr_read(vb + 64), tr_read(vb + 8 * PV64 + 64)), V11 = cat8(tr_read(vb + 16 * PV64 + 64), tr_read(vb + 24 * PV64 + 64));
        f32x16 Sx;
#pragma unroll
        for (int i = 0; i < 16; ++i) Sx[i] = 0.f;
        Sx = MFMA32(Kf[0], Qf[0], Sx); O0 = MFMA32(V00, Pp0, O0);
        Sx = MFMA32(Kf[1], Qf[1], Sx); O1 = MFMA32(V10, Pp0, O1);
        Sx = MFMA32(Kf[2], Qf[2], Sx); O0 = MFMA32(V01, Pp1, O0);
        Sx = MFMA32(Kf[3], Qf[3], Sx); O1 = MFMA32(V11, Pp1, O1);
        float P[16];
        if (fox) {
            const float off = clt + Doff;
            float tmax = -1e30f;
#pragma unroll
            for (int g = 0; g < 4; ++g) { const f32x4 ncs = *(LAS const f32x4*)(gl + 8 * g + 4 * hi);
#pragma unroll
                for (int e = 0; e < 4; ++e) P[4 * g + e] = fmaf(SC2, Sx[4 * g + e], ncs[e]); }
            if (diag) {
#pragma unroll
                for (int i = 0; i < 16; ++i) { const int sl = 8 * (i >> 2) + 4 * hi + (i & 3); if (sl > r) P[i] = -1e30f; } }
#pragma unroll
            for (int i = 0; i < 16; ++i) tmax = fmaxf(tmax, P[i]);
            tmax = xh_max(tmax) + off;
            if (__any(tmax > mrun)) {
                const float mnew = fmaxf(mrun, tmax), alpha = __builtin_amdgcn_exp2f(mrun - mnew); lsum *= alpha; mrun = mnew;
#pragma unroll
                for (int i = 0; i < 16; ++i) { O0[i] *= alpha; O1[i] *= alpha; } }
            const float msh = mrun - off; float ps = 0.f;
#pragma unroll
            for (int i = 0; i < 16; ++i) { P[i] = __builtin_amdgcn_exp2f(P[i] - msh); ps += P[i]; }
            lsum += ps;
            if (jt > 0 && ((jt - 1) >> 3) != (jt >> 3)) Doff += tot[bh * 8 + ((jt - 1) >> 3)];
        } else {
            float kp[16], gs[4], go[4]; float T = 1.f;
#pragma unroll
            for (int i = 0; i < 16; ++i) { const float ee = __builtin_amdgcn_exp2f(Sx[i]); const float sig = __builtin_amdgcn_rcpf(1.0f + ee); P[i] = sig; kp[i] = 1.0f - sig; }
            if (diag) {
#pragma unroll
                for (int i = 0; i < 16; ++i) { const int sl = 8 * (i >> 2) + 4 * hi + (i & 3); if (sl >= r) { P[i] = 0.f; kp[i] = 1.f; } } }
#pragma unroll
            for (int g = 0; g < 4; ++g) { gs[g] = (kp[4 * g] * kp[4 * g + 1]) * (kp[4 * g + 2] * kp[4 * g + 3]); T *= gs[g]; }
#pragma unroll
            for (int g = 0; g < 4; ++g) go[g] = xh_other(gs[g]);
            float above = Rsb;
#pragma unroll
            for (int g = 3; g >= 0; --g) {
                float suf = hi == 0 ? above * go[g] : above;
#pragma unroll
                for (int e = 3; e >= 0; --e) { const float a = P[4 * g + e] * suf; suf *= kp[4 * g + e]; P[4 * g + e] = a; }
                above *= gs[g] * go[g];
            }
            Rsb *= xh_prod(T);
        }
        Pp0 = pack8(P[0], P[1], P[2], P[3], P[4], P[5], P[6], P[7]); Pp1 = pack8(P[8], P[9], P[10], P[11], P[12], P[13], P[14], P[15]);
        if (!fox && __all(Rsb == 0.0f)) break;
    }
    { LAS const unsigned char* vb = wl + vlast + trbase;
      const s16x8 V00 = cat8(tr_read(vb), tr_read(vb + 8 * PV64)), V01 = cat8(tr_read(vb + 16 * PV64), tr_read(vb + 24 * PV64));
      const s16x8 V10 = cat8(tr_read(vb + 64), tr_read(vb + 8 * PV64 + 64)), V11 = cat8(tr_read(vb + 16 * PV64 + 64), tr_read(vb + 24 * PV64 + 64));
      O0 = MFMA32(V00, Pp0, O0); O1 = MFMA32(V10, Pp0, O1); O0 = MFMA32(V01, Pp1, O0); O1 = MFMA32(V11, Pp1, O1); }
    float inv = 1.0f;
    if (fox) { lsum = xh_sum(lsum); inv = __builtin_amdgcn_rcpf(lsum); }
    char* yb0 = (char*)(y + (size_t)b * S * D); const unsigned yo = (unsigned)(t * D + yoff + 4 * hi) * 2u;
#pragma unroll
    for (int g = 0; g < 4; ++g) {
        unsigned long long w0 = (unsigned long long)cvtpk(O0[4 * g] * inv, O0[4 * g + 1] * inv) | ((unsigned long long)cvtpk(O0[4 * g + 2] * inv, O0[4 * g + 3] * inv) << 32);
        unsigned long long w1 = (unsigned long long)cvtpk(O1[4 * g] * inv, O1[4 * g + 1] * inv) | ((unsigned long long)cvtpk(O1[4 * g + 2] * inv, O1[4 * g + 3] * inv) << 32);
        *(unsigned long long*)(yb0 + yo + 16 * g) = w0; *(unsigned long long*)(yb0 + yo + 64 + 16 * g) = w1; }
}
constexpr int PV128 = 272;
__device__ __forceinline__ void xattn_mfma_item(const bf16* qx, const bf16* kv, bf16* ox, LAS unsigned char* wl, int item, int lane) {
    const int head = item & 3, qblk = item >> 2;
    const int r = lane & 31, hi = lane >> 5;
    const int token = qblk * 32 + r, b = (qblk * 32) / S;
    s16x8 Qf[8];
    { const char* qb_ = (const char*)qx; const unsigned qo = (unsigned)(token * DX + head * 128 + 8 * hi) * 2u;
#pragma unroll
      for (int d0 = 0; d0 < 8; ++d0) Qf[d0] = *(const s16x8*)(qb_ + qo + 32 * d0); }
    f32x16 O[4];
#pragma unroll
    for (int k = 0; k < 4; ++k)
#pragma unroll
        for (int i = 0; i < 16; ++i) O[k][i] = 0.f;
    float mrun = -1e30f, lsum = 0.f;
    const int trbase = (4 * hi + ((lane >> 2) & 3)) * PV128 + (16 * ((lane >> 4) & 1) + 4 * (lane & 3)) * 2;
    const char* kvc = (const char*)(kv + (size_t)b * MEML * 1024);
    const unsigned kfo = (unsigned)(r * 1024 + head * 128 + 8 * hi) * 2u;
    const unsigned vlo = (unsigned)((lane >> 4) * 1024 + 512 + head * 128 + 8 * (lane & 15)) * 2u;
    s16x8 Kn[8]; v4u vn[8];
#pragma unroll
    for (int d0 = 0; d0 < 8; ++d0) Kn[d0] = *(const s16x8*)(kvc + kfo + 32 * d0);
#pragma unroll
    for (int i = 0; i < 8; ++i) vn[i] = *(const v4u*)(kvc + vlo + (size_t)(4 * i) * 2048);
    const float SCX = 0.08838834764831845f * 1.4426950408889634f;
    for (int jt = 0; jt < 8; ++jt) {
        f32x16 Sx;
#pragma unroll
        for (int i = 0; i < 16; ++i) Sx[i] = 0.f;
#pragma unroll
        for (int d0 = 0; d0 < 8; ++d0) Sx = MFMA32(Kn[d0], Qf[d0], Sx);
        { LAS unsigned char* dst = wl + (lane >> 4) * PV128 + 16 * (lane & 15);
#pragma unroll
          for (int i = 0; i < 8; ++i) *(LAS v4u*)(dst + 4 * i * PV128) = vn[i]; }
        if (jt < 7) { const char* tb = kvc + (size_t)((jt + 1) * 32) * 2048;
#pragma unroll
            for (int d0 = 0; d0 < 8; ++d0) Kn[d0] = *(const s16x8*)(tb + kfo + 32 * d0);
#pragma unroll
            for (int i = 0; i < 8; ++i) vn[i] = *(const v4u*)(tb + vlo + (size_t)(4 * i) * 2048); }
        float P[16]; float tmax = -1e30f;
#pragma unroll
        for (int i = 0; i < 16; ++i) { P[i] = Sx[i] * SCX; tmax = fmaxf(tmax, P[i]); }
        tmax = xh_max(tmax);
        if (__any(tmax > mrun)) { const float mnew = fmaxf(mrun, tmax), alpha = __builtin_amdgcn_exp2f(mrun - mnew); lsum *= alpha; mrun = mnew;
#pragma unroll
            for (int k = 0; k < 4; ++k)
#pragma unroll
                for (int i = 0; i < 16; ++i) O[k][i] *= alpha; }
        float ps = 0.f;
#pragma unroll
        for (int i = 0; i < 16; ++i) { P[i] = __builtin_amdgcn_exp2f(P[i] - mrun); ps += P[i]; }
        lsum += ps;
        const s16x8 Pf0 = pack8(P[0], P[1], P[2], P[3], P[4], P[5], P[6], P[7]), Pf1 = pack8(P[8], P[9], P[10], P[11], P[12], P[13], P[14], P[15]);
        LAS const unsigned char* vb = wl + trbase;
#pragma unroll
        for (int k = 0; k < 4; ++k) {
            const s16x8 Va = cat8(tr_read(vb + 64 * k), tr_read(vb + 8 * PV128 + 64 * k)), Vb = cat8(tr_read(vb + 16 * PV128 + 64 * k), tr_read(vb + 24 * PV128 + 64 * k));
            O[k] = MFMA32(Va, Pf0, O[k]); O[k] = MFMA32(Vb, Pf1, O[k]); }
    }
    lsum = xh_sum(lsum); const float inv = __builtin_amdgcn_rcpf(lsum);
    char* oc = (char*)ox; const unsigned oo = (unsigned)(token * DX + head * 128 + 4 * hi) * 2u;
#pragma unroll
    for (int k = 0; k < 4; ++k)
#pragma unroll
        for (int g = 0; g < 4; ++g) {
            const unsigned long long w0 = (unsigned long long)cvtpk(O[k][4 * g] * inv, O[k][4 * g + 1] * inv) | ((unsigned long long)cvtpk(O[k][4 * g + 2] * inv, O[k][4 * g + 3] * inv) << 32);
            *(unsigned long long*)(oc + oo + 64 * k + 16 * g) = w0; }
}

constexpr int ML_WSTRIDE = 18432, ML_RAWK = 0, ML_RAWQ = 5056, ML_WK = 5056, ML_V = 10112, ML_CW = 14720, ML_EB = 16768, ML_NL = 16896, ML_NW = 17152, ML_ITEM_F = 4224;
template <bool OUT>
__device__ __forceinline__ void mlstm_item(const bf16* u, bf16* y, float* scratch, const float* convw, const float* ib, const float* fbias, const float* normw, LAS unsigned char* wl, int bh, int c, int lane) {
    const int b = bh / 6, h = bh % 6, r = lane & 31, hi = lane >> 5;
    const bf16* ub = u + (size_t)b * S * NU;
    LAS float* cw = (LAS float*)(wl + ML_CW); LAS float* eb = (LAS float*)(wl + ML_EB); LAS float* nl = (LAS float*)(wl + ML_NL); LAS float* nwl = (LAS float*)(wl + ML_NW);
    for (int i = lane; i < 512; i += 64) { const int tap = i >> 7, ch = i & 127; cw[i] = convw[tap * 768 + (ch < 64 ? (64 * h + ch) : (384 + 64 * h + (ch - 64)))]; }
    if (OUT) nwl[lane] = normw[h * 64 + lane];
    const float ibh = ib[h], fbh = fbias[h];
    f32x16 X[2][2];
#pragma unroll
    for (int a = 0; a < 2; ++a)
#pragma unroll
        for (int bb = 0; bb < 2; ++bb)
#pragma unroll
            for (int i = 0; i < 16; ++i) X[a][bb][i] = 0.f;
    float nk = 0.f, Gsum = 0.f;
    if (OUT) {
        float dec = 1.f;
        for (int cp = c - 1; cp >= 0; --cp) {
            const float* s0 = scratch + (size_t)(bh * 16 + cp) * ML_ITEM_F;
            f32x16 v0[4];
#pragma unroll
            for (int blk = 0; blk < 4; ++blk) v0[blk] = *(const f32x16*)(s0 + blk * 1024 + lane * 16);
            const float n0 = s0[4096 + lane], g0 = s0[4160];
#pragma unroll
            for (int blk = 0; blk < 4; ++blk) X[blk >> 1][blk & 1] += v0[blk] * dec;
            nk += dec * n0;
            dec *= __expf(g0);
        }
    }
    nl[lane] = nk;
    const int trP = (4 * hi + ((lane >> 2) & 3)) * 144 + (16 * ((lane >> 4) & 1) + 4 * (lane & 3)) * 2;
    const int trN = (8 * hi + ((lane >> 2) & 3)) * 144 + (16 * ((lane >> 4) & 1) + 4 * (lane & 3)) * 2;
    for (int j = 0; j < 4; ++j) {
        const int t0 = c * 128 + j * 32, t = t0 + r;
        const bf16* trow = ub + (size_t)t * NU;
        const unsigned short gfr = trow[3468 + h], gir = trow[3462 + h];
        v4u vv[4], rk[5], rq[5];
        { const bf16* vrow = ub + (size_t)(t0 + (lane >> 3)) * NU + 2688 + 64 * h + 8 * (lane & 7);
#pragma unroll
          for (int i = 0; i < 4; ++i) vv[i] = *(const v4u*)(vrow + (size_t)(8 * i) * NU); }
#pragma unroll
        for (int i = 0; i < 5; ++i) { const int p = lane + 64 * i, row = p >> 3, ch8 = p & 7, tt = t0 - 3 + row; const bool ok = (p < 280) && (tt >= 0);
            const bf16* src = ub + (size_t)(ok ? tt : 0) * NU + 1920 + 64 * h + 8 * ch8;
            rk[i] = ok ? *(const v4u*)(src + 384) : (v4u){0u, 0u, 0u, 0u};
            if (OUT) rq[i] = ok ? *(const v4u*)(src) : (v4u){0u, 0u, 0u, 0u}; }
#pragma unroll
        for (int i = 0; i < 5; ++i) { const int p = lane + 64 * i, row = p >> 3, ch8 = p & 7;
            if (p < 280) { *(LAS v4u*)(wl + ML_RAWK + row * 144 + 16 * ch8) = rk[i]; if (OUT) *(LAS v4u*)(wl + ML_RAWQ + row * 144 + 16 * ch8) = rq[i]; } }
        { LAS unsigned char* dst = wl + ML_V + (lane >> 3) * 144 + 16 * (lane & 7);
#pragma unroll
          for (int i = 0; i < 4; ++i) *(LAS v4u*)(dst + 8 * i * 144) = vv[i]; }
        float bl = log_sigmoid_f(bf2f(gfr) + fbh); const float ii = bf2f(gir) + ibh;
#pragma unroll
        for (int o = 1; o < 32; o <<= 1) { const float v = __shfl_up(bl, o, 32); if (r >= o) bl += v; }
        const float g = __shfl(bl, 31, 32), es = ii - bl;
        eb[r] = es; Gsum += g;
        s16x8 Kf[4], Qf[4]; float dq = 0.f;
#pragma unroll
        for (int part = (OUT ? 0 : 1); part < 2; ++part) {
            LAS unsigned char* raw = wl + (part ? ML_RAWK : ML_RAWQ);
            const float w0 = cw[part * 64 + lane], w1 = cw[128 + part * 64 + lane], w2 = cw[256 + part * 64 + lane], w3 = cw[384 + part * 64 + lane];
            const float sc = part ? 0.125f : 1.0f;
            float xv[35];
#pragma unroll
            for (int i = 0; i < 35; ++i) xv[i] = bf2f(*(LAS const unsigned short*)(raw + i * 144 + 2 * lane));
#pragma unroll
            for (int i = 0; i < 16; ++i) {
                const float a0 = w0 * xv[2 * i] + w1 * xv[2 * i + 1] + w2 * xv[2 * i + 2] + w3 * xv[2 * i + 3];
                const float a1 = w0 * xv[2 * i + 1] + w1 * xv[2 * i + 2] + w2 * xv[2 * i + 3] + w3 * xv[2 * i + 4];
                const unsigned pk = cvtpk(a0 * sc * __builtin_amdgcn_rcpf(1.0f + __expf(-a0)), a1 * sc * __builtin_amdgcn_rcpf(1.0f + __expf(-a1)));
                *(LAS unsigned short*)(raw + (2 * i) * 144 + 2 * lane) = (unsigned short)pk; *(LAS unsigned short*)(raw + (2 * i + 1) * 144 + 2 * lane) = (unsigned short)(pk >> 16); }
#pragma unroll
            for (int f = 0; f < 4; ++f) {
                const unsigned long long p0 = *(LAS const unsigned long long*)(raw + r * 144 + (16 * f + 4 * hi) * 2), p1 = *(LAS const unsigned long long*)(raw + r * 144 + (16 * f + 8 + 4 * hi) * 2);
                const v4u fw = {(unsigned)p0, (unsigned)(p0 >> 32), (unsigned)p1, (unsigned)(p1 >> 32)};
                if (part) Kf[f] = __builtin_bit_cast(s16x8, fw); else Qf[f] = __builtin_bit_cast(s16x8, fw);
                if (OUT && part == 0) { const f32x4 n0 = *(LAS const f32x4*)(nl + 16 * f + 4 * hi), n1 = *(LAS const f32x4*)(nl + 16 * f + 8 + 4 * hi);
                    dq += (lo_f(fw.x) * n0[0] + hi_f(fw.x) * n0[1]) + (lo_f(fw.y) * n0[2] + hi_f(fw.y) * n0[3]) + (lo_f(fw.z) * n1[0] + hi_f(fw.z) * n1[1]) + (lo_f(fw.w) * n1[2] + hi_f(fw.w) * n1[3]); } }
        }
        if (OUT) {
            f32x16 Sx;
#pragma unroll
            for (int i = 0; i < 16; ++i) Sx[i] = 0.f;
#pragma unroll
            for (int f = 0; f < 4; ++f) Sx = MFMA32(Kf[f], Qf[f], Sx);
            float P[16]; float den = 0.f;
#pragma unroll
            for (int g4 = 0; g4 < 4; ++g4) { const f32x4 e4 = *(LAS const f32x4*)(eb + 8 * g4 + 4 * hi);
#pragma unroll
                for (int e = 0; e < 4; ++e) { const int sl = 8 * g4 + 4 * hi + e; const float d = (sl <= r) ? __expf(bl + e4[e]) : 0.f; P[4 * g4 + e] = Sx[4 * g4 + e] * d; den += P[4 * g4 + e]; } }
            den = xh_sum(den); dq = xh_sum(dq);
            const float ebt = __expf(bl);
            const float inv = 1.0f / fmaxf(fabsf(den + ebt * dq), 1.0f);
            const s16x8 Pf0 = pack8(P[0], P[1], P[2], P[3], P[4], P[5], P[6], P[7]), Pf1 = pack8(P[8], P[9], P[10], P[11], P[12], P[13], P[14], P[15]);
            unsigned long long ow[8];
#pragma unroll
            for (int vb = 0; vb < 2; ++vb)
#pragma unroll
                for (int g4 = 0; g4 < 4; ++g4) ow[4 * vb + g4] = *(const unsigned long long*)(trow + 3072 + 64 * h + 32 * vb + 8 * g4 + 4 * hi);
            f32x16 H[2]; float ms = 0.f;
#pragma unroll
            for (int vb = 0; vb < 2; ++vb) {
                LAS const unsigned char* vp = wl + ML_V + trP + 64 * vb;
                f32x16 Zi, Zx;
#pragma unroll
                for (int i = 0; i < 16; ++i) { Zi[i] = 0.f; Zx[i] = 0.f; }
                Zi = MFMA32(cat8(tr_read(vp), tr_read(vp + 8 * 144)), Pf0, Zi); Zi = MFMA32(cat8(tr_read(vp + 16 * 144), tr_read(vp + 24 * 144)), Pf1, Zi);
#pragma unroll
                for (int kb = 0; kb < 2; ++kb)
#pragma unroll
                    for (int sp = 0; sp < 2; ++sp) { const f32x16& xx = X[kb][vb];
                        const s16x8 xa = pack8(xx[8 * sp], xx[8 * sp + 1], xx[8 * sp + 2], xx[8 * sp + 3], xx[8 * sp + 4], xx[8 * sp + 5], xx[8 * sp + 6], xx[8 * sp + 7]);
                        Zx = MFMA32(xa, Qf[2 * kb + sp], Zx); }
#pragma unroll
                for (int i = 0; i < 16; ++i) { const float hv = (Zi[i] + ebt * Zx[i]) * inv; H[vb][i] = hv; ms += hv * hv; }
            }
            ms = xh_sum(ms);
            const float rs = rsqrtf(ms * (1.0f / 64.0f) + 1e-6f);
            bf16* yrow = y + ((size_t)b * S + t) * D + 640 + 64 * h;
#pragma unroll
            for (int vb = 0; vb < 2; ++vb)
#pragma unroll
                for (int g4 = 0; g4 < 4; ++g4) { const int v = 32 * vb + 8 * g4 + 4 * hi;
                    const unsigned o0 = (unsigned)ow[4 * vb + g4], o1 = (unsigned)(ow[4 * vb + g4] >> 32);
                    const f32x4 w4 = *(LAS const f32x4*)(nwl + v);
                    const float y0 = H[vb][4 * g4] * rs * w4[0] * sigmoid_f(lo_f(o0)), y1 = H[vb][4 * g4 + 1] * rs * w4[1] * sigmoid_f(hi_f(o0));
                    const float y2 = H[vb][4 * g4 + 2] * rs * w4[2] * sigmoid_f(lo_f(o1)), y3 = H[vb][4 * g4 + 3] * rs * w4[3] * sigmoid_f(hi_f(o1));
                    *(unsigned long long*)(yrow + v) = (unsigned long long)cvtpk(y0, y1) | ((unsigned long long)cvtpk(y2, y3) << 32); }
        }
        { const float wsc = __expf(g + es), eg = __expf(g);
#pragma unroll
          for (int f = 0; f < 4; ++f) { const v4u kw = __builtin_bit_cast(v4u, Kf[f]);
#pragma unroll
              for (int e = 0; e < 2; ++e) { const unsigned k0 = e ? kw.z : kw.x, k1 = e ? kw.w : kw.y; const int ch = 16 * f + 8 * e + 4 * hi;
                  *(LAS unsigned long long*)(wl + ML_WK + r * 144 + ch * 2) = (unsigned long long)cvtpk(lo_f(k0) * wsc, hi_f(k0) * wsc) | ((unsigned long long)cvtpk(lo_f(k1) * wsc, hi_f(k1) * wsc) << 32); } }
#pragma unroll
          for (int kb = 0; kb < 2; ++kb)
#pragma unroll
              for (int vb = 0; vb < 2; ++vb) { X[kb][vb] *= eg;
#pragma unroll
                  for (int sp = 0; sp < 2; ++sp) { LAS const unsigned char* kp = wl + ML_WK + trN + 16 * sp * 144 + 64 * kb; LAS const unsigned char* vp = wl + ML_V + trN + 16 * sp * 144 + 64 * vb;
                      X[kb][vb] = MFMA32(cat8(tr_read(kp), tr_read(kp + 4 * 144)), cat8(tr_read(vp), tr_read(vp + 4 * 144)), X[kb][vb]); } }
          float dn = 0.f;
#pragma unroll 8
          for (int s2 = 0; s2 < 32; ++s2) dn += bf2f(*(LAS const unsigned short*)(wl + ML_WK + s2 * 144 + 2 * lane));
          nk = eg * nk + dn; nl[lane] = nk; }
    }
    if (!OUT) {
        float* sp = scratch + (size_t)(bh * 16 + c) * ML_ITEM_F;
#pragma unroll
        for (int blk = 0; blk < 4; ++blk) {
#pragma unroll
            for (int i = 0; i < 8; ++i) st_wt64(sp + blk * 1024 + lane * 16 + 2 * i, X[blk >> 1][blk & 1][2 * i], X[blk >> 1][blk & 1][2 * i + 1]); }
        st_wt32(sp + 4096 + lane, nk);
        if (lane == 0) st_wt32(sp + 4160, Gsum);
    }
}

struct Args { const float* in[20]; float* out; unsigned char* ws; };
#define GEMM_PHASE(EpiT, SchedT, g, Sc, E) pg8::gemm_phase<EpiT, SchedT, true, true>(L, g, Sc, E)

__global__ void __launch_bounds__(512, 2) mega_fwd(Args a) {
    extern __shared__ __attribute__((aligned(16))) unsigned char lds[];
    LAS unsigned char* L = (LAS unsigned char*)lds;
    const int tid = threadIdx.x, lane = tid & 63, wave = __builtin_amdgcn_readfirstlane(tid >> 6);
    const int G = gridDim.x, bx = blockIdx.x;
    const int gw = bx * 8 + wave, NGW = G * 8;
    unsigned char* ws = a.ws;
    const float* x = a.in[0]; const float* mem = a.in[1];
    float* out = a.out;
    float* ssq = (float*)(ws + WS_SSQP); float* ssqm = (float*)(ws + WS_SSQP + 7 * MiB);
    bf16* ub = (bf16*)(ws + WS_U); bf16* actb = (bf16*)(ws + WS_U); bf16* yb = (bf16*)(ws + WS_Y); bf16* qxb = (bf16*)(ws + WS_QX); bf16* oxb = (bf16*)(ws + WS_OX);
    bf16* hb = (bf16*)(ws + WS_HB); bf16* memb = (bf16*)(ws + WS_MEMB); bf16* kvb = (bf16*)(ws + WS_KV);

    volatile LAS unsigned* bst = (volatile LAS unsigned*)(L + LDS_BARST); if (tid < 2) bst[tid] = 0u;
    __syncthreads();
    (void)xcd_barrier_post((unsigned*)(a.ws + WS_BAR), bst);
    {
        LAS float* tile = (LAS float*)L;
        constexpr int I_IN = 16 * 14, I_OUT = 16 * 4, I_XQ = 16 * 2, I_XKV = 16 * 4, I_XO = 8 * 4, I_GU = 16 * 22, I_DN = 44 * 4;
        constexpr int I_LAYER = I_IN + I_OUT + I_XQ + I_XKV + I_XO + I_GU + I_DN;
        for (int it = bx; it < 2 * I_LAYER; it += G) {
            const int l = it / I_LAYER; int r = it % I_LAYER;
            unsigned char* wl = ws + WS_W + (size_t)l * W_LAYER;
            if (r < I_IN) { conv_block_item(a.in[3] + (size_t)l * 1024 * 3474, nullptr, 3474, 1024, 1, a.in[2] + l * 1024, (bf16*)(wl + OW_IN), tile, r / 14, r % 14, tid); continue; } r -= I_IN;
            if (r < I_OUT) { conv_block_item(a.in[9] + (size_t)l * 1024 * 1024, nullptr, 1024, 1024, 0, nullptr, (bf16*)(wl + OW_OUT), tile, r / 4, r % 4, tid); continue; } r -= I_OUT;
            if (r < I_XQ) { conv_block_item(a.in[12] + (size_t)l * 1024 * 512, nullptr, 512, 1024, 0, a.in[10] + l * 1024, (bf16*)(wl + OW_XQ), tile, r / 2, r % 2, tid); continue; } r -= I_XQ;
            if (r < I_XKV) { conv_block_item(a.in[13] + (size_t)l * 1024 * 1024, nullptr, 1024, 1024, 0, a.in[11] + l * 1024, (bf16*)(wl + OW_XKV), tile, r / 4, r % 4, tid); continue; } r -= I_XKV;
            if (r < I_XO) { conv_block_item(a.in[14] + (size_t)l * 512 * 1024, nullptr, 1024, 512, 0, nullptr, (bf16*)(wl + OW_XO), tile, r / 4, r % 4, tid); continue; } r -= I_XO;
            if (r < I_GU) { conv_block_item(a.in[16] + (size_t)l * 1024 * DFF, a.in[17] + (size_t)l * 1024 * DFF, DFF, 1024, 2, a.in[15] + l * 1024, (bf16*)(wl + OW_GU), tile, r / 22, r % 22, tid); continue; } r -= I_GU;
            conv_block_item(a.in[18] + (size_t)l * DFF * 1024, nullptr, 1024, DFF, 0, nullptr, (bf16*)(wl + OW_DN), tile, r / 4, r % 4, tid);
        }
        for (int m = gw; m < M; m += NGW) row_to_bf16_ssq(x + (size_t)m * D, hb + (size_t)m * D, ssq + (size_t)m * 16, lane);
        for (int m = gw; m < MROWS; m += NGW) row_to_bf16_ssq(mem + (size_t)m * D, memb + (size_t)m * D, ssqm + (size_t)m * 16, lane);
        { float* prm = (float*)(ws + WS_PRM);
          for (int i = bx * 512 + tid; i < 2 * 8192 + 1024; i += G * 512) {
              float v = 0.f;
              if (i >= 2 * 8192) v = a.in[19][i - 2 * 8192];
              else { const int l = i >> 13, o = i & 8191;
                  if (o < 6) v = a.in[4][l * 6 + o]; else if (o >= 8 && o < 14) v = a.in[6][l * 6 + o - 8]; else if (o >= 16 && o < 22) v = a.in[7][l * 6 + o - 16];
                  else if (o >= 64 && o < 448) v = a.in[8][l * 384 + o - 64]; else if (o >= 512 && o < 3584) v = a.in[5][l * 3072 + o - 512]; }
              prm[i] = v; } }
    }
#define XBAR() do { XcdBarrier xb_; xb_.bar = (unsigned*)(ws + WS_BAR); xb_.x = xb_xcc_id(); xb_.st = (volatile LAS unsigned*)(L + LDS_BARST); xcd_barrier(xb_); } while (0)
    { unsigned char* ws = a.ws; XBAR(); }
    for (int ph = 0; ph < 16; ++ph) {
        const int l = ph >> 3, k = ph & 7;
        size_t zoff = 0; asm volatile("" : "+s"(zoff)); unsigned char* ws = a.ws + zoff;
        const unsigned char* wl = ws + WS_W + (size_t)l * W_LAYER;
        float* ssq = (float*)(ws + WS_SSQP); float* ssqm = (float*)(ws + WS_SSQP + 7 * MiB);
        bf16* ub = (bf16*)(ws + WS_U); bf16* actb = (bf16*)(ws + WS_U); bf16* yb = (bf16*)(ws + WS_Y); bf16* qxb = (bf16*)(ws + WS_QX); bf16* oxb = (bf16*)(ws + WS_OX);
        bf16* hb = (bf16*)(ws + WS_HB); bf16* memb = (bf16*)(ws + WS_MEMB); bf16* kvb = (bf16*)(ws + WS_KV);
        int tid_p = threadIdx.x; asm volatile("" : "+v"(tid_p)); const int lane = tid_p & 63, wave = __builtin_amdgcn_readfirstlane(tid_p >> 6), gw = bx * 8 + wave;
        if (k == 0 || k == 3) {
            const int j0 = (ph == 0) ? 0 : 2;
            for (int j = j0; j < 3; ++j) {
                pg8::Gemm g; pg8::EpiScaleBf16 E; int off = 0;
                if (j < 2) { g = pg8::Gemm{memb, (const bf16*)(ws + WS_W + (size_t)j * W_LAYER + OW_XKV), MROWS, 1024, 1024}; E = pg8::EpiScaleBf16{kvb + (size_t)j * MROWS * 1024, 1024, ssqm}; off = 128 + 32 * j; }
                else if (k == 0) { g = pg8::Gemm{hb, (const bf16*)(wl + OW_IN), M, NU, 1024}; E = pg8::EpiScaleBf16{ub, NU, ssq + (size_t)(3 * l) * M * 16}; }
                else { g = pg8::Gemm{hb, (const bf16*)(wl + OW_XQ), M, DX, 1024}; E = pg8::EpiScaleBf16{qxb, DX, ssq + (size_t)(3 * l + 1) * M * 16}; }
                pg8::OffsetOrder Sc; Sc.init(g.M, g.N, G, bx, off);
                GEMM_PHASE(pg8::EpiScaleBf16, pg8::OffsetOrder, g, Sc, E);
            }
        } else if (k == 2 || k == 5 || k == 7) {
            pg8::Gemm g; pg8::EpiResid E;
            if (k == 2) { g = pg8::Gemm{yb, (const bf16*)(wl + OW_OUT), M, 1024, 1024}; E = pg8::EpiResid{hb, ssq + (size_t)(3 * l + 1) * M * 16}; }
            else if (k == 5) { g = pg8::Gemm{oxb, (const bf16*)(wl + OW_XO), M, 1024, DX}; E = pg8::EpiResid{hb, ssq + (size_t)(3 * l + 2) * M * 16}; }
            else { g = pg8::Gemm{actb, (const bf16*)(wl + OW_DN), M, 1024, DFF}; E = pg8::EpiResid{hb, ssq + (size_t)(3 * l + 3) * M * 16}; }
            pg8::StaticOrder Sc; Sc.init(g.M, g.N, G, bx);
            GEMM_PHASE(pg8::EpiResid, pg8::StaticOrder, g, Sc, E);
        } else if (k == 6) {
            pg8::Gemm g{hb, (const bf16*)(wl + OW_GU), M, 2 * DFF, 1024}; pg8::StaticOrder Sc; Sc.init(M, 2 * DFF, G, bx);
            pg8::EpiSwiglu E{actb, DFF, ssq + (size_t)(3 * l + 2) * M * 16};
            GEMM_PHASE(pg8::EpiSwiglu, pg8::StaticOrder, g, Sc, E);
        } else if (k == 1) {
            const float* prm = (const float*)(ws + WS_PRM) + l * 8192;
            float* mscr = out;
            float* fcl = out + 14 * MiB / 4; float* ftot = out + 15 * MiB / 4;
            const int xcd0 = (int)(xb_xcc_id() & 7u); unsigned okmask = 0u;
            for (int qi = 0; qi < 3; ++qi) {
            const int xcd = (qi == 0) ? xcd0 : (qi == 1 ? (bx & 7) : ((xcd0 + 1) & 7));
            if (qi == 1 && xcd == xcd0) continue;
            unsigned* done = (unsigned*)(ws + WS_BAR + 15360) + 16 * (l * 8 + xcd);
            for (int sj = 0; sj < (qi == 2 ? 1 : 2); ++sj) {
            const int sq = (wave + sj) & 7;
            unsigned* ctr = (unsigned*)(ws + WS_BAR + 16384) + 16 * ((l * 8 + xcd) * 8 + sq);
            for (;;) {
                int it = 0; if (lane == 0) it = (int)atomicAdd(ctr, 1u); it = __builtin_amdgcn_readfirstlane(it) * 8 + sq;
                if (it >= 874) break;
                if (it < 138) {
                    if (it >= 48) mlstm_item<false>(ub, yb, mscr, prm + 512, prm + 8, prm + 16, prm + 64, L + wave * ML_WSTRIDE, xcd + 8 * ((it - 48) / 15), (it - 48) % 15, lane);
                    else fox_cumsum_item(ub, prm, fcl, ftot, (xcd + 8 * (it >> 3)) * 8 + (it & 7), lane);
                    asm volatile("s_waitcnt vmcnt(0)" ::: "memory");
                    if (lane == 0) atomicAdd(done + (it >= 48 ? 8 : 0), 1u);
                } else {
                    const bool isc = (it >= 266 && it < 362), issb = (it >= 362 && it < 618), isfox = !isc && !issb;
                    if (isfox && !((okmask >> xcd) & 1u)) { unsigned sp = 0u;
                        while (__hip_atomic_load(done, __ATOMIC_RELAXED, __HIP_MEMORY_SCOPE_AGENT) < 48u) { __builtin_amdgcn_s_sleep(40); if (++sp > (1u << 18)) break; }
                        __builtin_amdgcn_fence(__ATOMIC_ACQUIRE, "agent"); okmask |= 1u << xcd; }
                    if (isc && !((okmask >> (8 + xcd)) & 1u)) { unsigned sp = 0u;
                        while (__hip_atomic_load(done + 8, __ATOMIC_RELAXED, __HIP_MEMORY_SCOPE_AGENT) < 90u) { __builtin_amdgcn_s_sleep(40); if (++sp > (1u << 18)) break; }
                        __builtin_amdgcn_fence(__ATOMIC_ACQUIRE, "agent"); okmask |= 1u << (8 + xcd); }
                    if (isc) { const int ci = it - 266; mlstm_item<true>(ub, yb, mscr, prm + 512, prm + 8, prm + 16, prm + 64, L + wave * ML_WSTRIDE, xcd + 8 * (ci >> 4), 15 - (ci & 15), lane); }
                    else { int aitem; if (issb) { const int ai = it - 362; aitem = (ai >> 2) * 80 + 48 + xcd + 8 * (ai & 3); } else { const int ai = (it < 266) ? it - 138 : it - 490; aitem = (ai / 6) * 80 + xcd + 8 * (ai % 6); }
                        attn_mfma_item(ub, yb, fcl, ftot, L + wave * ML_WSTRIDE, aitem, lane); }
                }
            }
            }
            }
        } else {
            for (int it = gw; it < 2048; it += NGW) xattn_mfma_item(qxb, kvb + (size_t)l * MROWS * 1024, oxb, L + wave * 16384, it, lane);
        }
        XBAR();
    }
    {
        int tid_f = threadIdx.x; asm volatile("" : "+v"(tid_f)); const int lane = tid_f & 63, gw = bx * 8 + __builtin_amdgcn_readfirstlane(tid_f >> 6);
        const float* fw = (const float*)(a.ws + WS_PRM) + 2 * 8192; const float* sq = (const float*)(a.ws + WS_SSQP) + (size_t)6 * M * 16;
        const bf16* hbf = (const bf16*)(a.ws + WS_HB);
        for (int m = gw; m < M; m += NGW) {
            float sm = 0.f; { const f32x4* qp = (const f32x4*)(sq + (size_t)m * 16); const f32x4 q0 = qp[0], q1 = qp[1], q2 = qp[2], q3 = qp[3];
              sm = ((((q0[0] + q0[1]) + (q0[2] + q0[3])) + ((q1[0] + q1[1]) + (q1[2] + q1[3]))) + (((q2[0] + q2[1]) + (q2[2] + q2[3])) + ((q3[0] + q3[1]) + (q3[2] + q3[3])))); }
            const float rs = rsqrtf(sm * (1.0f / 1024.0f) + 1e-6f);
            const unsigned long long* hp = (const unsigned long long*)(hbf + (size_t)m * D) + lane; f32x4* rp = (f32x4*)(out + (size_t)m * D) + lane; const f32x4* wp = (const f32x4*)fw + lane;
#pragma unroll
            for (int j = 0; j < 4; ++j) { const unsigned long long hw = hp[64 * j]; const unsigned h0 = (unsigned)hw, h1 = (unsigned)(hw >> 32); const f32x4 w = wp[64 * j];
                f32x4 v = {lo_f(h0), hi_f(h0), lo_f(h1), hi_f(h1)}; v = v * rs * w; rp[64 * j] = v; }
        }
    }
}

extern "C" void kernel_launch(void* const* d_in, const int* in_sizes, int n_in, void* d_out, int out_size, void* d_ws, size_t ws_size, hipStream_t stream) {
    static int grid = 0;
    if (grid == 0) {
        if (n_in != 20 || out_size != M * D || ws_size < WS_END) { fprintf(stderr, "kernel_launch: unexpected shapes (n_in %d out %d ws %zu)\n", n_in, out_size, ws_size); grid = -1; return; }
        int dev = 0, cus = 0, per_cu = 0;
        hipGetDevice(&dev); hipDeviceGetAttribute(&cus, hipDeviceAttributeMultiprocessorCount, dev);
        if (hipFuncSetAttribute((const void*)mega_fwd, hipFuncAttributeMaxDynamicSharedMemorySize, LDS_BYTES) != hipSuccess) { fprintf(stderr, "kernel_launch: hipFuncSetAttribute failed\n"); grid = -1; return; }
        if (hipOccupancyMaxActiveBlocksPerMultiprocessor(&per_cu, (const void*)mega_fwd, 512, LDS_BYTES) != hipSuccess || per_cu < 1) { fprintf(stderr, "kernel_launch: occupancy query says %d\n", per_cu); (void)hipGetLastError(); per_cu = 1; }
        grid = cus * per_cu;
    }
    if (grid < 0) return;
    Args a{};
    for (int i = 0; i < 20; ++i) a.in[i] = (const float*)d_in[i];
    a.out = (float*)d_out; a.ws = (unsigned char*)d_ws;
    if (hipMemsetAsync((char*)d_ws + WS_BAR, 0, BAR_BYTES, stream) != hipSuccess) { fprintf(stderr, "kernel_launch: memset of the barrier words failed\n"); return; }
    void* args[] = {&a};
    hipError_t e = hipLaunchCooperativeKernel((const void*)mega_fwd, dim3(grid), dim3(512), args, LDS_BYTES, stream);
    if (e != hipSuccess) fprintf(stderr, "kernel_launch: cooperative launch failed: %s (grid %d)\n", hipGetErrorString(e), grid);
}
```

```cpp
#include <hip/hip_runtime.h>
#include <hip/hip_cooperative_groups.h>
#include <cstdio>
#include <cstdint>
#include <cmath>
namespace cg = cooperative_groups;
namespace pg8 {
#define PG8_LAS __attribute__((address_space(3)))
typedef unsigned short bf16_t;
typedef short bf16x8 __attribute__((ext_vector_type(8)));
typedef float f32x4 __attribute__((ext_vector_type(4)));
typedef unsigned u32x4 __attribute__((ext_vector_type(4)));
constexpr int BM = 256, BK = 64, HALF = 128, HTB = HALF * BK * 2  , STAGE_BYTES = 8 * HTB, NXCD = 8, WGM = 4;

__host__ __device__ __forceinline__ int lds_byte(int r, int c) { const int st = (r >> 4) * 2 + (c >> 5), rr = r & 15, cc = c & 31, ob = rr * 64 + cc * 2; return st * 1024 + (ob ^ (((ob >> 9) & 1) << 5)); }
__host__ __device__ __forceinline__ void stage_rc(int b, int& R, int& C) { const int st = b / 1024, sb = b % 1024, swz = sb ^ (((sb >> 9) & 1) << 5); R = (st >> 1) * 16 + swz / 64; C = (st & 1) * 32 + (swz % 64) / 2; }
__host__ __device__ __forceinline__ int perm32(int rho) { const int n = rho >> 4, i = rho & 15; return 8 * (i >> 2) + 4 * n + (i & 3); }

struct Unit { int pm, pn; };
struct Gemm { const bf16_t* A; const bf16_t* Bt; int M, N, K; };

struct StaticOrder {
    int nM, nN, nwg, G, c;
    __host__ __device__ void init(int M, int N, int G_, int c_) { nM = M / BM; nN = N / BM; nwg = nM * nN; G = G_; c = c_; }
    __host__ __device__ bool next(int i, Unit& u) const {
        const long L = (long)i * G + c; if (L >= nwg) return false;
        int wgid = (int)L; { const int q = nwg / NXCD, r = nwg % NXCD, xcd = wgid % NXCD, off = wgid / NXCD; wgid = (xcd < r ? xcd * (q + 1) : r * (q + 1) + (xcd - r) * q) + off; }
        const int nig = WGM * nN, gid = wgid / nig, fm = gid * WGM, gsz = (nM - fm) < WGM ? (nM - fm) : WGM;
        u.pm = fm + ((wgid % nig) % gsz); u.pn = (wgid % nig) / gsz; return true;
    }
    __device__ __forceinline__ void a_ready(const Unit&) const {}
    __device__ __forceinline__ void done(const Unit&) const {}
};

__device__ __forceinline__ unsigned cvt_pk_bf16(float lo, float hi) { unsigned r; asm volatile("v_cvt_pk_bf16_f32 %0, %1, %2" : "=v"(r) : "v"(lo), "v"(hi)); return r; }
typedef float f32x2 __attribute__((ext_vector_type(2)));
struct OffsetOrder {
    StaticOrder b;
    __device__ void init(int M, int N, int G, int c, int off) { b.init(M, N, G, (c + G - (off % G)) % G); }
    __device__ bool next(int i, Unit& u) const { return b.next(i, u); }
    __device__ __forceinline__ void a_ready(const Unit&) const {}
    __device__ __forceinline__ void done(const Unit&) const {}
};
struct EpiScaleBf16 {
    static constexpr bool PERM = true, AFTER_DRAIN = false;
    bf16_t* O; int ldc; const float* ssq;
    __device__ __forceinline__ void operator()(const f32x4 (&acc)[2][2][4][2], const Unit& u, int wr, int wc, int fr, int fq) const {
        const int row0 = u.pm * BM + wr * 64 + fr, col0 = u.pn * BM + wc * 32 + 8 * fq;
#pragma unroll
        for (int ai = 0; ai < 2; ++ai)
#pragma unroll
            for (int m = 0; m < 4; ++m) { const int row = row0 + ai * HALF + m * 16; const f32x4 q0 = *(const f32x4*)(ssq + (size_t)row * 16), q1 = *(const f32x4*)(ssq + (size_t)row * 16 + 4), q2 = *(const f32x4*)(ssq + (size_t)row * 16 + 8), q3 = *(const f32x4*)(ssq + (size_t)row * 16 + 12);
                const float rs = rsqrtf(((((q0[0] + q0[1]) + (q0[2] + q0[3])) + ((q1[0] + q1[1]) + (q1[2] + q1[3]))) + (((q2[0] + q2[1]) + (q2[2] + q2[3])) + ((q3[0] + q3[1]) + (q3[2] + q3[3])))) * (1.0f / 1024.0f) + 1e-6f);
                bf16_t* rowp = O + (size_t)row * ldc + col0;
#pragma unroll
                for (int bj = 0; bj < 2; ++bj) { const f32x4 v0 = acc[ai][bj][m][0] * rs, v1 = acc[ai][bj][m][1] * rs;
                    u32x4 w; w.x = cvt_pk_bf16(v0[0], v0[1]); w.y = cvt_pk_bf16(v0[2], v0[3]); w.z = cvt_pk_bf16(v1[0], v1[1]); w.w = cvt_pk_bf16(v1[2], v1[3]);
                    *(u32x4*)(rowp + bj * HALF) = w; } }
    }
};
struct EpiResid {
    static constexpr bool PERM = true, AFTER_DRAIN = false;
    bf16_t* hb; float* ssq;
    __device__ __forceinline__ void operator()(const f32x4 (&acc)[2][2][4][2], const Unit& u, int wr, int wc, int fr, int fq) const {
        const int row0 = u.pm * BM + wr * 64 + fr, col0 = u.pn * BM + wc * 32 + 8 * fq;
#pragma unroll
        for (int ai = 0; ai < 2; ++ai)
#pragma unroll
            for (int m = 0; m < 4; ++m) { const int row = row0 + ai * HALF + m * 16; const size_t off = (size_t)row * 1024 + col0; float part = 0.f;
#pragma unroll
                for (int bj = 0; bj < 2; ++bj) { const u32x4 b = *(const u32x4*)(hb + off + bj * HALF);
                    f32x4 v0 = acc[ai][bj][m][0], v1 = acc[ai][bj][m][1];
                    v0[0] += __uint_as_float(b.x << 16); v0[1] += __uint_as_float(b.x & 0xffff0000u); v0[2] += __uint_as_float(b.y << 16); v0[3] += __uint_as_float(b.y & 0xffff0000u);
                    v1[0] += __uint_as_float(b.z << 16); v1[1] += __uint_as_float(b.z & 0xffff0000u); v1[2] += __uint_as_float(b.w << 16); v1[3] += __uint_as_float(b.w & 0xffff0000u);
                    u32x4 w; w.x = cvt_pk_bf16(v0[0], v0[1]); w.y = cvt_pk_bf16(v0[2], v0[3]); w.z = cvt_pk_bf16(v1[0], v1[1]); w.w = cvt_pk_bf16(v1[2], v1[3]);
                    *(u32x4*)(hb + off + bj * HALF) = w;
                    part += (v0[0] * v0[0] + v0[1] * v0[1]) + (v0[2] * v0[2] + v0[3] * v0[3]) + (v1[0] * v1[0] + v1[1] * v1[1]) + (v1[2] * v1[2] + v1[3] * v1[3]); }
                part += __shfl_xor(part, 16); part += __shfl_xor(part, 32);
                if (fq == 0) ssq[(size_t)row * 16 + u.pn * 4 + wc] = part; }
    }
};
struct EpiSwiglu {
    static constexpr bool PERM = true, AFTER_DRAIN = false;
    bf16_t* O; int ldc; const float* ssq;
    __device__ __forceinline__ void operator()(const f32x4 (&acc)[2][2][4][2], const Unit& u, int wr, int wc, int fr, int fq) const {
        const int row0 = u.pm * BM + wr * 64 + fr, col0 = u.pn * HALF + wc * 32 + 8 * fq;
#pragma unroll
        for (int ai = 0; ai < 2; ++ai)
#pragma unroll
            for (int m = 0; m < 4; ++m) { const int row = row0 + ai * HALF + m * 16; const f32x4 q0 = *(const f32x4*)(ssq + (size_t)row * 16), q1 = *(const f32x4*)(ssq + (size_t)row * 16 + 4), q2 = *(const f32x4*)(ssq + (size_t)row * 16 + 8), q3 = *(const f32x4*)(ssq + (size_t)row * 16 + 12);
                const float rs = rsqrtf(((((q0[0] + q0[1]) + (q0[2] + q0[3])) + ((q1[0] + q1[1]) + (q1[2] + q1[3]))) + (((q2[0] + q2[1]) + (q2[2] + q2[3])) + ((q3[0] + q3[1]) + (q3[2] + q3[3])))) * (1.0f / 1024.0f) + 1e-6f);
                float a[8];
#pragma unroll
                for (int n = 0; n < 2; ++n)
#pragma unroll
                    for (int j = 0; j < 4; ++j) { const float g = acc[ai][0][m][n][j] * rs, up = acc[ai][1][m][n][j] * rs; a[4 * n + j] = g * up * __builtin_amdgcn_rcpf(1.0f + __expf(-g)); }
                u32x4 w; w.x = cvt_pk_bf16(a[0], a[1]); w.y = cvt_pk_bf16(a[2], a[3]); w.z = cvt_pk_bf16(a[4], a[5]); w.w = cvt_pk_bf16(a[6], a[7]);
                *(u32x4*)(O + (size_t)row * ldc + col0) = w; }
    }
};
template <class Epi, class Sched, bool ALIGN_EPI = false, bool SP2 = false>
__device__ __forceinline__ void gemm_phase(PG8_LAS unsigned char* lds, const Gemm g, const Sched& S, const Epi& E) {
    int tid_l = threadIdx.x; asm volatile("" : "+v"(tid_l));
    const int tid = tid_l, wid = __builtin_amdgcn_readfirstlane(tid >> 6), lane = tid & 63, wr = wid >> 2, wc = wid & 3, fr = lane & 15, fq = lane >> 4;
    const int K = g.K, nt = K / BK;
    unsigned voffA[2], voffB[2];
#pragma unroll
    for (int i = 0; i < 2; ++i) { int R, C; stage_rc(tid * 16 + i * 8192, R, C); const int Rb = Epi::PERM ? ((R & ~31) + perm32(R & 31)) : R;
        voffA[i] = (unsigned)(R * K + C) * 2u; voffB[i] = (unsigned)(Rb * K + C) * 2u; }
    const size_t kstep = (size_t)(BK * 2);
    const size_t hstep = (size_t)HALF * K * 2;
    const size_t tstep = 2 * hstep;
    const unsigned ldsw = (unsigned)wid * 1024u;
    const int aoff = lds_byte(wr * 64 + fr, fq * 8), boff = lds_byte(wc * 32 + fr, fq * 8);
#define PG8_SA(b, h) (((b) * 2 + (h)) * HTB)
#define PG8_SB(b, h) ((4 + (b) * 2 + (h)) * HTB)
#define PG8_STAGE(bufoff, gbase, voff) do { _Pragma("unroll") for (int _i = 0; _i < 2; ++_i) \
        __builtin_amdgcn_global_load_lds((const unsigned*)((const char*)(gbase) + (voff)[_i]), (PG8_LAS unsigned*)(lds + (bufoff) + ldsw + _i * 8192), 16, 0, 0); } while (0)
#define PG8_LDA(dst, b, h) do { _Pragma("unroll") for (int m = 0; m < 4; ++m) _Pragma("unroll") for (int k = 0; k < 2; ++k) dst[m][k] = *(const PG8_LAS bf16x8*)(lds + PG8_SA(b, h) + aoff + m * 2048 + k * 1024); } while (0)
#define PG8_LDB(dst, b, h) do { _Pragma("unroll") for (int n = 0; n < 2; ++n) _Pragma("unroll") for (int k = 0; k < 2; ++k) dst[n][k] = *(const PG8_LAS bf16x8*)(lds + PG8_SB(b, h) + boff + n * 2048 + k * 1024); } while (0)
#define PG8_MMA(ai, bj, At, Bt) do { __builtin_amdgcn_s_setprio(1); _Pragma("unroll") for (int m = 0; m < 4; ++m) _Pragma("unroll") for (int n = 0; n < 2; ++n) _Pragma("unroll") for (int k = 0; k < 2; ++k) \
        acc[ai][bj][m][n] = __builtin_amdgcn_mfma_f32_16x16x32_bf16(Bt[n][k], At[m][k], acc[ai][bj][m][n], 0, 0, 0); __builtin_amdgcn_s_setprio(0); } while (0)
#define PG8_WAIT_V(n) asm volatile("s_waitcnt vmcnt(" #n ")" ::: "memory")
#define PG8_WAIT_L(n) asm volatile("s_waitcnt lgkmcnt(" #n ")" ::: "memory")
#define PG8_BAR __builtin_amdgcn_s_barrier()
#define PG8_SCHED __builtin_amdgcn_sched_barrier(0)
    Unit cur, nxt; int ui = 0;
    if (!S.next(0, cur)) return;
    f32x4 acc[2][2][4][2];
#pragma unroll
    for (int a = 0; a < 2; ++a)
#pragma unroll
        for (int b = 0; b < 2; ++b)
#pragma unroll
            for (int m = 0; m < 4; ++m)
#pragma unroll
                for (int n = 0; n < 2; ++n) acc[a][b][m][n] = (f32x4){0.f, 0.f, 0.f, 0.f};
    bf16x8 At[4][2], B0[2][2], B1[2][2];
    const char* cA = (const char*)g.A + (size_t)cur.pm * tstep; const char* cB = (const char*)g.Bt + (size_t)cur.pn * tstep;
    S.a_ready(cur);
    if constexpr (SP2) {
        PG8_STAGE(PG8_SB(0, 0), cB, voffB); PG8_STAGE(PG8_SB(0, 1), cB + hstep, voffB); PG8_STAGE(PG8_SA(0, 0), cA, voffA); PG8_STAGE(PG8_SA(0, 1), cA + hstep, voffA);
        if (wr == 1) PG8_BAR;
        PG8_WAIT_V(2); PG8_BAR;
        PG8_STAGE(PG8_SB(1, 0), cB + kstep, voffB); PG8_STAGE(PG8_SA(1, 0), cA + kstep, voffA); PG8_STAGE(PG8_SB(1, 1), cB + hstep + kstep, voffB);
        PG8_WAIT_V(6); PG8_BAR;
    } else {
        PG8_STAGE(PG8_SB(0, 0), cB, voffB); PG8_STAGE(PG8_SA(0, 0), cA, voffA); PG8_STAGE(PG8_SB(0, 1), cB + hstep, voffB); PG8_STAGE(PG8_SA(0, 1), cA + hstep, voffA);
        if (wr == 1) PG8_BAR;
        PG8_WAIT_V(4); PG8_BAR;
        PG8_STAGE(PG8_SB(1, 0), cB + kstep, voffB); PG8_STAGE(PG8_SA(1, 0), cA + kstep, voffA); PG8_STAGE(PG8_SB(1, 1), cB + hstep + kstep, voffB);
        PG8_WAIT_V(6); PG8_BAR;
    }
    for (;;) {
        const bool has_next = S.next(ui + 1, nxt);
        const char* nA = has_next ? (const char*)g.A + (size_t)nxt.pm * tstep : cA; const char* nB = has_next ? (const char*)g.Bt + (size_t)nxt.pn * tstep : cB;
        for (int t = 0; t < nt; t += 2) {
            const bool last = (t == nt - 2);
            const char* a1 = cA + (size_t)(t + 1) * kstep;
            const char* a2 = last ? nA : cA + (size_t)(t + 2) * kstep; const char* b2 = last ? nB : cB + (size_t)(t + 2) * kstep;
            const char* a3 = a2 + kstep; const char* b3 = b2 + kstep;
            if (last && has_next) S.a_ready(nxt);
            if constexpr (SP2) {
            PG8_LDB(B0, 0, 0); PG8_LDB(B1, 0, 1); PG8_SCHED; PG8_LDA(At, 0, 0); PG8_STAGE(PG8_SA(1, 1), a1 + hstep, voffA);
            PG8_WAIT_V(8); PG8_WAIT_L(0); PG8_BAR; PG8_MMA(0, 0, At, B0); PG8_MMA(0, 1, At, B1); PG8_BAR; PG8_SCHED;
            PG8_LDA(At, 0, 1); PG8_STAGE(PG8_SB(0, 0), b2, voffB); PG8_STAGE(PG8_SB(0, 1), b2 + hstep, voffB); PG8_STAGE(PG8_SA(0, 0), a2, voffA);
            PG8_WAIT_V(8); PG8_WAIT_L(0); PG8_BAR; PG8_MMA(1, 0, At, B0); PG8_MMA(1, 1, At, B1); PG8_BAR; PG8_SCHED;
            PG8_LDB(B0, 1, 0); PG8_LDB(B1, 1, 1); PG8_SCHED; PG8_LDA(At, 1, 0); PG8_STAGE(PG8_SA(0, 1), a2 + hstep, voffA);
            PG8_WAIT_V(8); PG8_WAIT_L(0); PG8_BAR; PG8_MMA(0, 0, At, B0); PG8_MMA(0, 1, At, B1); PG8_BAR; PG8_SCHED;
            PG8_LDA(At, 1, 1); PG8_STAGE(PG8_SB(1, 0), b3, voffB); PG8_STAGE(PG8_SB(1, 1), b3 + hstep, voffB); PG8_STAGE(PG8_SA(1, 0), a3, voffA);
            PG8_WAIT_V(8); PG8_WAIT_L(0); PG8_BAR; PG8_MMA(1, 0, At, B0); PG8_MMA(1, 1, At, B1); PG8_BAR; PG8_SCHED;
            } else {
            PG8_LDB(B0, 0, 0); PG8_SCHED; PG8_LDA(At, 0, 0); PG8_STAGE(PG8_SA(1, 1), a1 + hstep, voffA);
            PG8_WAIT_L(8); PG8_BAR; PG8_WAIT_L(0); PG8_MMA(0, 0, At, B0); PG8_BAR; PG8_SCHED;
            PG8_LDB(B1, 0, 1); PG8_STAGE(PG8_SB(0, 0), b2, voffB);
            PG8_BAR; PG8_WAIT_L(0); PG8_MMA(0, 1, At, B1); PG8_BAR;
            PG8_LDA(At, 0, 1); PG8_STAGE(PG8_SA(0, 0), a2, voffA);
            PG8_BAR; PG8_WAIT_L(0); PG8_MMA(1, 0, At, B0); PG8_BAR; PG8_SCHED;
            PG8_STAGE(PG8_SB(0, 1), b2 + hstep, voffB);
            PG8_WAIT_V(6); PG8_BAR; PG8_MMA(1, 1, At, B1); PG8_BAR;
            PG8_LDB(B0, 1, 0); PG8_SCHED; PG8_LDA(At, 1, 0); PG8_STAGE(PG8_SA(0, 1), a2 + hstep, voffA);
            PG8_WAIT_L(8); PG8_BAR; PG8_WAIT_L(0); PG8_MMA(0, 0, At, B0); PG8_BAR; PG8_SCHED;
            PG8_LDB(B1, 1, 1); PG8_STAGE(PG8_SB(1, 0), b3, voffB);
            PG8_BAR; PG8_WAIT_L(0); PG8_MMA(0, 1, At, B1); PG8_BAR;
            PG8_LDA(At, 1, 1); PG8_STAGE(PG8_SA(1, 0), a3, voffA);
            PG8_BAR; PG8_WAIT_L(0); PG8_MMA(1, 0, At, B0); PG8_BAR; PG8_SCHED;
            PG8_STAGE(PG8_SB(1, 1), b3 + hstep, voffB);
            PG8_WAIT_V(6); PG8_BAR; PG8_MMA(1, 1, At, B1); PG8_BAR;
            }
        }
        if constexpr (ALIGN_EPI) { if (wr == 0) PG8_BAR; }
        if constexpr (!Epi::AFTER_DRAIN) { E(acc, cur, wr, wc, fr, fq); S.done(cur); }
        if (!has_next) break;
#pragma unroll
        for (int a = 0; a < 2; ++a)
#pragma unroll
            for (int b = 0; b < 2; ++b)
#pragma unroll
                for (int m = 0; m < 4; ++m)
#pragma unroll
                    for (int n = 0; n < 2; ++n) acc[a][b][m][n] = (f32x4){0.f, 0.f, 0.f, 0.f};
        cur = nxt; cA = nA; cB = nB; ++ui;
        if constexpr (ALIGN_EPI) { if (wr == 1) PG8_BAR; }
    }
    PG8_WAIT_V(0);
    if constexpr (!ALIGN_EPI) { if (wr == 0) PG8_BAR; }
    PG8_BAR;
    if constexpr (Epi::AFTER_DRAIN) { E.fused(acc, cur, wr, wc, fr, fq, lds, wid, lane); S.done(cur); }
#undef PG8_SA
#undef PG8_SB
#undef PG8_STAGE
#undef PG8_LDA
#undef PG8_LDB
#undef PG8_MMA
#undef PG8_WAIT_V
#undef PG8_WAIT_L
#undef PG8_BAR
#undef PG8_SCHED
}
}
#define LAS __attribute__((address_space(3)))
typedef unsigned short bf16;
typedef unsigned v4u __attribute__((ext_vector_type(4)));
typedef float f32x4 __attribute__((ext_vector_type(4)));

constexpr int NB = 8, S = 2048, D = 1024, M = NB * S, NU = 3584, DFF = 2816, MEML = 256, MROWS = NB * MEML, DX = 512;
constexpr size_t MiB = 1u << 20;
constexpr size_t WS_SSQ = 0;
constexpr size_t WS_SSQM = 512 * 1024;
constexpr size_t WS_BAR = 768 * 1024, BAR_BYTES = 32768;
constexpr int LDS_BARST = 147392;
constexpr size_t WS_PRM = 800 * 1024;
constexpr size_t WS_W = 1 * MiB, W_LAYER = 29 * MiB + MiB / 2;
constexpr size_t OW_IN = 0, OW_OUT = 7 * MiB, OW_XQ = 9 * MiB, OW_XKV = 10 * MiB, OW_XO = 12 * MiB, OW_GU = 13 * MiB, OW_DN = 24 * MiB;
constexpr size_t WS_U = 60 * MiB;
constexpr size_t WS_Y = 172 * MiB;
constexpr size_t WS_QX = 172 * MiB, WS_OX = 188 * MiB;
constexpr size_t WS_HB = 204 * MiB;
constexpr size_t WS_MEMB = 236 * MiB;
constexpr size_t WS_KV = 240 * MiB;
constexpr size_t WS_SSQP = 248 * MiB;
constexpr size_t WS_END = 256 * MiB;
constexpr int LDS_BYTES = 147456;

__device__ __forceinline__ unsigned f2bf(float f) { unsigned u = __builtin_bit_cast(unsigned, f); return (u + 0x7fffu + ((u >> 16) & 1u)) >> 16; }
__device__ __forceinline__ unsigned pk2(float lo, float hi) { return f2bf(lo) | (f2bf(hi) << 16); }
__device__ __forceinline__ float bf2f(unsigned short v) { return __uint_as_float(((unsigned)v) << 16); }
__device__ __forceinline__ float lo_f(unsigned w) { return __uint_as_float(w << 16); }
__device__ __forceinline__ float hi_f(unsigned w) { return __uint_as_float(w & 0xffff0000u); }
__device__ __forceinline__ float log_sigmoid_f(float x) { return fminf(x, 0.f) - __logf(1.0f + __expf(-fabsf(x))); }
__device__ __forceinline__ float sigmoid_f(float x) { return __builtin_amdgcn_rcpf(1.0f + __expf(-x)); }
__device__ __forceinline__ float wave_sum(float v) {
#pragma unroll
    for (int o = 1; o < 64; o <<= 1) v += __shfl_xor(v, o);
    return v;
}

#define XB_TMO      128
#define XB_XCNT(j)  (256  + 64 * (j))
#define XB_XSUB(j)  (1280 + 64 * (j))
#define XB_XGEN(j)  (2304 + 64 * (j))
#define XB_TOP      3328
#define XB_TOPGEN   3392
#define XCD_BAR_WORDS 3456
#define XB_SPIN_CAP (1u << 18)

__device__ __forceinline__ unsigned xb_ld(unsigned* p)              { return __hip_atomic_load(p, __ATOMIC_RELAXED, __HIP_MEMORY_SCOPE_AGENT); }
__device__ __forceinline__ unsigned xb_add(unsigned* p, unsigned v) { return __hip_atomic_fetch_add(p, v, __ATOMIC_RELAXED, __HIP_MEMORY_SCOPE_AGENT); }
__device__ __forceinline__ unsigned xb_xcc_id() { return (unsigned)__builtin_amdgcn_s_getreg((3 << 11) | 20) & 0xFu; }
#define XB_SPIN(cond, bar) do { unsigned _sp = 0; while (cond) { __builtin_amdgcn_s_sleep(1); \
    if ((++_sp & 255u) == 0u) { if (xb_ld(&(bar)[XB_TMO])) break; if (_sp > XB_SPIN_CAP) { atomicAdd(&(bar)[XB_TMO], 1u); break; } } } } while (0)

struct XcdBarrier {
    unsigned* bar; unsigned x;
    volatile LAS unsigned* st;
};

__device__ __forceinline__ XcdBarrier xcd_barrier_post(unsigned* bar, volatile LAS unsigned* st) {
    XcdBarrier b; b.bar = bar; b.x = xb_xcc_id(); b.st = st;
    if (threadIdx.x == 0) (void)xb_add(&bar[XB_XCNT(b.x)], 1u);
    return b;
}
__device__ __forceinline__ void xcd_barrier_complete(unsigned* bar, unsigned x, unsigned& nloc, unsigned& nx) {
    const unsigned G = gridDim.x * gridDim.y * gridDim.z;
    unsigned sum, cnt, mine, sp = 0u;
    for (;;) {
        sum = 0u; cnt = 0u; mine = 0u;
#pragma unroll
        for (unsigned j = 0; j < 16; ++j) { const unsigned c = xb_ld(&bar[XB_XCNT(j)]); sum += c; cnt += (c > 0u) ? 1u : 0u; mine = (j == x) ? c : mine; }
        if (sum == G) break;
        __builtin_amdgcn_s_sleep(1);
        if ((++sp & 255u) == 0u) { if (xb_ld(&bar[XB_TMO])) break; if (sp > XB_SPIN_CAP) { atomicAdd(&bar[XB_TMO], 1u); break; } }
    }
    nloc = mine > 0u ? mine : 1u; nx = cnt > 0u ? cnt : 1u;
}

__device__ __forceinline__ void xcd_barrier(const XcdBarrier& b) {
    asm volatile("s_waitcnt vmcnt(0)" ::: "memory");
    __syncthreads();
    if (threadIdx.x == 0) {
        unsigned* bar = b.bar;
        __builtin_amdgcn_s_waitcnt(0);
        unsigned nloc = b.st[0], nx = b.st[1];
        if (nloc == 0u) { xcd_barrier_complete(bar, b.x, nloc, nx); b.st[0] = nloc; b.st[1] = nx; }
        const unsigned old = xb_add(&bar[XB_XSUB(b.x)], 1u);
        const unsigned gen = old / nloc;
        if (old + 1u == (gen + 1u) * nloc) {
            __builtin_amdgcn_fence(__ATOMIC_RELEASE, "agent");
            asm volatile("s_waitcnt vmcnt(0)" ::: "memory");
            const unsigned og = xb_add(&bar[XB_TOP], 1u);
            const unsigned tg = og / nx;
            if (og + 1u == (tg + 1u) * nx) xb_add(&bar[XB_TOPGEN], 1u);
            else XB_SPIN(xb_ld(&bar[XB_TOPGEN]) == tg, bar);
            __builtin_amdgcn_fence(__ATOMIC_ACQUIRE, "agent");
            xb_add(&bar[XB_XGEN(b.x)], 1u);
            asm volatile("s_waitcnt vmcnt(0)" ::: "memory");
        } else {
            XB_SPIN(xb_ld(&bar[XB_XGEN(b.x)]) == gen, bar);
            __builtin_amdgcn_fence(__ATOMIC_ACQUIRE, "agent");
            asm volatile("s_waitcnt vmcnt(0)" ::: "memory");
        }
    }
    __syncthreads();
}

__device__ __forceinline__ void conv_item(const float* W0, const float* W1, int pitch, int K, int mode, const float* rowscale, bf16* WT, LAS float* scr, int item, int nblk, int lane) {
    const int kb = item / nblk, nb = item % nblk, k0 = 64 * kb, n0 = 32 * nb;
    const int n = n0 + (lane & 31);
    const float* src = nullptr;
    if (mode == 0) src = W0 + n;
    else if (mode == 1) { if (n < 1152) src = W0 + n; else if (n < 3456) src = W0 + n + 6; else if (n < 3462) src = W0 + 1152 + (n - 3456); else if (n < 3474) src = W0 + n; }
    else { const int t = n >> 8, j = n & 255; src = (j < 128) ? (W0 + 128 * t + j) : (W1 + 128 * t + (j - 128)); }
#pragma unroll
    for (int i = 0; i < 32; ++i) { const int kk = 2 * i + (lane >> 5); float v = src ? src[(size_t)(k0 + kk) * pitch] : 0.f; if (rowscale) v *= rowscale[k0 + kk]; scr[kk * 33 + (lane & 31)] = v; }
    asm volatile("s_waitcnt lgkmcnt(0)" ::: "memory");
    const int c = lane & 7;
#pragma unroll
    for (int j = 0; j < 4; ++j) { const int nn = (lane >> 3) + 8 * j; const LAS float* s = scr + (8 * c) * 33 + nn;
        v4u o; o.x = pk2(s[0 * 33], s[1 * 33]); o.y = pk2(s[2 * 33], s[3 * 33]); o.z = pk2(s[4 * 33], s[5 * 33]); o.w = pk2(s[6 * 33], s[7 * 33]);
        *(v4u*)(WT + (size_t)(n0 + nn) * K + k0 + 8 * c) = o; }
    asm volatile("s_waitcnt lgkmcnt(0)" ::: "memory");
}
__device__ __forceinline__ void conv_block_item(const float* W0, const float* W1, int pitch, int K, int mode, const float* rowscale, bf16* WT, LAS float* tile, int kb, int nb, int tid) {
    const int k0 = 64 * kb, n0 = 256 * nb, c4 = (tid & 63) * 4;
#pragma unroll
    for (int i = 0; i < 8; ++i) { const int row = 8 * i + (tid >> 6); f32x4 v = {0.f, 0.f, 0.f, 0.f};
        const float* rp = W0 + (size_t)(k0 + row) * pitch;
        if (mode == 0) v = *(const f32x4*)(rp + n0 + c4);
        else if (mode == 2) { const float* rq = (c4 < 128 ? rp : W1 + (size_t)(k0 + row) * pitch) + 128 * nb + (c4 & 127); v = *(const f32x4*)rq; }
        else {
#pragma unroll
            for (int j = 0; j < 4; ++j) { const int n = n0 + c4 + j; int sc = -1;
                if (n < 1152) sc = n; else if (n < 3456) sc = n + 6; else if (n < 3462) sc = 1152 + (n - 3456); else if (n < 3474) sc = n;
                v[j] = sc >= 0 ? rp[sc] : 0.f; } }
        if (rowscale) v = v * rowscale[k0 + row];
        LAS float* d = tile + row * 257 + c4; d[0] = v[0]; d[1] = v[1]; d[2] = v[2]; d[3] = v[3]; }
    __syncthreads();
    const int q = tid & 7;
#pragma unroll
    for (int pass = 0; pass < 4; ++pass) { const int nl = (tid >> 3) + 64 * pass; const LAS float* sp = tile + (8 * q) * 257 + nl;
        v4u o; o.x = pk2(sp[0], sp[257]); o.y = pk2(sp[2 * 257], sp[3 * 257]); o.z = pk2(sp[4 * 257], sp[5 * 257]); o.w = pk2(sp[6 * 257], sp[7 * 257]);
        *(v4u*)(WT + (size_t)(n0 + nl) * K + k0 + 8 * q) = o; }
    __syncthreads();
}
__device__ __forceinline__ void row_to_bf16_ssq(const float* xrow, bf16* orow, float* ssq_out, int lane) {
    const f32x4* xr = (const f32x4*)xrow + lane; f32x4 v[4]; float s2 = 0.f;
#pragma unroll
    for (int j = 0; j < 4; ++j) { v[j] = xr[64 * j]; s2 += (v[j].x * v[j].x + v[j].y * v[j].y) + (v[j].z * v[j].z + v[j].w * v[j].w); }
    s2 = wave_sum(s2);
    unsigned long long* o8 = (unsigned long long*)orow + lane;
#pragma unroll
    for (int j = 0; j < 4; ++j) o8[64 * j] = (unsigned long long)pk2(v[j].x, v[j].y) | ((unsigned long long)pk2(v[j].z, v[j].w) << 32);
    if (lane < 16) ssq_out[lane] = lane == 0 ? s2 : 0.f;
}

typedef short s16x8 __attribute__((ext_vector_type(8)));
typedef short s16x4 __attribute__((ext_vector_type(4)));
typedef float f32x16 __attribute__((ext_vector_type(16)));
__device__ __forceinline__ s16x4 tr_read(LAS const unsigned char* p) { return __builtin_bit_cast(s16x4, __builtin_amdgcn_ds_read_tr16_b64_v4i16((LAS s16x4*)p)); }
__device__ __forceinline__ s16x8 cat8(s16x4 a, s16x4 b) { return (s16x8){a[0], a[1], a[2], a[3], b[0], b[1], b[2], b[3]}; }
__device__ __forceinline__ unsigned cvtpk(float lo, float hi) { return pg8::cvt_pk_bf16(lo, hi); }
__device__ __forceinline__ s16x8 pack8(float a0, float a1, float a2, float a3, float a4, float a5, float a6, float a7) {
    v4u w; w.x = cvtpk(a0, a1); w.y = cvtpk(a2, a3); w.z = cvtpk(a4, a5); w.w = cvtpk(a6, a7); return __builtin_bit_cast(s16x8, w); }
#define MFMA32(a, b, c) __builtin_amdgcn_mfma_f32_32x32x16_bf16(a, b, c, 0, 0, 0)
__device__ __forceinline__ float xh_sum(float x) { auto rr = __builtin_amdgcn_permlane32_swap(__float_as_uint(x), __float_as_uint(x), false, false); return __uint_as_float(rr[0]) + __uint_as_float(rr[1]); }
__device__ __forceinline__ float xh_max(float x) { auto rr = __builtin_amdgcn_permlane32_swap(__float_as_uint(x), __float_as_uint(x), false, false); return fmaxf(__uint_as_float(rr[0]), __uint_as_float(rr[1])); }
__device__ __forceinline__ float xh_prod(float x) { auto rr = __builtin_amdgcn_permlane32_swap(__float_as_uint(x), __float_as_uint(x), false, false); return __uint_as_float(rr[0]) * __uint_as_float(rr[1]); }
__device__ __forceinline__ float xh_other(float x) { auto rr = __builtin_amdgcn_permlane32_swap(__float_as_uint(x), __float_as_uint(x), false, false); return __uint_as_float(rr[0] == __float_as_uint(x) ? rr[1] : rr[0]); }
__device__ __forceinline__ void st_wt64(float* p, float a, float b) { __hip_atomic_store((unsigned long long*)p, ((unsigned long long)__float_as_uint(b) << 32) | (unsigned long long)__float_as_uint(a), __ATOMIC_RELAXED, __HIP_MEMORY_SCOPE_AGENT); }
__device__ __forceinline__ void st_wt32(float* p, float a) { __hip_atomic_store((unsigned*)p, __float_as_uint(a), __ATOMIC_RELAXED, __HIP_MEMORY_SCOPE_AGENT); }
__device__ __forceinline__ void fox_cumsum_item(const bf16* u, const float* foxb, float* cl, float* tot, int item, int lane) {
    const int bhf = item >> 3, seg = item & 7, b = bhf / 6, h = bhf % 6;
    const float fb = foxb[h];
    const bf16* p = u + ((size_t)b * S + seg * 256 + 4 * lane) * NU + 3456 + h;
    const float L2E = 1.4426950408889634f;
    float l0 = L2E * log_sigmoid_f(bf2f(p[0]) + fb), l1 = L2E * log_sigmoid_f(bf2f(p[NU]) + fb), l2 = L2E * log_sigmoid_f(bf2f(p[2 * NU]) + fb), l3 = L2E * log_sigmoid_f(bf2f(p[3 * NU]) + fb);
    l1 += l0; l2 += l1; l3 += l2;
    float inc = l3;
#pragma unroll
    for (int o = 1; o < 64; o <<= 1) { const float v = __shfl_up(inc, o, 64); if (lane >= o) inc += v; }
    const float ex = inc - l3;
    { float* d = cl + (size_t)bhf * S + seg * 256 + 4 * lane; st_wt64(d, ex + l0, ex + l1); st_wt64(d + 2, ex + l2, ex + l3); }
    if (lane == 63) st_wt32(tot + bhf * 8 + seg, inc);
}
constexpr int PV64 = 144;
__device__ __forceinline__ void attn_mfma_item(const bf16* u, bf16* y, const float* cl, const float* tot, LAS unsigned char* wl, int item, int lane) {
    const int bh = item % 80, qb = 63 - item / 80;
    const bool fox = bh < 48;
    int b, h, qoff, koff, voff, yoff;
    if (fox) { b = bh / 6; h = bh % 6; qoff = h * 64; koff = 384 + h * 64; voff = 768 + h * 64; yoff = h * 64; }
    else { const int rr = bh - 48; b = rr / 4; h = rr % 4; qoff = 1152 + h * 64; koff = 1408 + h * 64; voff = 1664 + h * 64; yoff = 384 + h * 64; }
    const int r = lane & 31, hi = lane >> 5;
    const char* ubc = (const char*)(u + (size_t)b * S * NU);
    const int t = qb * 32 + r;
    const float* clh = cl + (size_t)(fox ? bh : 0) * S;
    s16x8 Qf[4];
    { const unsigned qo = (unsigned)(t * NU + qoff + 8 * hi) * 2u;
#pragma unroll
      for (int d0 = 0; d0 < 4; ++d0) Qf[d0] = *(const s16x8*)(ubc + qo + 32 * d0);
      if (!fox) {
          const float qs = -0.125f * 1.4426950408889634f;
#pragma unroll
          for (int d0 = 0; d0 < 4; ++d0) { const v4u w = __builtin_bit_cast(v4u, Qf[d0]);
              Qf[d0] = pack8(lo_f(w.x) * qs, hi_f(w.x) * qs, lo_f(w.y) * qs, hi_f(w.y) * qs, lo_f(w.z) * qs, hi_f(w.z) * qs, lo_f(w.w) * qs, hi_f(w.w) * qs); } } }
    f32x16 O0, O1;
#pragma unroll
    for (int i = 0; i < 16; ++i) { O0[i] = 0.f; O1[i] = 0.f; }
    float mrun = -1e30f, lsum = 0.f, Rsb = 1.f, Doff = 0.f;
    const float clt = fox ? clh[t] : 0.f;
    LAS float* gl = (LAS float*)(wl + 4608);
    const int trbase = (4 * hi + ((lane >> 2) & 3)) * PV64 + (16 * ((lane >> 4) & 1) + 4 * (lane & 3)) * 2;
    const unsigned lane_off = (unsigned)((lane >> 3) * NU + 8 * (lane & 7)) * 2u;
    v4u kn[4], vn[4]; float gn = 0.f;
    { const char* tb = ubc + (size_t)(qb * 32) * NU * 2;
#pragma unroll
      for (int i = 0; i < 4; ++i) { kn[i] = *(const v4u*)(tb + (size_t)(8 * i * NU + koff) * 2 + lane_off); vn[i] = *(const v4u*)(tb + (size_t)(8 * i * NU + voff) * 2 + lane_off); }
      if (fox) gn = clh[qb * 32 + r]; }
    LAS unsigned char* kl = wl + 4736;
    const int kfoff = r * PV64 + 16 * hi;
    const float SC2 = 0.125f * 1.4426950408889634f;
    { LAS unsigned char* z = wl + 9344 + (lane >> 3) * PV64 + 16 * (lane & 7);
#pragma unroll
      for (int i = 0; i < 4; ++i) *(LAS v4u*)(z + 8 * i * PV64) = (v4u){0u, 0u, 0u, 0u}; }
    s16x8 Pp0 = {0, 0, 0, 0, 0, 0, 0, 0}, Pp1 = {0, 0, 0, 0, 0, 0, 0, 0};
    int vlast = 0;
    for (int jt = qb; jt >= 0; --jt) {
        const bool diag = (jt == qb);
        const int vcur = ((qb - jt) & 1) ? 9344 : 0, vprev = 9344 - vcur; vlast = vcur;
        { LAS unsigned char* dk = kl + (lane >> 3) * PV64 + 16 * (lane & 7); LAS unsigned char* dv = wl + vcur + (lane >> 3) * PV64 + 16 * (lane & 7);
#pragma unroll
          for (int i = 0; i < 4; ++i) { *(LAS v4u*)(dk + 8 * i * PV64) = kn[i]; *(LAS v4u*)(dv + 8 * i * PV64) = vn[i]; } }
        if (fox) gl[r] = -gn;
        if (jt > 0) { const char* tb = ubc + (size_t)((jt - 1) * 32) * NU * 2;
#pragma unroll
          for (int i = 0; i < 4; ++i) { kn[i] = *(const v4u*)(tb + (size_t)(8 * i * NU + koff) * 2 + lane_off); vn[i] = *(const v4u*)(tb + (size_t)(8 * i * NU + voff) * 2 + lane_off); }
          if (fox) gn = clh[(jt - 1) * 32 + r]; }
        s16x8 Kf[4];
#pragma unroll
        for (int d0 = 0; d0 < 4; ++d0) Kf[d0] = *(LAS const s16x8*)(kl + kfoff + 32 * d0);
        LAS const unsigned char* vb = wl + vprev + trbase;
        const s16x8 V00 = cat8(tr_read(vb), tr_read(vb + 8 * PV64)), V01 = cat8(tr_read(vb + 16 * PV64), tr_read(vb + 24 * PV64));
        const s16x8 V10 = cat8(tr_read(vb + 64), tr_read(vb + 8 * PV64 + 64)), V11 = cat8(tr_read(vb + 16 * PV64 + 64), tr_read(vb + 24 * PV64 + 64));
        f32x16 Sx;
#pragma unroll
        for (int i = 0; i < 16; ++i) Sx[i] = 0.f;
        Sx = MFMA32(Kf[0], Qf[0], Sx); O0 = MFMA32(V00, Pp0, O0);
        Sx = MFMA32(Kf[1], Qf[1], Sx); O1 = MFMA32(V10, Pp0, O1);
        Sx = MFMA32(Kf[2], Qf[2], Sx); O0 = MFMA32(V01, Pp1, O0);
        Sx = MFMA32(Kf[3], Qf[3], Sx); O1 = MFMA32(V11, Pp1, O1);
        float P[16];
        if (fox) {
            const float off = clt + Doff;
            float tmax = -1e30f;
#pragma unroll
            for (int g = 0; g < 4; ++g) { const f32x4 ncs = *(LAS const f32x4*)(gl + 8 * g + 4 * hi);
#pragma unroll
                for (int e = 0; e < 4; ++e) P[4 * g + e] = fmaf(SC2, Sx[4 * g + e], ncs[e]); }
            if (diag) {
#pragma unroll
                for (int i = 0; i < 16; ++i) { const int sl = 8 * (i >> 2) + 4 * hi + (i & 3); if (sl > r) P[i] = -1e30f; } }
#pragma unroll
            for (int i = 0; i < 16; ++i) tmax = fmaxf(tmax, P[i]);
            tmax = xh_max(tmax) + off;
            if (__any(tmax > mrun)) {
                const float mnew = fmaxf(mrun, tmax), alpha = __builtin_amdgcn_exp2f(mrun - mnew); lsum *= alpha; mrun = mnew;
#pragma unroll
                for (int i = 0; i < 16; ++i) { O0[i] *= alpha; O1[i] *= alpha; } }
            const float msh = mrun - off; float ps = 0.f;
#pragma unroll
            for (int i = 0; i < 16; ++i) { P[i] = __builtin_amdgcn_exp2f(P[i] - msh); ps += P[i]; }
            lsum += ps;
            if (jt > 0 && ((jt - 1) >> 3) != (jt >> 3)) Doff += tot[bh * 8 + ((jt - 1) >> 3)];
        } else {
            float kp[16], gs[4], go[4]; float T = 1.f;
#pragma unroll
            for (int i = 0; i < 16; ++i) { const float ee = __builtin_amdgcn_exp2f(Sx[i]); const float sig = __builtin_amdgcn_rcpf(1.0f + ee); P[i] = sig; kp[i] = 1.0f - sig; }
            if (diag) {
#pragma unroll
                for (int i = 0; i < 16; ++i) { const int sl = 8 * (i >> 2) + 4 * hi + (i & 3); if (sl >= r) { P[i] = 0.f; kp[i] = 1.f; } } }
#pragma unroll
            for (int g = 0; g < 4; ++g) { gs[g] = (kp[4 * g] * kp[4 * g + 1]) * (kp[4 * g + 2] * kp[4 * g + 3]); T *= gs[g]; }
#pragma unroll
            for (int g = 0; g < 4; ++g) go[g] = xh_other(gs[g]);
            float above = Rsb;
#pragma unroll
            for (int g = 3; g >= 0; --g) {
                float suf = hi == 0 ? above * go[g] : above;
#pragma unroll
                for (int e = 3; e >= 0; --e) { const float a = P[4 * g + e] * suf; suf *= kp[4 * g + e]; P[4 * g + e] = a; }
                above *= gs[g] * go[g];
            }
            Rsb *= xh_prod(T);
        }
        Pp0 = pack8(P[0], P[1], P[2], P[3], P[4], P[5], P[6], P[7]); Pp1 = pack8(P[8], P[9], P[10], P[11], P[12], P[13], P[14], P[15]);
        if (!fox && __all(Rsb == 0.0f)) break;
    }
    { LAS const unsigned char* vb = wl + vlast + trbase;
      const s16x8 V00 = cat8(tr_read(vb), tr_read(vb + 8 * PV64)), V01 = cat8(tr_read(vb + 16 * PV64), tr_read(vb + 24 * PV64));
      const s16x8 V10 = cat8(tr_read(vb + 64), tr_read(vb + 8 * PV64 + 64)), V11 = cat8(tr_read(vb + 16 * PV64 + 64), tr_read(vb + 24 * PV64 + 64));
      O0 = MFMA32(V00, Pp0, O0); O1 = MFMA32(V10, Pp0, O1); O0 = MFMA32(V01, Pp1, O0); O1 = MFMA32(V11, Pp1, O1); }
    float inv = 1.0f;
    if (fox) { lsum = xh_sum(lsum); inv = __builtin_amdgcn_rcpf(lsum); }
    char* yb0 = (char*)(y + (size_t)b * S * D); const unsigned yo = (unsigned)(t * D + yoff + 4 * hi) * 2u;
#pragma unroll
    for (int g = 0; g < 4; ++g) {
        unsigned long long w0 = (unsigned long long)cvtpk(O0[4 * g] * inv, O0[4 * g + 1] * inv) | ((unsigned long long)cvtpk(O0[4 * g + 2] * inv, O0[4 * g + 3] * inv) << 32);
        unsigned long long w1 = (unsigned long long)cvtpk(O1[4 * g] * inv, O1[4 * g + 1] * inv) | ((unsigned long long)cvtpk(O1[4 * g + 2] * inv, O1[4 * g + 3] * inv) << 32);
        *(unsigned long long*)(yb0 + yo + 16 * g) = w0; *(unsigned long long*)(yb0 + yo + 64 + 16 * g) = w1; }
}
constexpr int PV128 = 272;
__device__ __forceinline__ void xattn_mfma_item(const bf16* qx, const bf16* kv, bf16* ox, LAS unsigned char* wl, int item, int lane) {
    const int head = item & 3, qblk = item >> 2;
    const int r = lane & 31, hi = lane >> 5;
    const int token = qblk * 32 + r, b = (qblk * 32) / S;
    s16x8 Qf[8];
    { const char* qb_ = (const char*)qx; const unsigned qo = (unsigned)(token * DX + head * 128 + 8 * hi) * 2u;
#pragma unroll
      for (int d0 = 0; d0 < 8; ++d0) Qf[d0] = *(const s16x8*)(qb_ + qo + 32 * d0); }
    f32x16 O[4];
#pragma unroll
    for (int k = 0; k < 4; ++k)
#pragma unroll
        for (int i = 0; i < 16; ++i) O[k][i] = 0.f;
    float mrun = -1e30f, lsum = 0.f;
    const int trbase = (4 * hi + ((lane >> 2) & 3)) * PV128 + (16 * ((lane >> 4) & 1) + 4 * (lane & 3)) * 2;
    const char* kvc = (const char*)(kv + (size_t)b * MEML * 1024);
    const unsigned kfo = (unsigned)(r * 1024 + head * 128 + 8 * hi) * 2u;
    const unsigned vlo = (unsigned)((lane >> 4) * 1024 + 512 + head * 128 + 8 * (lane & 15)) * 2u;
    s16x8 Kn[8]; v4u vn[8];
#pragma unroll
    for (int d0 = 0; d0 < 8; ++d0) Kn[d0] = *(const s16x8*)(kvc + kfo + 32 * d0);
#pragma unroll
    for (int i = 0; i < 8; ++i) vn[i] = *(const v4u*)(kvc + vlo + (size_t)(4 * i) * 2048);
    const float SCX = 0.08838834764831845f * 1.4426950408889634f;
    for (int jt = 0; jt < 8; ++jt) {
        f32x16 Sx;
#pragma unroll
        for (int i = 0; i < 16; ++i) Sx[i] = 0.f;
#pragma unroll
        for (int d0 = 0; d0 < 8; ++d0) Sx = MFMA32(Kn[d0], Qf[d0], Sx);
        { LAS unsigned char* dst = wl + (lane >> 4) * PV128 + 16 * (lane & 15);
#pragma unroll
          for (int i = 0; i < 8; ++i) *(LAS v4u*)(dst + 4 * i * PV128) = vn[i]; }
        if (jt < 7) { const char* tb = kvc + (size_t)((jt + 1) * 32) * 2048;
#pragma unroll
            for (int d0 = 0; d0 < 8; ++d0) Kn[d0] = *(const s16x8*)(tb + kfo + 32 * d0);
#pragma unroll
            for (int i = 0; i < 8; ++i) vn[i] = *(const v4u*)(tb + vlo + (size_t)(4 * i) * 2048); }
        float P[16]; float tmax = -1e30f;
#pragma unroll
        for (int i = 0; i < 16; ++i) { P[i] = Sx[i] * SCX; tmax = fmaxf(tmax, P[i]); }
        tmax = xh_max(tmax);
        if (__any(tmax > mrun)) { const float mnew = fmaxf(mrun, tmax), alpha = __builtin_amdgcn_exp2f(mrun - mnew); lsum *= alpha; mrun = mnew;
#pragma unroll
            for (int k = 0; k < 4; ++k)
#pragma unroll
                for (int i = 0; i < 16; ++i) O[k][i] *= alpha; }
        float ps = 0.f;
#pragma unroll
        for (int i = 0; i < 16; ++i) { P[i] = __builtin_amdgcn_exp2f(P[i] - mrun); ps += P[i]; }
        lsum += ps;
        const s16x8 Pf0 = pack8(P[0], P[1], P[2], P[3], P[4], P[5], P[6], P[7]), Pf1 = pack8(P[8], P[9], P[10], P[11], P[12], P[13], P[14], P[15]);
        LAS const unsigned char* vb = wl + trbase;
#pragma unroll
        for (int k = 0; k < 4; ++k) {
            const s16x8 Va = cat8(tr_read(vb + 64 * k), tr_read(vb + 8 * PV128 + 64 * k)), Vb = cat8(tr_read(vb + 16 * PV128 + 64 * k), tr_read(vb + 24 * PV128 + 64 * k));
            O[k] = MFMA32(Va, Pf0, O[k]); O[k] = MFMA32(Vb, Pf1, O[k]); }
    }
    lsum = xh_sum(lsum); const float inv = __builtin_amdgcn_rcpf(lsum);
    char* oc = (char*)ox; const unsigned oo = (unsigned)(token * DX + head * 128 + 4 * hi) * 2u;
#pragma unroll
    for (int k = 0; k < 4; ++k)
#pragma unroll
        for (int g = 0; g < 4; ++g) {
            const unsigned long long w0 = (unsigned long long)cvtpk(O[k][4 * g] * inv, O[k][4 * g + 1] * inv) | ((unsigned long long)cvtpk(O[k][4 * g + 2] * inv, O[k][4 * g + 3] * inv) << 32);
            *(unsigned long long*)(oc + oo + 64 * k + 16 * g) = w0; }
}

constexpr int ML_WSTRIDE = 18432, ML_RAWK = 0, ML_RAWQ = 5056, ML_WK = 5056, ML_V = 10112, ML_CW = 14720, ML_EB = 16768, ML_NL = 16896, ML_NW = 17152, ML_ITEM_F = 4224;
template <bool OUT>
__device__ __forceinline__ void mlstm_item(const bf16* u, bf16* y, float* scratch, const float* convw, const float* ib, const float* fbias, const float* normw, LAS unsigned char* wl, int bh, int c, int lane) {
    const int b = bh / 6, h = bh % 6, r = lane & 31, hi = lane >> 5;
    const bf16* ub = u + (size_t)b * S * NU;
    LAS float* cw = (LAS float*)(wl + ML_CW); LAS float* eb = (LAS float*)(wl + ML_EB); LAS float* nl = (LAS float*)(wl + ML_NL); LAS float* nwl = (LAS float*)(wl + ML_NW);
    for (int i = lane; i < 512; i += 64) { const int tap = i >> 7, ch = i & 127; cw[i] = convw[tap * 768 + (ch < 64 ? (64 * h + ch) : (384 + 64 * h + (ch - 64)))]; }
    if (OUT) nwl[lane] = normw[h * 64 + lane];
    const float ibh = ib[h], fbh = fbias[h];
    f32x16 X[2][2];
#pragma unroll
    for (int a = 0; a < 2; ++a)
#pragma unroll
        for (int bb = 0; bb < 2; ++bb)
#pragma unroll
            for (int i = 0; i < 16; ++i) X[a][bb][i] = 0.f;
    float nk = 0.f, Gsum = 0.f;
    if (OUT) {
        float dec = 1.f;
        for (int cp = c - 1; cp >= 0; --cp) {
            const float* s0 = scratch + (size_t)(bh * 16 + cp) * ML_ITEM_F;
            f32x16 v0[4];
#pragma unroll
            for (int blk = 0; blk < 4; ++blk) v0[blk] = *(const f32x16*)(s0 + blk * 1024 + lane * 16);
            const float n0 = s0[4096 + lane], g0 = s0[4160];
#pragma unroll
            for (int blk = 0; blk < 4; ++blk) X[blk >> 1][blk & 1] += v0[blk] * dec;
            nk += dec * n0;
            dec *= __expf(g0);
        }
    }
    nl[lane] = nk;
    const int trP = (4 * hi + ((lane >> 2) & 3)) * 144 + (16 * ((lane >> 4) & 1) + 4 * (lane & 3)) * 2;
    const int trN = (8 * hi + ((lane >> 2) & 3)) * 144 + (16 * ((lane >> 4) & 1) + 4 * (lane & 3)) * 2;
    for (int j = 0; j < 4; ++j) {
        const int t0 = c * 128 + j * 32, t = t0 + r;
        const bf16* trow = ub + (size_t)t * NU;
        const unsigned short gfr = trow[3468 + h], gir = trow[3462 + h];
        v4u vv[4], rk[5], rq[5];
        { const bf16* vrow = ub + (size_t)(t0 + (lane >> 3)) * NU + 2688 + 64 * h + 8 * (lane & 7);
#pragma unroll
          for (int i = 0; i < 4; ++i) vv[i] = *(const v4u*)(vrow + (size_t)(8 * i) * NU); }
#pragma unroll
        for (int i = 0; i < 5; ++i) { const int p = lane + 64 * i, row = p >> 3, ch8 = p & 7, tt = t0 - 3 + row; const bool ok = (p < 280) && (tt >= 0);
            const bf16* src = ub + (size_t)(ok ? tt : 0) * NU + 1920 + 64 * h + 8 * ch8;
            rk[i] = ok ? *(const v4u*)(src + 384) : (v4u){0u, 0u, 0u, 0u};
            if (OUT) rq[i] = ok ? *(const v4u*)(src) : (v4u){0u, 0u, 0u, 0u}; }
#pragma unroll
        for (int i = 0; i < 5; ++i) { const int p = lane + 64 * i, row = p >> 3, ch8 = p & 7;
            if (p < 280) { *(LAS v4u*)(wl + ML_RAWK + row * 144 + 16 * ch8) = rk[i]; if (OUT) *(LAS v4u*)(wl + ML_RAWQ + row * 144 + 16 * ch8) = rq[i]; } }
        { LAS unsigned char* dst = wl + ML_V + (lane >> 3) * 144 + 16 * (lane & 7);
#pragma unroll
          for (int i = 0; i < 4; ++i) *(LAS v4u*)(dst + 8 * i * 144) = vv[i]; }
        float bl = log_sigmoid_f(bf2f(gfr) + fbh); const float ii = bf2f(gir) + ibh;
#pragma unroll
        for (int o = 1; o < 32; o <<= 1) { const float v = __shfl_up(bl, o, 32); if (r >= o) bl += v; }
        const float g = __shfl(bl, 31, 32), es = ii - bl;
        eb[r] = es; Gsum += g;
        s16x8 Kf[4], Qf[4]; float dq = 0.f;
#pragma unroll
        for (int part = (OUT ? 0 : 1); part < 2; ++part) {
            LAS unsigned char* raw = wl + (part ? ML_RAWK : ML_RAWQ);
            const float w0 = cw[part * 64 + lane], w1 = cw[128 + part * 64 + lane], w2 = cw[256 + part * 64 + lane], w3 = cw[384 + part * 64 + lane];
            const float sc = part ? 0.125f : 1.0f;
            float xv[35];
#pragma unroll
            for (int i = 0; i < 35; ++i) xv[i] = bf2f(*(LAS const unsigned short*)(raw + i * 144 + 2 * lane));
#pragma unroll
            for (int i = 0; i < 16; ++i) {
                const float a0 = w0 * xv[2 * i] + w1 * xv[2 * i + 1] + w2 * xv[2 * i + 2] + w3 * xv[2 * i + 3];
                const float a1 = w0 * xv[2 * i + 1] + w1 * xv[2 * i + 2] + w2 * xv[2 * i + 3] + w3 * xv[2 * i + 4];
                const unsigned pk = cvtpk(a0 * sc * __builtin_amdgcn_rcpf(1.0f + __expf(-a0)), a1 * sc * __builtin_amdgcn_rcpf(1.0f + __expf(-a1)));
                *(LAS unsigned short*)(raw + (2 * i) * 144 + 2 * lane) = (unsigned short)pk; *(LAS unsigned short*)(raw + (2 * i + 1) * 144 + 2 * lane) = (unsigned short)(pk >> 16); }
#pragma unroll
            for (int f = 0; f < 4; ++f) {
                const unsigned long long p0 = *(LAS const unsigned long long*)(raw + r * 144 + (16 * f + 4 * hi) * 2), p1 = *(LAS const unsigned long long*)(raw + r * 144 + (16 * f + 8 + 4 * hi) * 2);
                const v4u fw = {(unsigned)p0, (unsigned)(p0 >> 32), (unsigned)p1, (unsigned)(p1 >> 32)};
                if (part) Kf[f] = __builtin_bit_cast(s16x8, fw); else Qf[f] = __builtin_bit_cast(s16x8, fw);
                if (OUT && part == 0) { const f32x4 n0 = *(LAS const f32x4*)(nl + 16 * f + 4 * hi), n1 = *(LAS const f32x4*)(nl + 16 * f + 8 + 4 * hi);
                    dq += (lo_f(fw.x) * n0[0] + hi_f(fw.x) * n0[1]) + (lo_f(fw.y) * n0[2] + hi_f(fw.y) * n0[3]) + (lo_f(fw.z) * n1[0] + hi_f(fw.z) * n1[1]) + (lo_f(fw.w) * n1[2] + hi_f(fw.w) * n1[3]); } }
        }
        if (OUT) {
            f32x16 Sx;
#pragma unroll
            for (int i = 0; i < 16; ++i) Sx[i] = 0.f;
#pragma unroll
            for (int f = 0; f < 4; ++f) Sx = MFMA32(Kf[f], Qf[f], Sx);
            float P[16]; float den = 0.f;
#pragma unroll
            for (int g4 = 0; g4 < 4; ++g4) { const f32x4 e4 = *(LAS const f32x4*)(eb + 8 * g4 + 4 * hi);
#pragma unroll
                for (int e = 0; e < 4; ++e) { const int sl = 8 * g4 + 4 * hi + e; const float d = (sl <= r) ? __expf(bl + e4[e]) : 0.f; P[4 * g4 + e] = Sx[4 * g4 + e] * d; den += P[4 * g4 + e]; } }
            den = xh_sum(den); dq = xh_sum(dq);
            const float ebt = __expf(bl);
            const float inv = 1.0f / fmaxf(fabsf(den + ebt * dq), 1.0f);
            const s16x8 Pf0 = pack8(P[0], P[1], P[2], P[3], P[4], P[5], P[6], P[7]), Pf1 = pack8(P[8], P[9], P[10], P[11], P[12], P[13], P[14], P[15]);
            unsigned long long ow[8];
#pragma unroll
            for (int vb = 0; vb < 2; ++vb)
#pragma unroll
                for (int g4 = 0; g4 < 4; ++g4) ow[4 * vb + g4] = *(const unsigned long long*)(trow + 3072 + 64 * h + 32 * vb + 8 * g4 + 4 * hi);
            f32x16 H[2]; float ms = 0.f;
#pragma unroll
            for (int vb = 0; vb < 2; ++vb) {
                LAS const unsigned char* vp = wl + ML_V + trP + 64 * vb;
                f32x16 Zi, Zx;
#pragma unroll
                for (int i = 0; i < 16; ++i) { Zi[i] = 0.f; Zx[i] = 0.f; }
                Zi = MFMA32(cat8(tr_read(vp), tr_read(vp + 8 * 144)), Pf0, Zi); Zi = MFMA32(cat8(tr_read(vp + 16 * 144), tr_read(vp + 24 * 144)), Pf1, Zi);
#pragma unroll
                for (int kb = 0; kb < 2; ++kb)
#pragma unroll
                    for (int sp = 0; sp < 2; ++sp) { const f32x16& xx = X[kb][vb];
                        const s16x8 xa = pack8(xx[8 * sp], xx[8 * sp + 1], xx[8 * sp + 2], xx[8 * sp + 3], xx[8 * sp + 4], xx[8 * sp + 5], xx[8 * sp + 6], xx[8 * sp + 7]);
                        Zx = MFMA32(xa, Qf[2 * kb + sp], Zx); }
#pragma unroll
                for (int i = 0; i < 16; ++i) { const float hv = (Zi[i] + ebt * Zx[i]) * inv; H[vb][i] = hv; ms += hv * hv; }
            }
            ms = xh_sum(ms);
            const float rs = rsqrtf(ms * (1.0f / 64.0f) + 1e-6f);
            bf16* yrow = y + ((size_t)b * S + t) * D + 640 + 64 * h;
#pragma unroll
            for (int vb = 0; vb < 2; ++vb)
#pragma unroll
                for (int g4 = 0; g4 < 4; ++g4) { const int v = 32 * vb + 8 * g4 + 4 * hi;
                    const unsigned o0 = (unsigned)ow[4 * vb + g4], o1 = (unsigned)(ow[4 * vb + g4] >> 32);
                    const f32x4 w4 = *(LAS const f32x4*)(nwl + v);
                    const float y0 = H[vb][4 * g4] * rs * w4[0] * sigmoid_f(lo_f(o0)), y1 = H[vb][4 * g4 + 1] * rs * w4[1] * sigmoid_f(hi_f(o0));
                    const float y2 = H[vb][4 * g4 + 2] * rs * w4[2] * sigmoid_f(lo_f(o1)), y3 = H[vb][4 * g4 + 3] * rs * w4[3] * sigmoid_f(hi_f(o1));
                    *(unsigned long long*)(yrow + v) = (unsigned long long)cvtpk(y0, y1) | ((unsigned long long)cvtpk(y2, y3) << 32); }
        }
        { const float wsc = __expf(g + es), eg = __expf(g);
#pragma unroll
          for (int f = 0; f < 4; ++f) { const v4u kw = __builtin_bit_cast(v4u, Kf[f]);
#pragma unroll
              for (int e = 0; e < 2; ++e) { const unsigned k0 = e ? kw.z : kw.x, k1 = e ? kw.w : kw.y; const int ch = 16 * f + 8 * e + 4 * hi;
                  *(LAS unsigned long long*)(wl + ML_WK + r * 144 + ch * 2) = (unsigned long long)cvtpk(lo_f(k0) * wsc, hi_f(k0) * wsc) | ((unsigned long long)cvtpk(lo_f(k1) * wsc, hi_f(k1) * wsc) << 32); } }
#pragma unroll
          for (int kb = 0; kb < 2; ++kb)
#pragma unroll
              for (int vb = 0; vb < 2; ++vb) { X[kb][vb] *= eg;
#pragma unroll
                  for (int sp = 0; sp < 2; ++sp) { LAS const unsigned char* kp = wl + ML_WK + trN + 16 * sp * 144 + 64 * kb; LAS const unsigned char* vp = wl + ML_V + trN + 16 * sp * 144 + 64 * vb;
                      X[kb][vb] = MFMA32(cat8(tr_read(kp), tr_read(kp + 4 * 144)), cat8(tr_read(vp), tr_read(vp + 4 * 144)), X[kb][vb]); } }
          float dn = 0.f;
#pragma unroll 8
          for (int s2 = 0; s2 < 32; ++s2) dn += bf2f(*(LAS const unsigned short*)(wl + ML_WK + s2 * 144 + 2 * lane));
          nk = eg * nk + dn; nl[lane] = nk; }
    }
    if (!OUT) {
        float* sp = scratch + (size_t)(bh * 16 + c) * ML_ITEM_F;
#pragma unroll
        for (int blk = 0; blk < 4; ++blk) {
#pragma unroll
            for (int i = 0; i < 8; ++i) st_wt64(sp + blk * 1024 + lane * 16 + 2 * i, X[blk >> 1][blk & 1][2 * i], X[blk >> 1][blk & 1][2 * i + 1]); }
        st_wt32(sp + 4096 + lane, nk);
        if (lane == 0) st_wt32(sp + 4160, Gsum);
    }
}

struct Args { const float* in[20]; float* out; unsigned char* ws; };
#define GEMM_PHASE(EpiT, SchedT, g, Sc, E) pg8::gemm_phase<EpiT, SchedT, true, true>(L, g, Sc, E)

__global__ void __launch_bounds__(512, 2) mega_fwd(Args a) {
    extern __shared__ __attribute__((aligned(16))) unsigned char lds[];
    LAS unsigned char* L = (LAS unsigned char*)lds;
    const int tid = threadIdx.x, lane = tid & 63, wave = __builtin_amdgcn_readfirstlane(tid >> 6);
    const int G = gridDim.x, bx = blockIdx.x;
    const int gw = bx * 8 + wave, NGW = G * 8;
    unsigned char* ws = a.ws;
    const float* x = a.in[0]; const float* mem = a.in[1];
    float* out = a.out;
    float* ssq = (float*)(ws + WS_SSQP); float* ssqm = (float*)(ws + WS_SSQP + 7 * MiB);
    bf16* ub = (bf16*)(ws + WS_U); bf16* actb = (bf16*)(ws + WS_U); bf16* yb = (bf16*)(ws + WS_Y); bf16* qxb = (bf16*)(ws + WS_QX); bf16* oxb = (bf16*)(ws + WS_OX);
    bf16* hb = (bf16*)(ws + WS_HB); bf16* memb = (bf16*)(ws + WS_MEMB); bf16* kvb = (bf16*)(ws + WS_KV);

    volatile LAS unsigned* bst = (volatile LAS unsigned*)(L + LDS_BARST); if (tid < 2) bst[tid] = 0u;
    __syncthreads();
    (void)xcd_barrier_post((unsigned*)(a.ws + WS_BAR), bst);
    {
        LAS float* tile = (LAS float*)L;
        constexpr int I_IN = 16 * 14, I_OUT = 16 * 4, I_XQ = 16 * 2, I_XKV = 16 * 4, I_XO = 8 * 4, I_GU = 16 * 22, I_DN = 44 * 4;
        constexpr int I_LAYER = I_IN + I_OUT + I_XQ + I_XKV + I_XO + I_GU + I_DN;
        for (int it = bx; it < 2 * I_LAYER; it += G) {
            const int l = it / I_LAYER; int r = it % I_LAYER;
            unsigned char* wl = ws + WS_W + (size_t)l * W_LAYER;
            if (r < I_IN) { conv_block_item(a.in[3] + (size_t)l * 1024 * 3474, nullptr, 3474, 1024, 1, a.in[2] + l * 1024, (bf16*)(wl + OW_IN), tile, r / 14, r % 14, tid); continue; } r -= I_IN;
            if (r < I_OUT) { conv_block_item(a.in[9] + (size_t)l * 1024 * 1024, nullptr, 1024, 1024, 0, nullptr, (bf16*)(wl + OW_OUT), tile, r / 4, r % 4, tid); continue; } r -= I_OUT;
            if (r < I_XQ) { conv_block_item(a.in[12] + (size_t)l * 1024 * 512, nullptr, 512, 1024, 0, a.in[10] + l * 1024, (bf16*)(wl + OW_XQ), tile, r / 2, r % 2, tid); continue; } r -= I_XQ;
            if (r < I_XKV) { conv_block_item(a.in[13] + (size_t)l * 1024 * 1024, nullptr, 1024, 1024, 0, a.in[11] + l * 1024, (bf16*)(wl + OW_XKV), tile, r / 4, r % 4, tid); continue; } r -= I_XKV;
            if (r < I_XO) { conv_block_item(a.in[14] + (size_t)l * 512 * 1024, nullptr, 1024, 512, 0, nullptr, (bf16*)(wl + OW_XO), tile, r / 4, r % 4, tid); continue; } r -= I_XO;
            if (r < I_GU) { conv_block_item(a.in[16] + (size_t)l * 1024 * DFF, a.in[17] + (size_t)l * 1024 * DFF, DFF, 1024, 2, a.in[15] + l * 1024, (bf16*)(wl + OW_GU), tile, r / 22, r % 22, tid); continue; } r -= I_GU;
            conv_block_item(a.in[18] + (size_t)l * DFF * 1024, nullptr, 1024, DFF, 0, nullptr, (bf16*)(wl + OW_DN), tile, r / 4, r % 4, tid);
        }
        for (int m = gw; m < M; m += NGW) row_to_bf16_ssq(x + (size_t)m * D, hb + (size_t)m * D, ssq + (size_t)m * 16, lane);
        for (int m = gw; m < MROWS; m += NGW) row_to_bf16_ssq(mem + (size_t)m * D, memb + (size_t)m * D, ssqm + (size_t)m * 16, lane);
        { float* prm = (float*)(ws + WS_PRM);
          for (int i = bx * 512 + tid; i < 2 * 8192 + 1024; i += G * 512) {
              float v = 0.f;
              if (i >= 2 * 8192) v = a.in[19][i - 2 * 8192];
              else { const int l = i >> 13, o = i & 8191;
                  if (o < 6) v = a.in[4][l * 6 + o]; else if (o >= 8 && o < 14) v = a.in[6][l * 6 + o - 8]; else if (o >= 16 && o < 22) v = a.in[7][l * 6 + o - 16];
                  else if (o >= 64 && o < 448) v = a.in[8][l * 384 + o - 64]; else if (o >= 512 && o < 3584) v = a.in[5][l * 3072 + o - 512]; }
              prm[i] = v; } }
    }
#define XBAR() do { XcdBarrier xb_; xb_.bar = (unsigned*)(ws + WS_BAR); xb_.x = xb_xcc_id(); xb_.st = (volatile LAS unsigned*)(L + LDS_BARST); xcd_barrier(xb_); } while (0)
    { unsigned char* ws = a.ws; XBAR(); }
    for (int ph = 0; ph < 16; ++ph) {
        const int l = ph >> 3, k = ph & 7;
        size_t zoff = 0; asm volatile("" : "+s"(zoff)); unsigned char* ws = a.ws + zoff;
        const unsigned char* wl = ws + WS_W + (size_t)l * W_LAYER;
        float* ssq = (float*)(ws + WS_SSQP); float* ssqm = (float*)(ws + WS_SSQP + 7 * MiB);
        bf16* ub = (bf16*)(ws + WS_U); bf16* actb = (bf16*)(ws + WS_U); bf16* yb = (bf16*)(ws + WS_Y); bf16* qxb = (bf16*)(ws + WS_QX); bf16* oxb = (bf16*)(ws + WS_OX);
        bf16* hb = (bf16*)(ws + WS_HB); bf16* memb = (bf16*)(ws + WS_MEMB); bf16* kvb = (bf16*)(ws + WS_KV);
        int tid_p = threadIdx.x; asm volatile("" : "+v"(tid_p)); const int lane = tid_p & 63, wave = __builtin_amdgcn_readfirstlane(tid_p >> 6), gw = bx * 8 + wave;
        if (k == 0 || k == 3) {
            const int j0 = (ph == 0) ? 0 : 2;
            for (int j = j0; j < 3; ++j) {
                pg8::Gemm g; pg8::EpiScaleBf16 E; int off = 0;
                if (j < 2) { g = pg8::Gemm{memb, (const bf16*)(ws + WS_W + (size_t)j * W_LAYER + OW_XKV), MROWS, 1024, 1024}; E = pg8::EpiScaleBf16{kvb + (size_t)j * MROWS * 1024, 1024, ssqm}; off = 128 + 32 * j; }
                else if (k == 0) { g = pg8::Gemm{hb, (const bf16*)(wl + OW_IN), M, NU, 1024}; E = pg8::EpiScaleBf16{ub, NU, ssq + (size_t)(3 * l) * M * 16}; }
                else { g = pg8::Gemm{hb, (const bf16*)(wl + OW_XQ), M, DX, 1024}; E = pg8::EpiScaleBf16{qxb, DX, ssq + (size_t)(3 * l + 1) * M * 16}; }
                pg8::OffsetOrder Sc; Sc.init(g.M, g.N, G, bx, off);
                GEMM_PHASE(pg8::EpiScaleBf16, pg8::OffsetOrder, g, Sc, E);
            }
        } else if (k == 2 || k == 5 || k == 7) {
            pg8::Gemm g; pg8::EpiResid E;
            if (k == 2) { g = pg8::Gemm{yb, (const bf16*)(wl + OW_OUT), M, 1024, 1024}; E = pg8::EpiResid{hb, ssq + (size_t)(3 * l + 1) * M * 16}; }
            else if (k == 5) { g = pg8::Gemm{oxb, (const bf16*)(wl + OW_XO), M, 1024, DX}; E = pg8::EpiResid{hb, ssq + (size_t)(3 * l + 2) * M * 16}; }
            else { g = pg8::Gemm{actb, (const bf16*)(wl + OW_DN), M, 1024, DFF}; E = pg8::EpiResid{hb, ssq + (size_t)(3 * l + 3) * M * 16}; }
            pg8::StaticOrder Sc; Sc.init(g.M, g.N, G, bx);
            GEMM_PHASE(pg8::EpiResid, pg8::StaticOrder, g, Sc, E);
        } else if (k == 6) {
            pg8::Gemm g{hb, (const bf16*)(wl + OW_GU), M, 2 * DFF, 1024}; pg8::StaticOrder Sc; Sc.init(M, 2 * DFF, G, bx);
            pg8::EpiSwiglu E{actb, DFF, ssq + (size_t)(3 * l + 2) * M * 16};
            GEMM_PHASE(pg8::EpiSwiglu, pg8::StaticOrder, g, Sc, E);
        } else if (k == 1) {
            const float* prm = (const float*)(ws + WS_PRM) + l * 8192;
            float* mscr = out;
            float* fcl = out + 14 * MiB / 4; float* ftot = out + 15 * MiB / 4;
            const int xcd0 = (int)(xb_xcc_id() & 7u); unsigned okmask = 0u;
            for (int qi = 0; qi < 3; ++qi) {
            const int xcd = (qi == 0) ? xcd0 : (qi == 1 ? (bx & 7) : ((xcd0 + 1) & 7));
            if (qi == 1 && xcd == xcd0) continue;
            unsigned* done = (unsigned*)(ws + WS_BAR + 15360) + 16 * (l * 8 + xcd);
            for (int sj = 0; sj < (qi == 2 ? 1 : 2); ++sj) {
            const int sq = (wave + sj) & 7;
            unsigned* ctr = (unsigned*)(ws + WS_BAR + 16384) + 16 * ((l * 8 + xcd) * 8 + sq);
            for (;;) {
                int it = 0; if (lane == 0) it = (int)atomicAdd(ctr, 1u); it = __builtin_amdgcn_readfirstlane(it) * 8 + sq;
                if (it >= 874) break;
                if (it < 138) {
                    if (it >= 48) mlstm_item<false>(ub, yb, mscr, prm + 512, prm + 8, prm + 16, prm + 64, L + wave * ML_WSTRIDE, xcd + 8 * ((it - 48) / 15), (it - 48) % 15, lane);
                    else fox_cumsum_item(ub, prm, fcl, ftot, (xcd + 8 * (it >> 3)) * 8 + (it & 7), lane);
                    asm volatile("s_waitcnt vmcnt(0)" ::: "memory");
                    if (lane == 0) atomicAdd(done + (it >= 48 ? 8 : 0), 1u);
                } else {
                    const bool isc = (it >= 266 && it < 362), issb = (it >= 362 && it < 618), isfox = !isc && !issb;
                    if (isfox && !((okmask >> xcd) & 1u)) { unsigned sp = 0u;
                        while (__hip_atomic_load(done, __ATOMIC_RELAXED, __HIP_MEMORY_SCOPE_AGENT) < 48u) { __builtin_amdgcn_s_sleep(120); if (++sp > (1u << 17)) break; }
                        __builtin_amdgcn_fence(__ATOMIC_ACQUIRE, "agent"); okmask |= 1u << xcd; }
                    if (isc && !((okmask >> (8 + xcd)) & 1u)) { unsigned sp = 0u;
                        while (__hip_atomic_load(done + 8, __ATOMIC_RELAXED, __HIP_MEMORY_SCOPE_AGENT) < 90u) { __builtin_amdgcn_s_sleep(120); if (++sp > (1u << 17)) break; }
                        __builtin_amdgcn_fence(__ATOMIC_ACQUIRE, "agent"); okmask |= 1u << (8 + xcd); }
                    if (isc) { const int ci = it - 266; mlstm_item<true>(ub, yb, mscr, prm + 512, prm + 8, prm + 16, prm + 64, L + wave * ML_WSTRIDE, xcd + 8 * (ci >> 4), 15 - (ci & 15), lane); }
                    else { int aitem; if (issb) { const int ai = it - 362; aitem = (ai >> 2) * 80 + 48 + xcd + 8 * (ai & 3); } else { const int ai = (it < 266) ? it - 138 : it - 490; aitem = (ai / 6) * 80 + xcd + 8 * (ai % 6); }
                        attn_mfma_item(ub, yb, fcl, ftot, L + wave * ML_WSTRIDE, aitem, lane); }
                }
            }
            }
            }
        } else {
            for (int it = gw; it < 2048; it += NGW) xattn_mfma_item(qxb, kvb + (size_t)l * MROWS * 1024, oxb, L + wave * 16384, it, lane);
        }
        XBAR();
    }
    {
        int tid_f = threadIdx.x; asm volatile("" : "+v"(tid_f)); const int lane = tid_f & 63, gw = bx * 8 + __builtin_amdgcn_readfirstlane(tid_f >> 6);
        const float* fw = (const float*)(a.ws + WS_PRM) + 2 * 8192; const float* sq = (const float*)(a.ws + WS_SSQP) + (size_t)6 * M * 16;
        const bf16* hbf = (const bf16*)(a.ws + WS_HB);
        for (int m = gw; m < M; m += NGW) {
            float sm = 0.f; { const f32x4* qp = (const f32x4*)(sq + (size_t)m * 16); const f32x4 q0 = qp[0], q1 = qp[1], q2 = qp[2], q3 = qp[3];
              sm = ((((q0[0] + q0[1]) + (q0[2] + q0[3])) + ((q1[0] + q1[1]) + (q1[2] + q1[3]))) + (((q2[0] + q2[1]) + (q2[2] + q2[3])) + ((q3[0] + q3[1]) + (q3[2] + q3[3])))); }
            const float rs = rsqrtf(sm * (1.0f / 1024.0f) + 1e-6f);
            const unsigned long long* hp = (const unsigned long long*)(hbf + (size_t)m * D) + lane; f32x4* rp = (f32x4*)(out + (size_t)m * D) + lane; const f32x4* wp = (const f32x4*)fw + lane;
#pragma unroll
            for (int j = 0; j < 4; ++j) { const unsigned long long hw = hp[64 * j]; const unsigned h0 = (unsigned)hw, h1 = (unsigned)(hw >> 32); const f32x4 w = wp[64 * j];
                f32x4 v = {lo_f(h0), hi_f(h0), lo_f(h1), hi_f(h1)}; v = v * rs * w; rp[64 * j] = v; }
        }
    }
}

extern "C" void kernel_launch(void* const* d_in, const int* in_sizes, int n_in, void* d_out, int out_size, void* d_ws, size_t ws_size, hipStream_t stream) {
    static int grid = 0;
    if (grid == 0) {
        if (n_in != 20 || out_size != M * D || ws_size < WS_END) { fprintf(stderr, "kernel_launch: unexpected shapes (n_in %d out %d ws %zu)\n", n_in, out_size, ws_size); grid = -1; return; }
        int dev = 0, cus = 0, per_cu = 0;
        hipGetDevice(&dev); hipDeviceGetAttribute(&cus, hipDeviceAttributeMultiprocessorCount, dev);
        if (hipFuncSetAttribute((const void*)mega_fwd, hipFuncAttributeMaxDynamicSharedMemorySize, LDS_BYTES) != hipSuccess) { fprintf(stderr, "kernel_launch: hipFuncSetAttribute failed\n"); grid = -1; return; }
        if (hipOccupancyMaxActiveBlocksPerMultiprocessor(&per_cu, (const void*)mega_fwd, 512, LDS_BYTES) != hipSuccess || per_cu < 1) { fprintf(stderr, "kernel_launch: occupancy query says %d\n", per_cu); (void)hipGetLastError(); per_cu = 1; }
        grid = cus * per_cu;
    }
    if (grid < 0) return;
    Args a{};
    for (int i = 0; i < 20; ++i) a.in[i] = (const float*)d_in[i];
    a.out = (float*)d_out; a.ws = (unsigned char*)d_ws;
    if (hipMemsetAsync((char*)d_ws + WS_BAR, 0, BAR_BYTES, stream) != hipSuccess) { fprintf(stderr, "kernel_launch: memset of the barrier words failed\n"); return; }
    void* args[] = {&a};
    hipError_t e = hipLaunchCooperativeKernel((const void*)mega_fwd, dim3(grid), dim3(512), args, LDS_BYTES, stream);
    if (e != hipSuccess) fprintf(stderr, "kernel_launch: cooperative launch failed: %s (grid %d)\n", hipGetErrorString(e), grid);
}
```

```cpp
#include <hip/hip_runtime.h>
#include <hip/hip_cooperative_groups.h>
#include <cstdio>
#include <cstdint>
#include <cmath>
namespace cg = cooperative_groups;
namespace pg8 {
#define PG8_LAS __attribute__((address_space(3)))
typedef unsigned short bf16_t;
typedef short bf16x8 __attribute__((ext_vector_type(8)));
typedef float f32x4 __attribute__((ext_vector_type(4)));
typedef unsigned u32x4 __attribute__((ext_vector_type(4)));
constexpr int BM = 256, BK = 64, HALF = 128, HTB = HALF * BK * 2  , STAGE_BYTES = 8 * HTB, NXCD = 8, WGM = 4;

__host__ __device__ __forceinline__ int lds_byte(int r, int c) { const int st = (r >> 4) * 2 + (c >> 5), rr = r & 15, cc = c & 31, ob = rr * 64 + cc * 2; return st * 1024 + (ob ^ (((ob >> 9) & 1) << 5)); }
__host__ __device__ __forceinline__ void stage_rc(int b, int& R, int& C) { const int st = b / 1024, sb = b % 1024, swz = sb ^ (((sb >> 9) & 1) << 5); R = (st >> 1) * 16 + swz / 64; C = (st & 1) * 32 + (swz % 64) / 2; }
__host__ __device__ __forceinline__ int perm32(int rho) { const int n = rho >> 4, i = rho & 15; return 8 * (i >> 2) + 4 * n + (i & 3); }

struct Unit { int pm, pn; };
struct Gemm { const bf16_t* A; const bf16_t* Bt; int M, N, K; };

struct StaticOrder {
    int nM, nN, nwg, G, c;
    __host__ __device__ void init(int M, int N, int G_, int c_) { nM = M / BM; nN = N / BM; nwg = nM * nN; G = G_; c = c_; }
    __host__ __device__ bool next(int i, Unit& u) const {
        const long L = (long)i * G + c; if (L >= nwg) return false;
        int wgid = (int)L; { const int q = nwg / NXCD, r = nwg % NXCD, xcd = wgid % NXCD, off = wgid / NXCD; wgid = (xcd < r ? xcd * (q + 1) : r * (q + 1) + (xcd - r) * q) + off; }
        const int nig = WGM * nN, gid = wgid / nig, fm = gid * WGM, gsz = (nM - fm) < WGM ? (nM - fm) : WGM;
        u.pm = fm + ((wgid % nig) % gsz); u.pn = (wgid % nig) / gsz; return true;
    }
    __device__ __forceinline__ void a_ready(const Unit&) const {}
    __device__ __forceinline__ void done(const Unit&) const {}
};

__device__ __forceinline__ unsigned cvt_pk_bf16(float lo, float hi) { unsigned r; asm volatile("v_cvt_pk_bf16_f32 %0, %1, %2" : "=v"(r) : "v"(lo), "v"(hi)); return r; }
typedef float f32x2 __attribute__((ext_vector_type(2)));
struct OffsetOrder {
    StaticOrder b;
    __device__ void init(int M, int N, int G, int c, int off) { b.init(M, N, G, (c + G - (off % G)) % G); }
    __device__ bool next(int i, Unit& u) const { return b.next(i, u); }
    __device__ __forceinline__ void a_ready(const Unit&) const {}
    __device__ __forceinline__ void done(const Unit&) const {}
};
struct EpiScaleBf16 {
    static constexpr bool PERM = true, AFTER_DRAIN = false;
    bf16_t* O; int ldc; const float* ssq;
    __device__ __forceinline__ void operator()(const f32x4 (&acc)[2][2][4][2], const Unit& u, int wr, int wc, int fr, int fq) const {
        const int row0 = u.pm * BM + wr * 64 + fr, col0 = u.pn * BM + wc * 32 + 8 * fq;
#pragma unroll
        for (int ai = 0; ai < 2; ++ai)
#pragma unroll
            for (int m = 0; m < 4; ++m) { const int row = row0 + ai * HALF + m * 16; const f32x4 q0 = *(const f32x4*)(ssq + (size_t)row * 16), q1 = *(const f32x4*)(ssq + (size_t)row * 16 + 4), q2 = *(const f32x4*)(ssq + (size_t)row * 16 + 8), q3 = *(const f32x4*)(ssq + (size_t)row * 16 + 12);
                const float rs = rsqrtf(((((q0[0] + q0[1]) + (q0[2] + q0[3])) + ((q1[0] + q1[1]) + (q1[2] + q1[3]))) + (((q2[0] + q2[1]) + (q2[2] + q2[3])) + ((q3[0] + q3[1]) + (q3[2] + q3[3])))) * (1.0f / 1024.0f) + 1e-6f);
                bf16_t* rowp = O + (size_t)row * ldc + col0;
#pragma unroll
                for (int bj = 0; bj < 2; ++bj) { const f32x4 v0 = acc[ai][bj][m][0] * rs, v1 = acc[ai][bj][m][1] * rs;
                    u32x4 w; w.x = cvt_pk_bf16(v0[0], v0[1]); w.y = cvt_pk_bf16(v0[2], v0[3]); w.z = cvt_pk_bf16(v1[0], v1[1]); w.w = cvt_pk_bf16(v1[2], v1[3]);
                    *(u32x4*)(rowp + bj * HALF) = w; } }
    }
};
struct EpiResid {
    static constexpr bool PERM = true, AFTER_DRAIN = false;
    bf16_t* hb; float* ssq;
    __device__ __forceinline__ void operator()(const f32x4 (&acc)[2][2][4][2], const Unit& u, int wr, int wc, int fr, int fq) const {
        const int row0 = u.pm * BM + wr * 64 + fr, col0 = u.pn * BM + wc * 32 + 8 * fq;
#pragma unroll
        for (int ai = 0; ai < 2; ++ai)
#pragma unroll
            for (int m = 0; m < 4; ++m) { const int row = row0 + ai * HALF + m * 16; const size_t off = (size_t)row * 1024 + col0; float part = 0.f;
#pragma unroll
                for (int bj = 0; bj < 2; ++bj) { const u32x4 b = *(const u32x4*)(hb + off + bj * HALF);
                    f32x4 v0 = acc[ai][bj][m][0], v1 = acc[ai][bj][m][1];
                    v0[0] += __uint_as_float(b.x << 16); v0[1] += __uint_as_float(b.x & 0xffff0000u); v0[2] += __uint_as_float(b.y << 16); v0[3] += __uint_as_float(b.y & 0xffff0000u);
                    v1[0] += __uint_as_float(b.z << 16); v1[1] += __uint_as_float(b.z & 0xffff0000u); v1[2] += __uint_as_float(b.w << 16); v1[3] += __uint_as_float(b.w & 0xffff0000u);
                    u32x4 w; w.x = cvt_pk_bf16(v0[0], v0[1]); w.y = cvt_pk_bf16(v0[2], v0[3]); w.z = cvt_pk_bf16(v1[0], v1[1]); w.w = cvt_pk_bf16(v1[2], v1[3]);
                    *(u32x4*)(hb + off + bj * HALF) = w;
                    part += (v0[0] * v0[0] + v0[1] * v0[1]) + (v0[2] * v0[2] + v0[3] * v0[3]) + (v1[0] * v1[0] + v1[1] * v1[1]) + (v1[2] * v1[2] + v1[3] * v1[3]); }
                part += __shfl_xor(part, 16); part += __shfl_xor(part, 32);
                if (fq == 0) ssq[(size_t)row * 16 + u.pn * 4 + wc] = part; }
    }
};
struct EpiSwiglu {
    static constexpr bool PERM = true, AFTER_DRAIN = false;
    bf16_t* O; int ldc; const float* ssq;
    __device__ __forceinline__ void operator()(const f32x4 (&acc)[2][2][4][2], const Unit& u, int wr, int wc, int fr, int fq) const {
        const int row0 = u.pm * BM + wr * 64 + fr, col0 = u.pn * HALF + wc * 32 + 8 * fq;
#pragma unroll
        for (int ai = 0; ai < 2; ++ai)
#pragma unroll
            for (int m = 0; m < 4; ++m) { const int row = row0 + ai * HALF + m * 16; const f32x4 q0 = *(const f32x4*)(ssq + (size_t)row * 16), q1 = *(const f32x4*)(ssq + (size_t)row * 16 + 4), q2 = *(const f32x4*)(ssq + (size_t)row * 16 + 8), q3 = *(const f32x4*)(ssq + (size_t)row * 16 + 12);
                const float rs = rsqrtf(((((q0[0] + q0[1]) + (q0[2] + q0[3])) + ((q1[0] + q1[1]) + (q1[2] + q1[3]))) + (((q2[0] + q2[1]) + (q2[2] + q2[3])) + ((q3[0] + q3[1]) + (q3[2] + q3[3])))) * (1.0f / 1024.0f) + 1e-6f);
                float a[8];
#pragma unroll
                for (int n = 0; n < 2; ++n)
#pragma unroll
                    for (int j = 0; j < 4; ++j) { const float g = acc[ai][0][m][n][j] * rs, up = acc[ai][1][m][n][j] * rs; a[4 * n + j] = g * up * __builtin_amdgcn_rcpf(1.0f + __expf(-g)); }
                u32x4 w; w.x = cvt_pk_bf16(a[0], a[1]); w.y = cvt_pk_bf16(a[2], a[3]); w.z = cvt_pk_bf16(a[4], a[5]); w.w = cvt_pk_bf16(a[6], a[7]);
                *(u32x4*)(O + (size_t)row * ldc + col0) = w; }
    }
};
template <class Epi, class Sched, bool ALIGN_EPI = false, bool SP2 = false>
__device__ __forceinline__ void gemm_phase(PG8_LAS unsigned char* lds, const Gemm g, const Sched& S, const Epi& E) {
    int tid_l = threadIdx.x; asm volatile("" : "+v"(tid_l));
    const int tid = tid_l, wid = __builtin_amdgcn_readfirstlane(tid >> 6), lane = tid & 63, wr = wid >> 2, wc = wid & 3, fr = lane & 15, fq = lane >> 4;
    const int K = g.K, nt = K / BK;
    unsigned voffA[2], voffB[2];
#pragma unroll
    for (int i = 0; i < 2; ++i) { int R, C; stage_rc(tid * 16 + i * 8192, R, C); const int Rb = Epi::PERM ? ((R & ~31) + perm32(R & 31)) : R;
        voffA[i] = (unsigned)(R * K + C) * 2u; voffB[i] = (unsigned)(Rb * K + C) * 2u; }
    const size_t kstep = (size_t)(BK * 2);
    const size_t hstep = (size_t)HALF * K * 2;
    const size_t tstep = 2 * hstep;
    const unsigned ldsw = (unsigned)wid * 1024u;
    const int aoff = lds_byte(wr * 64 + fr, fq * 8), boff = lds_byte(wc * 32 + fr, fq * 8);
#define PG8_SA(b, h) (((b) * 2 + (h)) * HTB)
#define PG8_SB(b, h) ((4 + (b) * 2 + (h)) * HTB)
#define PG8_STAGE(bufoff, gbase, voff) do { _Pragma("unroll") for (int _i = 0; _i < 2; ++_i) \
        __builtin_amdgcn_global_load_lds((const unsigned*)((const char*)(gbase) + (voff)[_i]), (PG8_LAS unsigned*)(lds + (bufoff) + ldsw + _i * 8192), 16, 0, 0); } while (0)
#define PG8_LDA(dst, b, h) do { _Pragma("unroll") for (int m = 0; m < 4; ++m) _Pragma("unroll") for (int k = 0; k < 2; ++k) dst[m][k] = *(const PG8_LAS bf16x8*)(lds + PG8_SA(b, h) + aoff + m * 2048 + k * 1024); } while (0)
#define PG8_LDB(dst, b, h) do { _Pragma("unroll") for (int n = 0; n < 2; ++n) _Pragma("unroll") for (int k = 0; k < 2; ++k) dst[n][k] = *(const PG8_LAS bf16x8*)(lds + PG8_SB(b, h) + boff + n * 2048 + k * 1024); } while (0)
#define PG8_MMA(ai, bj, At, Bt) do { __builtin_amdgcn_s_setprio(1); _Pragma("unroll") for (int m = 0; m < 4; ++m) _Pragma("unroll") for (int n = 0; n < 2; ++n) _Pragma("unroll") for (int k = 0; k < 2; ++k) \
        acc[ai][bj][m][n] = __builtin_amdgcn_mfma_f32_16x16x32_bf16(Bt[n][k], At[m][k], acc[ai][bj][m][n], 0, 0, 0); __builtin_amdgcn_s_setprio(0); } while (0)
#define PG8_WAIT_V(n) asm volatile("s_waitcnt vmcnt(" #n ")" ::: "memory")
#define PG8_WAIT_L(n) asm volatile("s_waitcnt lgkmcnt(" #n ")" ::: "memory")
#define PG8_BAR __builtin_amdgcn_s_barrier()
#define PG8_SCHED __builtin_amdgcn_sched_barrier(0)
    Unit cur, nxt; int ui = 0;
    if (!S.next(0, cur)) return;
    f32x4 acc[2][2][4][2];
#pragma unroll
    for (int a = 0; a < 2; ++a)
#pragma unroll
        for (int b = 0; b < 2; ++b)
#pragma unroll
            for (int m = 0; m < 4; ++m)
#pragma unroll
                for (int n = 0; n < 2; ++n) acc[a][b][m][n] = (f32x4){0.f, 0.f, 0.f, 0.f};
    bf16x8 At[4][2], B0[2][2], B1[2][2];
    const char* cA = (const char*)g.A + (size_t)cur.pm * tstep; const char* cB = (const char*)g.Bt + (size_t)cur.pn * tstep;
    S.a_ready(cur);
    if constexpr (SP2) {
        PG8_STAGE(PG8_SB(0, 0), cB, voffB); PG8_STAGE(PG8_SB(0, 1), cB + hstep, voffB); PG8_STAGE(PG8_SA(0, 0), cA, voffA); PG8_STAGE(PG8_SA(0, 1), cA + hstep, voffA);
        if (wr == 1) PG8_BAR;
        PG8_WAIT_V(2); PG8_BAR;
        PG8_STAGE(PG8_SB(1, 0), cB + kstep, voffB); PG8_STAGE(PG8_SA(1, 0), cA + kstep, voffA); PG8_STAGE(PG8_SB(1, 1), cB + hstep + kstep, voffB);
        PG8_WAIT_V(6); PG8_BAR;
    } else {
        PG8_STAGE(PG8_SB(0, 0), cB, voffB); PG8_STAGE(PG8_SA(0, 0), cA, voffA); PG8_STAGE(PG8_SB(0, 1), cB + hstep, voffB); PG8_STAGE(PG8_SA(0, 1), cA + hstep, voffA);
        if (wr == 1) PG8_BAR;
        PG8_WAIT_V(4); PG8_BAR;
        PG8_STAGE(PG8_SB(1, 0), cB + kstep, voffB); PG8_STAGE(PG8_SA(1, 0), cA + kstep, voffA); PG8_STAGE(PG8_SB(1, 1), cB + hstep + kstep, voffB);
        PG8_WAIT_V(6); PG8_BAR;
    }
    for (;;) {
        const bool has_next = S.next(ui + 1, nxt);
        const char* nA = has_next ? (const char*)g.A + (size_t)nxt.pm * tstep : cA; const char* nB = has_next ? (const char*)g.Bt + (size_t)nxt.pn * tstep : cB;
        for (int t = 0; t < nt; t += 2) {
            const bool last = (t == nt - 2);
            const char* a1 = cA + (size_t)(t + 1) * kstep;
            const char* a2 = last ? nA : cA + (size_t)(t + 2) * kstep; const char* b2 = last ? nB : cB + (size_t)(t + 2) * kstep;
            const char* a3 = a2 + kstep; const char* b3 = b2 + kstep;
            if (last && has_next) S.a_ready(nxt);
            if constexpr (SP2) {
            PG8_LDB(B0, 0, 0); PG8_LDB(B1, 0, 1); PG8_SCHED; PG8_LDA(At, 0, 0); PG8_STAGE(PG8_SA(1, 1), a1 + hstep, voffA);
            PG8_WAIT_V(8); PG8_WAIT_L(0); PG8_BAR; PG8_MMA(0, 0, At, B0); PG8_MMA(0, 1, At, B1); PG8_BAR; PG8_SCHED;
            PG8_LDA(At, 0, 1); PG8_STAGE(PG8_SB(0, 0), b2, voffB); PG8_STAGE(PG8_SB(0, 1), b2 + hstep, voffB); PG8_STAGE(PG8_SA(0, 0), a2, voffA);
            PG8_WAIT_V(8); PG8_WAIT_L(0); PG8_BAR; PG8_MMA(1, 0, At, B0); PG8_MMA(1, 1, At, B1); PG8_BAR; PG8_SCHED;
            PG8_LDB(B0, 1, 0); PG8_LDB(B1, 1, 1); PG8_SCHED; PG8_LDA(At, 1, 0); PG8_STAGE(PG8_SA(0, 1), a2 + hstep, voffA);
            PG8_WAIT_V(8); PG8_WAIT_L(0); PG8_BAR; PG8_MMA(0, 0, At, B0); PG8_MMA(0, 1, At, B1); PG8_BAR; PG8_SCHED;
            PG8_LDA(At, 1, 1); PG8_STAGE(PG8_SB(1, 0), b3, voffB); PG8_STAGE(PG8_SB(1, 1), b3 + hstep, voffB); PG8_STAGE(PG8_SA(1, 0), a3, voffA);
            PG8_WAIT_V(8); PG8_WAIT_L(0); PG8_BAR; PG8_MMA(1, 0, At, B0); PG8_MMA(1, 1, At, B1); PG8_BAR; PG8_SCHED;
            } else {
            PG8_LDB(B0, 0, 0); PG8_SCHED; PG8_LDA(At, 0, 0); PG8_STAGE(PG8_SA(1, 1), a1 + hstep, voffA);
            PG8_WAIT_L(8); PG8_BAR; PG8_WAIT_L(0); PG8_MMA(0, 0, At, B0); PG8_BAR; PG8_SCHED;
            PG8_LDB(B1, 0, 1); PG8_STAGE(PG8_SB(0, 0), b2, voffB);
            PG8_BAR; PG8_WAIT_L(0); PG8_MMA(0, 1, At, B1); PG8_BAR;
            PG8_LDA(At, 0, 1); PG8_STAGE(PG8_SA(0, 0), a2, voffA);
            PG8_BAR; PG8_WAIT_L(0); PG8_MMA(1, 0, At, B0); PG8_BAR; PG8_SCHED;
            PG8_STAGE(PG8_SB(0, 1), b2 + hstep, voffB);
            PG8_WAIT_V(6); PG8_BAR; PG8_MMA(1, 1, At, B1); PG8_BAR;
            PG8_LDB(B0, 1, 0); PG8_SCHED; PG8_LDA(At, 1, 0); PG8_STAGE(PG8_SA(0, 1), a2 + hstep, voffA);
            PG8_WAIT_L(8); PG8_BAR; PG8_WAIT_L(0); PG8_MMA(0, 0, At, B0); PG8_BAR; PG8_SCHED;
            PG8_LDB(B1, 1, 1); PG8_STAGE(PG8_SB(1, 0), b3, voffB);
            PG8_BAR; PG8_WAIT_L(0); PG8_MMA(0, 1, At, B1); PG8_BAR;
            PG8_LDA(At, 1, 1); PG8_STAGE(PG8_SA(1, 0), a3, voffA);
            PG8_BAR; PG8_WAIT_L(0); PG8_MMA(1, 0, At, B0); PG8_BAR; PG8_SCHED;
            PG8_STAGE(PG8_SB(1, 1), b3 + hstep, voffB);
            PG8_WAIT_V(6); PG8_BAR; PG8_MMA(1, 1, At, B1); PG8_BAR;
            }
        }
        if constexpr (ALIGN_EPI) { if (wr == 0) PG8_BAR; }
        if constexpr (!Epi::AFTER_DRAIN) { E(acc, cur, wr, wc, fr, fq); S.done(cur); }
        if (!has_next) break;
#pragma unroll
        for (int a = 0; a < 2; ++a)
#pragma unroll
            for (int b = 0; b < 2; ++b)
#pragma unroll
                for (int m = 0; m < 4; ++m)
#pragma unroll
                    for (int n = 0; n < 2; ++n) acc[a][b][m][n] = (f32x4){0.f, 0.f, 0.f, 0.f};
        cur = nxt; cA = nA; cB = nB; ++ui;
        if constexpr (ALIGN_EPI) { if (wr == 1) PG8_BAR; }
    }
    PG8_WAIT_V(0);
    if constexpr (!ALIGN_EPI) { if (wr == 0) PG8_BAR; }
    PG8_BAR;
    if constexpr (Epi::AFTER_DRAIN) { E.fused(acc, cur, wr, wc, fr, fq, lds, wid, lane); S.done(cur); }
#undef PG8_SA
#undef PG8_SB
#undef PG8_STAGE
#undef PG8_LDA
#undef PG8_LDB
#undef PG8_MMA
#undef PG8_WAIT_V
#undef PG8_WAIT_L
#undef PG8_BAR
#undef PG8_SCHED
}
}
#define LAS __attribute__((address_space(3)))
typedef unsigned short bf16;
typedef unsigned v4u __attribute__((ext_vector_type(4)));
typedef float f32x4 __attribute__((ext_vector_type(4)));

constexpr int NB = 8, S = 2048, D = 1024, M = NB * S, NU = 3584, DFF = 2816, MEML = 256, MROWS = NB * MEML, DX = 512;
constexpr size_t MiB = 1u << 20;
constexpr size_t WS_SSQ = 0;
constexpr size_t WS_SSQM = 512 * 1024;
constexpr size_t WS_BAR = 768 * 1024, BAR_BYTES = 32768;
constexpr int LDS_BARST = 147392;
constexpr size_t WS_PRM = 800 * 1024;
constexpr size_t WS_W = 1 * MiB, W_LAYER = 29 * MiB + MiB / 2;
constexpr size_t OW_IN = 0, OW_OUT = 7 * MiB, OW_XQ = 9 * MiB, OW_XKV = 10 * MiB, OW_XO = 12 * MiB, OW_GU = 13 * MiB, OW_DN = 24 * MiB;
constexpr size_t WS_U = 60 * MiB;
constexpr size_t WS_Y = 172 * MiB;
constexpr size_t WS_QX = 172 * MiB, WS_OX = 188 * MiB;
constexpr size_t WS_HB = 204 * MiB;
constexpr size_t WS_MEMB = 236 * MiB;
constexpr size_t WS_KV = 240 * MiB;
constexpr size_t WS_SSQP = 248 * MiB;
constexpr size_t WS_END = 256 * MiB;
constexpr int LDS_BYTES = 147456;

__device__ __forceinline__ unsigned f2bf(float f) { unsigned u = __builtin_bit_cast(unsigned, f); return (u + 0x7fffu + ((u >> 16) & 1u)) >> 16; }
__device__ __forceinline__ unsigned pk2(float lo, float hi) { return f2bf(lo) | (f2bf(hi) << 16); }
__device__ __forceinline__ float bf2f(unsigned short v) { return __uint_as_float(((unsigned)v) << 16); }
__device__ __forceinline__ float lo_f(unsigned w) { return __uint_as_float(w << 16); }
__device__ __forceinline__ float hi_f(unsigned w) { return __uint_as_float(w & 0xffff0000u); }
__device__ __forceinline__ float log_sigmoid_f(float x) { return fminf(x, 0.f) - __logf(1.0f + __expf(-fabsf(x))); }
__device__ __forceinline__ float sigmoid_f(float x) { return __builtin_amdgcn_rcpf(1.0f + __expf(-x)); }
__device__ __forceinline__ float wave_sum(float v) {
#pragma unroll
    for (int o = 1; o < 64; o <<= 1) v += __shfl_xor(v, o);
    return v;
}

#define XB_TMO      128
#define XB_XCNT(j)  (256  + 64 * (j))
#define XB_XSUB(j)  (1280 + 64 * (j))
#define XB_XGEN(j)  (2304 + 64 * (j))
#define XB_TOP      3328
#define XB_TOPGEN   3392
#define XCD_BAR_WORDS 3456
#define XB_SPIN_CAP (1u << 18)

__device__ __forceinline__ unsigned xb_ld(unsigned* p)              { return __hip_atomic_load(p, __ATOMIC_RELAXED, __HIP_MEMORY_SCOPE_AGENT); }
__device__ __forceinline__ unsigned xb_add(unsigned* p, unsigned v) { return __hip_atomic_fetch_add(p, v, __ATOMIC_RELAXED, __HIP_MEMORY_SCOPE_AGENT); }
__device__ __forceinline__ unsigned xb_xcc_id() { return (unsigned)__builtin_amdgcn_s_getreg((3 << 11) | 20) & 0xFu; }
#define XB_SPIN(cond, bar) do { unsigned _sp = 0; while (cond) { __builtin_amdgcn_s_sleep(1); \
    if ((++_sp & 255u) == 0u) { if (xb_ld(&(bar)[XB_TMO])) break; if (_sp > XB_SPIN_CAP) { atomicAdd(&(bar)[XB_TMO], 1u); break; } } } } while (0)

struct XcdBarrier {
    unsigned* bar; unsigned x;
    volatile LAS unsigned* st;
};

__device__ __forceinline__ XcdBarrier xcd_barrier_post(unsigned* bar, volatile LAS unsigned* st) {
    XcdBarrier b; b.bar = bar; b.x = xb_xcc_id(); b.st = st;
    if (threadIdx.x == 0) (void)xb_add(&bar[XB_XCNT(b.x)], 1u);
    return b;
}
__device__ __forceinline__ void xcd_barrier_complete(unsigned* bar, unsigned x, unsigned& nloc, unsigned& nx) {
    const unsigned G = gridDim.x * gridDim.y * gridDim.z;
    unsigned sum, cnt, mine, sp = 0u;
    for (;;) {
        sum = 0u; cnt = 0u; mine = 0u;
#pragma unroll
        for (unsigned j = 0; j < 16; ++j) { const unsigned c = xb_ld(&bar[XB_XCNT(j)]); sum += c; cnt += (c > 0u) ? 1u : 0u; mine = (j == x) ? c : mine; }
        if (sum == G) break;
        __builtin_amdgcn_s_sleep(1);
        if ((++sp & 255u) == 0u) { if (xb_ld(&bar[XB_TMO])) break; if (sp > XB_SPIN_CAP) { atomicAdd(&bar[XB_TMO], 1u); break; } }
    }
    nloc = mine > 0u ? mine : 1u; nx = cnt > 0u ? cnt : 1u;
}

__device__ __forceinline__ void xcd_barrier(const XcdBarrier& b) {
    asm volatile("s_waitcnt vmcnt(0)" ::: "memory");
    __syncthreads();
    if (threadIdx.x == 0) {
        unsigned* bar = b.bar;
        __builtin_amdgcn_s_waitcnt(0);
        unsigned nloc = b.st[0], nx = b.st[1];
        if (nloc == 0u) { xcd_barrier_complete(bar, b.x, nloc, nx); b.st[0] = nloc; b.st[1] = nx; }
        const unsigned old = xb_add(&bar[XB_XSUB(b.x)], 1u);
        const unsigned gen = old / nloc;
        if (old + 1u == (gen + 1u) * nloc) {
            __builtin_amdgcn_fence(__ATOMIC_RELEASE, "agent");
            asm volatile("s_waitcnt vmcnt(0)" ::: "memory");
            const unsigned og = xb_add(&bar[XB_TOP], 1u);
            const unsigned tg = og / nx;
            if (og + 1u == (tg + 1u) * nx) xb_add(&bar[XB_TOPGEN], 1u);
            else XB_SPIN(xb_ld(&bar[XB_TOPGEN]) == tg, bar);
            __builtin_amdgcn_fence(__ATOMIC_ACQUIRE, "agent");
            xb_add(&bar[XB_XGEN(b.x)], 1u);
            asm volatile("s_waitcnt vmcnt(0)" ::: "memory");
        } else {
            XB_SPIN(xb_ld(&bar[XB_XGEN(b.x)]) == gen, bar);
            __builtin_amdgcn_fence(__ATOMIC_ACQUIRE, "agent");
            asm volatile("s_waitcnt vmcnt(0)" ::: "memory");
        }
    }
    __syncthreads();
}

__device__ __forceinline__ void conv_item(const float* W0, const float* W1, int pitch, int K, int mode, const float* rowscale, bf16* WT, LAS float* scr, int item, int nblk, int lane) {
    const int kb = item / nblk, nb = item % nblk, k0 = 64 * kb, n0 = 32 * nb;
    const int n = n0 + (lane & 31);
    const float* src = nullptr;
    if (mode == 0) src = W0 + n;
    else if (mode == 1) { if (n < 1152) src = W0 + n; else if (n < 3456) src = W0 + n + 6; else if (n < 3462) src = W0 + 1152 + (n - 3456); else if (n < 3474) src = W0 + n; }
    else { const int t = n >> 8, j = n & 255; src = (j < 128) ? (W0 + 128 * t + j) : (W1 + 128 * t + (j - 128)); }
#pragma unroll
    for (int i = 0; i < 32; ++i) { const int kk = 2 * i + (lane >> 5); float v = src ? src[(size_t)(k0 + kk) * pitch] : 0.f; if (rowscale) v *= rowscale[k0 + kk]; scr[kk * 33 + (lane & 31)] = v; }
    asm volatile("s_waitcnt lgkmcnt(0)" ::: "memory");
    const int c = lane & 7;
#pragma unroll
    for (int j = 0; j < 4; ++j) { const int nn = (lane >> 3) + 8 * j; const LAS float* s = scr + (8 * c) * 33 + nn;
        v4u o; o.x = pk2(s[0 * 33], s[1 * 33]); o.y = pk2(s[2 * 33], s[3 * 33]); o.z = pk2(s[4 * 33], s[5 * 33]); o.w = pk2(s[6 * 33], s[7 * 33]);
        *(v4u*)(WT + (size_t)(n0 + nn) * K + k0 + 8 * c) = o; }
    asm volatile("s_waitcnt lgkmcnt(0)" ::: "memory");
}
__device__ __forceinline__ void conv_block_item(const float* W0, const float* W1, int pitch, int K, int mode, const float* rowscale, bf16* WT, LAS float* tile, int kb, int nb, int tid) {
    const int k0 = 64 * kb, n0 = 256 * nb, c4 = (tid & 63) * 4;
#pragma unroll
    for (int i = 0; i < 8; ++i) { const int row = 8 * i + (tid >> 6); f32x4 v = {0.f, 0.f, 0.f, 0.f};
        const float* rp = W0 + (size_t)(k0 + row) * pitch;
        if (mode == 0) v = *(const f32x4*)(rp + n0 + c4);
        else if (mode == 2) { const float* rq = (c4 < 128 ? rp : W1 + (size_t)(k0 + row) * pitch) + 128 * nb + (c4 & 127); v = *(const f32x4*)rq; }
        else {
#pragma unroll
            for (int j = 0; j < 4; ++j) { const int n = n0 + c4 + j; int sc = -1;
                if (n < 1152) sc = n; else if (n < 3456) sc = n + 6; else if (n < 3462) sc = 1152 + (n - 3456); else if (n < 3474) sc = n;
                v[j] = sc >= 0 ? rp[sc] : 0.f; } }
        if (rowscale) v = v * rowscale[k0 + row];
        LAS float* d = tile + row * 257 + c4; d[0] = v[0]; d[1] = v[1]; d[2] = v[2]; d[3] = v[3]; }
    __syncthreads();
    const int q = tid & 7;
#pragma unroll
    for (int pass = 0; pass < 4; ++pass) { const int nl = (tid >> 3) + 64 * pass; const LAS float* sp = tile + (8 * q) * 257 + nl;
        v4u o; o.x = pk2(sp[0], sp[257]); o.y = pk2(sp[2 * 257], sp[3 * 257]); o.z = pk2(sp[4 * 257], sp[5 * 257]); o.w = pk2(sp[6 * 257], sp[7 * 257]);
        *(v4u*)(WT + (size_t)(n0 + nl) * K + k0 + 8 * q) = o; }
    __syncthreads();
}
__device__ __forceinline__ void row_to_bf16_ssq(const float* xrow, bf16* orow, float* ssq_out, int lane) {
    const f32x4* xr = (const f32x4*)xrow + lane; f32x4 v[4]; float s2 = 0.f;
#pragma unroll
    for (int j = 0; j < 4; ++j) { v[j] = xr[64 * j]; s2 += (v[j].x * v[j].x + v[j].y * v[j].y) + (v[j].z * v[j].z + v[j].w * v[j].w); }
    s2 = wave_sum(s2);
    unsigned long long* o8 = (unsigned long long*)orow + lane;
#pragma unroll
    for (int j = 0; j < 4; ++j) o8[64 * j] = (unsigned long long)pk2(v[j].x, v[j].y) | ((unsigned long long)pk2(v[j].z, v[j].w) << 32);
    if (lane < 16) ssq_out[lane] = lane == 0 ? s2 : 0.f;
}

typedef short s16x8 __attribute__((ext_vector_type(8)));
typedef short s16x4 __attribute__((ext_vector_type(4)));
typedef float f32x16 __attribute__((ext_vector_type(16)));
__device__ __forceinline__ s16x4 tr_read(LAS const unsigned char* p) { return __builtin_bit_cast(s16x4, __builtin_amdgcn_ds_read_tr16_b64_v4i16((LAS s16x4*)p)); }
__device__ __forceinline__ s16x8 cat8(s16x4 a, s16x4 b) { return (s16x8){a[0], a[1], a[2], a[3], b[0], b[1], b[2], b[3]}; }
__device__ __forceinline__ unsigned cvtpk(float lo, float hi) { return pg8::cvt_pk_bf16(lo, hi); }
__device__ __forceinline__ s16x8 pack8(float a0, float a1, float a2, float a3, float a4, float a5, float a6, float a7) {
    v4u w; w.x = cvtpk(a0, a1); w.y = cvtpk(a2, a3); w.z = cvtpk(a4, a5); w.w = cvtpk(a6, a7); return __builtin_bit_cast(s16x8, w); }
#define MFMA32(a, b, c) __builtin_amdgcn_mfma_f32_32x32x16_bf16(a, b, c, 0, 0, 0)
__device__ __forceinline__ float xh_sum(float x) { auto rr = __builtin_amdgcn_permlane32_swap(__float_as_uint(x), __float_as_uint(x), false, false); return __uint_as_float(rr[0]) + __uint_as_float(rr[1]); }
__device__ __forceinline__ float xh_max(float x) { auto rr = __builtin_amdgcn_permlane32_swap(__float_as_uint(x), __float_as_uint(x), false, false); return fmaxf(__uint_as_float(rr[0]), __uint_as_float(rr[1])); }
__device__ __forceinline__ float xh_prod(float x) { auto rr = __builtin_amdgcn_permlane32_swap(__float_as_uint(x), __float_as_uint(x), false, false); return __uint_as_float(rr[0]) * __uint_as_float(rr[1]); }
__device__ __forceinline__ float xh_other(float x) { auto rr = __builtin_amdgcn_permlane32_swap(__float_as_uint(x), __float_as_uint(x), false, false); return __uint_as_float(rr[0] == __float_as_uint(x) ? rr[1] : rr[0]); }
__device__ __forceinline__ void st_wt64(float* p, float a, float b) { __hip_atomic_store((unsigned long long*)p, ((unsigned long long)__float_as_uint(b) << 32) | (unsigned long long)__float_as_uint(a), __ATOMIC_RELAXED, __HIP_MEMORY_SCOPE_AGENT); }
__device__ __forceinline__ void st_wt32(float* p, float a) { __hip_atomic_store((unsigned*)p, __float_as_uint(a), __ATOMIC_RELAXED, __HIP_MEMORY_SCOPE_AGENT); }
__device__ __forceinline__ void fox_cumsum_item(const bf16* u, const float* foxb, float* cl, float* tot, int item, int lane) {
    const int bhf = item >> 3, seg = item & 7, b = bhf / 6, h = bhf % 6;
    const float fb = foxb[h];
    const bf16* p = u + ((size_t)b * S + seg * 256 + 4 * lane) * NU + 3456 + h;
    const float L2E = 1.4426950408889634f;
    float l0 = L2E * log_sigmoid_f(bf2f(p[0]) + fb), l1 = L2E * log_sigmoid_f(bf2f(p[NU]) + fb), l2 = L2E * log_sigmoid_f(bf2f(p[2 * NU]) + fb), l3 = L2E * log_sigmoid_f(bf2f(p[3 * NU]) + fb);
    l1 += l0; l2 += l1; l3 += l2;
    float inc = l3;
#pragma unroll
    for (int o = 1; o < 64; o <<= 1) { const float v = __shfl_up(inc, o, 64); if (lane >= o) inc += v; }
    const float ex = inc - l3;
    { float* d = cl + (size_t)bhf * S + seg * 256 + 4 * lane; st_wt64(d, ex + l0, ex + l1); st_wt64(d + 2, ex + l2, ex + l3); }
    if (lane == 63) st_wt32(tot + bhf * 8 + seg, inc);
}
constexpr int PV64 = 144;
__device__ __forceinline__ void attn_mfma_item(const bf16* u, bf16* y, const float* cl, const float* tot, LAS unsigned char* wl, int item, int lane) {
    const int bh = item % 80, qb = 63 - item / 80;
    const bool fox = bh < 48;
    int b, h, qoff, koff, voff, yoff;
    if (fox) { b = bh / 6; h = bh % 6; qoff = h * 64; koff = 384 + h * 64; voff = 768 + h * 64; yoff = h * 64; }
    else { const int rr = bh - 48; b = rr / 4; h = rr % 4; qoff = 1152 + h * 64; koff = 1408 + h * 64; voff = 1664 + h * 64; yoff = 384 + h * 64; }
    const int r = lane & 31, hi = lane >> 5;
    const char* ubc = (const char*)(u + (size_t)b * S * NU);
    const int t = qb * 32 + r;
    const float* clh = cl + (size_t)(fox ? bh : 0) * S;
    s16x8 Qf[4];
    { const unsigned qo = (unsigned)(t * NU + qoff + 8 * hi) * 2u;
#pragma unroll
      for (int d0 = 0; d0 < 4; ++d0) Qf[d0] = *(const s16x8*)(ubc + qo + 32 * d0);
      if (!fox) {
          const float qs = -0.125f * 1.4426950408889634f;
#pragma unroll
          for (int d0 = 0; d0 < 4; ++d0) { const v4u w = __builtin_bit_cast(v4u, Qf[d0]);
              Qf[d0] = pack8(lo_f(w.x) * qs, hi_f(w.x) * qs, lo_f(w.y) * qs, hi_f(w.y) * qs, lo_f(w.z) * qs, hi_f(w.z) * qs, lo_f(w.w) * qs, hi_f(w.w) * qs); } } }
    f32x16 O0, O1;
#pragma unroll
    for (int i = 0; i < 16; ++i) { O0[i] = 0.f; O1[i] = 0.f; }
    float mrun = -1e30f, lsum = 0.f, Rsb = 1.f, Doff = 0.f;
    const float clt = fox ? clh[t] : 0.f;
    LAS float* gl = (LAS float*)(wl + 4608);
    const int trbase = (4 * hi + ((lane >> 2) & 3)) * PV64 + (16 * ((lane >> 4) & 1) + 4 * (lane & 3)) * 2;
    const unsigned lane_off = (unsigned)((lane >> 3) * NU + 8 * (lane & 7)) * 2u;
    v4u kn[4], vn[4]; float gn = 0.f;
    { const char* tb = ubc + (size_t)(qb * 32) * NU * 2;
#pragma unroll
      for (int i = 0; i < 4; ++i) { kn[i] = *(const v4u*)(tb + (size_t)(8 * i * NU + koff) * 2 + lane_off); vn[i] = *(const v4u*)(tb + (size_t)(8 * i * NU + voff) * 2 + lane_off); }
      if (fox) gn = clh[qb * 32 + r]; }
    LAS unsigned char* kl = wl + 4736;
    const int kfoff = r * PV64 + 16 * hi;
    const float SC2 = 0.125f * 1.4426950408889634f;
    { LAS unsigned char* z = wl + 9344 + (lane >> 3) * PV64 + 16 * (lane & 7);
#pragma unroll
      for (int i = 0; i < 4; ++i) *(LAS v4u*)(z + 8 * i * PV64) = (v4u){0u, 0u, 0u, 0u}; }
    s16x8 Pp0 = {0, 0, 0, 0, 0, 0, 0, 0}, Pp1 = {0, 0, 0, 0, 0, 0, 0, 0};
    int vlast = 0;
    for (int jt = qb; jt >= 0; --jt) {
        const bool diag = (jt == qb);
        const int vcur = ((qb - jt) & 1) ? 9344 : 0, vprev = 9344 - vcur; vlast = vcur;
        { LAS unsigned char* dk = kl + (lane >> 3) * PV64 + 16 * (lane & 7); LAS unsigned char* dv = wl + vcur + (lane >> 3) * PV64 + 16 * (lane & 7);
#pragma unroll
          for (int i = 0; i < 4; ++i) { *(LAS v4u*)(dk + 8 * i * PV64) = kn[i]; *(LAS v4u*)(dv + 8 * i * PV64) = vn[i]; } }
        if (fox) gl[r] = -gn;
        if (jt > 0) { const char* tb = ubc + (size_t)((jt - 1) * 32) * NU * 2;
#pragma unroll
          for (int i = 0; i < 4; ++i) { kn[i] = *(const v4u*)(tb + (size_t)(8 * i * NU + koff) * 2 + lane_off); vn[i] = *(const v4u*)(tb + (size_t)(8 * i * NU + voff) * 2 + lane_off); }
          if (fox) gn = clh[(jt - 1) * 32 + r]; }
        s16x8 Kf[4];
#pragma unroll
        for (int d0 = 0; d0 < 4; ++d0) Kf[d0] = *(LAS const s16x8*)(kl + kfoff + 32 * d0);
        LAS const unsigned char* vb = wl + vprev + trbase;
        const s16x8 V00 = cat8(tr_read(vb), tr_read(vb + 8 * PV64)), V01 = cat8(tr_read(vb + 16 * PV64), tr_read(vb + 24 * PV64));
        const s16x8 V10 = cat8(tr_read(vb + 64), tr_read(vb + 8 * PV64 + 64)), V11 = cat8(tr_read(vb + 16 * PV64 + 64), tr_read(vb + 24 * PV64 + 64));
        f32x16 Sx;
#pragma unroll
        for (int i = 0; i < 16; ++i) Sx[i] = 0.f;
        Sx = MFMA32(Kf[0], Qf[0], Sx); O0 = MFMA32(V00, Pp0, O0);
        Sx = MFMA32(Kf[1], Qf[1], Sx); O1 = MFMA32(V10, Pp0, O1);
        Sx = MFMA32(Kf[2], Qf[2], Sx); O0 = MFMA32(V01, Pp1, O0);
        Sx = MFMA32(Kf[3], Qf[3], Sx); O1 = MFMA32(V11, Pp1, O1);
        float P[16];
        if (fox) {
            const float off = clt + Doff;
            float tmax = -1e30f;
#pragma unroll
            for (int g = 0; g < 4; ++g) { const f32x4 ncs = *(LAS const f32x4*)(gl + 8 * g + 4 * hi);
#pragma unroll
                for (int e = 0; e < 4; ++e) P[4 * g + e] = fmaf(SC2, Sx[4 * g + e], ncs[e]); }
            if (diag) {
#pragma unroll
                for (int i = 0; i < 16; ++i) { const int sl = 8 * (i >> 2) + 4 * hi + (i & 3); if (sl > r) P[i] = -1e30f; } }
#pragma unroll
            for (int i = 0; i < 16; ++i) tmax = fmaxf(tmax, P[i]);
            tmax = xh_max(tmax) + off;
            if (__any(tmax > mrun)) {
                const float mnew = fmaxf(mrun, tmax), alpha = __builtin_amdgcn_exp2f(mrun - mnew); lsum *= alpha; mrun = mnew;
#pragma unroll
                for (int i = 0; i < 16; ++i) { O0[i] *= alpha; O1[i] *= alpha; } }
            const float msh = mrun - off; float ps = 0.f;
#pragma unroll
            for (int i = 0; i < 16; ++i) { P[i] = __builtin_amdgcn_exp2f(P[i] - msh); ps += P[i]; }
            lsum += ps;
            if (jt > 0 && ((jt - 1) >> 3) != (jt >> 3)) Doff += tot[bh * 8 + ((jt - 1) >> 3)];
        } else {
            float kp[16], gs[4], go[4]; float T = 1.f;
#pragma unroll
            for (int i = 0; i < 16; ++i) { const float ee = __builtin_amdgcn_exp2f(Sx[i]); const float sig = __builtin_amdgcn_rcpf(1.0f + ee); P[i] = sig; kp[i] = 1.0f - sig; }
            if (diag) {
#pragma unroll
                for (int i = 0; i < 16; ++i) { const int sl = 8 * (i >> 2) + 4 * hi + (i & 3); if (sl >= r) { P[i] = 0.f; kp[i] = 1.f; } } }
#pragma unroll
            for (int g = 0; g < 4; ++g) { gs[g] = (kp[4 * g] * kp[4 * g + 1]) * (kp[4 * g + 2] * kp[4 * g + 3]); T *= gs[g]; }
#pragma unroll
            for (int g = 0; g < 4; ++g) go[g] = xh_other(gs[g]);
            float above = Rsb;
#pragma unroll
            for (int g = 3; g >= 0; --g) {
                float suf = hi == 0 ? above * go[g] : above;
#pragma unroll
                for (int e = 3; e >= 0; --e) { const float a = P[4 * g + e] * suf; suf *= kp[4 * g + e]; P[4 * g + e] = a; }
                above *= gs[g] * go[g];
            }
            Rsb *= xh_prod(T);
        }
        Pp0 = pack8(P[0], P[1], P[2], P[3], P[4], P[5], P[6], P[7]); Pp1 = pack8(P[8], P[9], P[10], P[11], P[12], P[13], P[14], P[15]);
        if (!fox && __all(Rsb == 0.0f)) break;
    }
    { LAS const unsigned char* vb = wl + vlast + trbase;
      const s16x8 V00 = cat8(tr_read(vb), tr_read(vb + 8 * PV64)), V01 = cat8(tr_read(vb + 16 * PV64), tr_read(vb + 24 * PV64));
      const s16x8 V10 = cat8(tr_read(vb + 64), tr_read(vb + 8 * PV64 + 64)), V11 = cat8(tr_read(vb + 16 * PV64 + 64), tr_read(vb + 24 * PV64 + 64));
      O0 = MFMA32(V00, Pp0, O0); O1 = MFMA32(V10, Pp0, O1); O0 = MFMA32(V01, Pp1, O0); O1 = MFMA32(V11, Pp1, O1); }
    float inv = 1.0f;
    if (fox) { lsum = xh_sum(lsum); inv = __builtin_amdgcn_rcpf(lsum); }
    char* yb0 = (char*)(y + (size_t)b * S * D); const unsigned yo = (unsigned)(t * D + yoff + 4 * hi) * 2u;
#pragma unroll
    for (int g = 0; g < 4; ++g) {
        unsigned long long w0 = (unsigned long long)cvtpk(O0[4 * g] * inv, O0[4 * g + 1] * inv) | ((unsigned long long)cvtpk(O0[4 * g + 2] * inv, O0[4 * g + 3] * inv) << 32);
        unsigned long long w1 = (unsigned long long)cvtpk(O1[4 * g] * inv, O1[4 * g + 1] * inv) | ((unsigned long long)cvtpk(O1[4 * g + 2] * inv, O1[4 * g + 3] * inv) << 32);
        *(unsigned long long*)(yb0 + yo + 16 * g) = w0; *(unsigned long long*)(yb0 + yo + 64 + 16 * g) = w1; }
}
constexpr int PV128 = 272;
__device__ __forceinline__ void xattn_mfma_item(const bf16* qx, const bf16* kv, bf16* ox, LAS unsigned char* wl, int item, int lane) {
    const int head = item & 3, qblk = item >> 2;
    const int r = lane & 31, hi = lane >> 5;
    const int token = qblk * 32 + r, b = (qblk * 32) / S;
    s16x8 Qf[8];
    { const char* qb_ = (const char*)qx; const unsigned qo = (unsigned)(token * DX + head * 128 + 8 * hi) * 2u;
#pragma unroll
      for (int d0 = 0; d0 < 8; ++d0) Qf[d0] = *(const s16x8*)(qb_ + qo + 32 * d0); }
    f32x16 O[4];
#pragma unroll
    for (int k = 0; k < 4; ++k)
#pragma unroll
        for (int i = 0; i < 16; ++i) O[k][i] = 0.f;
    float mrun = -1e30f, lsum = 0.f;
    const int trbase = (4 * hi + ((lane >> 2) & 3)) * PV128 + (16 * ((lane >> 4) & 1) + 4 * (lane & 3)) * 2;
    const char* kvc = (const char*)(kv + (size_t)b * MEML * 1024);
    const unsigned kfo = (unsigned)(r * 1024 + head * 128 + 8 * hi) * 2u;
    const unsigned vlo = (unsigned)((lane >> 4) * 1024 + 512 + head * 128 + 8 * (lane & 15)) * 2u;
    s16x8 Kn[8]; v4u vn[8];
#pragma unroll
    for (int d0 = 0; d0 < 8; ++d0) Kn[d0] = *(const s16x8*)(kvc + kfo + 32 * d0);
#pragma unroll
    for (int i = 0; i < 8; ++i) vn[i] = *(const v4u*)(kvc + vlo + (size_t)(4 * i) * 2048);
    const float SCX = 0.08838834764831845f * 1.4426950408889634f;
    for (int jt = 0; jt < 8; ++jt) {
        f32x16 Sx;
#pragma unroll
        for (int i = 0; i < 16; ++i) Sx[i] = 0.f;
#pragma unroll
        for (int d0 = 0; d0 < 8; ++d0) Sx = MFMA32(Kn[d0], Qf[d0], Sx);
        { LAS unsigned char* dst = wl + (lane >> 4) * PV128 + 16 * (lane & 15);
#pragma unroll
          for (int i = 0; i < 8; ++i) *(LAS v4u*)(dst + 4 * i * PV128) = vn[i]; }
        if (jt < 7) { const char* tb = kvc + (size_t)((jt + 1) * 32) * 2048;
#pragma unroll
            for (int d0 = 0; d0 < 8; ++d0) Kn[d0] = *(const s16x8*)(tb + kfo + 32 * d0);
#pragma unroll
            for (int i = 0; i < 8; ++i) vn[i] = *(const v4u*)(tb + vlo + (size_t)(4 * i) * 2048); }
        float P[16]; float tmax = -1e30f;
#pragma unroll
        for (int i = 0; i < 16; ++i) { P[i] = Sx[i] * SCX; tmax = fmaxf(tmax, P[i]); }
        tmax = xh_max(tmax);
        if (__any(tmax > mrun)) { const float mnew = fmaxf(mrun, tmax), alpha = __builtin_amdgcn_exp2f(mrun - mnew); lsum *= alpha; mrun = mnew;
#pragma unroll
            for (int k = 0; k < 4; ++k)
#pragma unroll
                for (int i = 0; i < 16; ++i) O[k][i] *= alpha; }
        float ps = 0.f;
#pragma unroll
        for (int i = 0; i < 16; ++i) { P[i] = __builtin_amdgcn_exp2f(P[i] - mrun); ps += P[i]; }
        lsum += ps;
        const s16x8 Pf0 = pack8(P[0], P[1], P[2], P[3], P[4], P[5], P[6], P[7]), Pf1 = pack8(P[8], P[9], P[10], P[11], P[12], P[13], P[14], P[15]);
        LAS const unsigned char* vb = wl + trbase;
#pragma unroll
        for (int k = 0; k < 4; ++k) {
            const s16x8 Va = cat8(tr_read(vb + 64 * k), tr_read(vb + 8 * PV128 + 64 * k)), Vb = cat8(tr_read(vb + 16 * PV128 + 64 * k), tr_read(vb + 24 * PV128 + 64 * k));
            O[k] = MFMA32(Va, Pf0, O[k]); O[k] = MFMA32(Vb, Pf1, O[k]); }
    }
    lsum = xh_sum(lsum); const float inv = __builtin_amdgcn_rcpf(lsum);
    char* oc = (char*)ox; const unsigned oo = (unsigned)(token * DX + head * 128 + 4 * hi) * 2u;
#pragma unroll
    for (int k = 0; k < 4; ++k)
#pragma unroll
        for (int g = 0; g < 4; ++g) {
            const unsigned long long w0 = (unsigned long long)cvtpk(O[k][4 * g] * inv, O[k][4 * g + 1] * inv) | ((unsigned long long)cvtpk(O[k][4 * g + 2] * inv, O[k][4 * g + 3] * inv) << 32);
            *(unsigned long long*)(oc + oo + 64 * k + 16 * g) = w0; }
}

constexpr int ML_WSTRIDE = 18432, ML_RAWK = 0, ML_RAWQ = 5056, ML_WK = 5056, ML_V = 10112, ML_CW = 14720, ML_EB = 16768, ML_NL = 16896, ML_NW = 17152, ML_ITEM_F = 4224;
template <bool OUT>
__device__ __forceinline__ void mlstm_item(const bf16* u, bf16* y, float* scratch, const float* convw, const float* ib, const float* fbias, const float* normw, LAS unsigned char* wl, int bh, int c, int lane) {
    const int b = bh / 6, h = bh % 6, r = lane & 31, hi = lane >> 5;
    const bf16* ub = u + (size_t)b * S * NU;
    LAS float* cw = (LAS float*)(wl + ML_CW); LAS float* eb = (LAS float*)(wl + ML_EB); LAS float* nl = (LAS float*)(wl + ML_NL); LAS float* nwl = (LAS float*)(wl + ML_NW);
    for (int i = lane; i < 512; i += 64) { const int tap = i >> 7, ch = i & 127; cw[i] = convw[tap * 768 + (ch < 64 ? (64 * h + ch) : (384 + 64 * h + (ch - 64)))]; }
    if (OUT) nwl[lane] = normw[h * 64 + lane];
    const float ibh = ib[h], fbh = fbias[h];
    f32x16 X[2][2];
#pragma unroll
    for (int a = 0; a < 2; ++a)
#pragma unroll
        for (int bb = 0; bb < 2; ++bb)
#pragma unroll
            for (int i = 0; i < 16; ++i) X[a][bb][i] = 0.f;
    float nk = 0.f, Gsum = 0.f;
    if (OUT) {
        float dec = 1.f;
        for (int cp = c - 1; cp >= 0; --cp) {
            const float* s0 = scratch + (size_t)(bh * 16 + cp) * ML_ITEM_F;
            f32x16 v0[4];
#pragma unroll
            for (int blk = 0; blk < 4; ++blk) v0[blk] = *(const f32x16*)(s0 + blk * 1024 + lane * 16);
            const float n0 = s0[4096 + lane], g0 = s0[4160];
#pragma unroll
            for (int blk = 0; blk < 4; ++blk) X[blk >> 1][blk & 1] += v0[blk] * dec;
            nk += dec * n0;
            dec *= __expf(g0);
        }
    }
    nl[lane] = nk;
    const int trP = (4 * hi + ((lane >> 2) & 3)) * 144 + (16 * ((lane >> 4) & 1) + 4 * (lane & 3)) * 2;
    const int trN = (8 * hi + ((lane >> 2) & 3)) * 144 + (16 * ((lane >> 4) & 1) + 4 * (lane & 3)) * 2;
    for (int j = 0; j < 4; ++j) {
        const int t0 = c * 128 + j * 32, t = t0 + r;
        const bf16* trow = ub + (size_t)t * NU;
        const unsigned short gfr = trow[3468 + h], gir = trow[3462 + h];
        v4u vv[4], rk[5], rq[5];
        { const bf16* vrow = ub + (size_t)(t0 + (lane >> 3)) * NU + 2688 + 64 * h + 8 * (lane & 7);
#pragma unroll
          for (int i = 0; i < 4; ++i) vv[i] = *(const v4u*)(vrow + (size_t)(8 * i) * NU); }
#pragma unroll
        for (int i = 0; i < 5; ++i) { const int p = lane + 64 * i, row = p >> 3, ch8 = p & 7, tt = t0 - 3 + row; const bool ok = (p < 280) && (tt >= 0);
            const bf16* src = ub + (size_t)(ok ? tt : 0) * NU + 1920 + 64 * h + 8 * ch8;
            rk[i] = ok ? *(const v4u*)(src + 384) : (v4u){0u, 0u, 0u, 0u};
            if (OUT) rq[i] = ok ? *(const v4u*)(src) : (v4u){0u, 0u, 0u, 0u}; }
#pragma unroll
        for (int i = 0; i < 5; ++i) { const int p = lane + 64 * i, row = p >> 3, ch8 = p & 7;
            if (p < 280) { *(LAS v4u*)(wl + ML_RAWK + row * 144 + 16 * ch8) = rk[i]; if (OUT) *(LAS v4u*)(wl + ML_RAWQ + row * 144 + 16 * ch8) = rq[i]; } }
        { LAS unsigned char* dst = wl + ML_V + (lane >> 3) * 144 + 16 * (lane & 7);
#pragma unroll
          for (int i = 0; i < 4; ++i) *(LAS v4u*)(dst + 8 * i * 144) = vv[i]; }
        float bl = log_sigmoid_f(bf2f(gfr) + fbh); const float ii = bf2f(gir) + ibh;
#pragma unroll
        for (int o = 1; o < 32; o <<= 1) { const float v = __shfl_up(bl, o, 32); if (r >= o) bl += v; }
        const float g = __shfl(bl, 31, 32), es = ii - bl;
        eb[r] = es; Gsum += g;
        s16x8 Kf[4], Qf[4]; float dq = 0.f;
#pragma unroll
        for (int part = (OUT ? 0 : 1); part < 2; ++part) {
            LAS unsigned char* raw = wl + (part ? ML_RAWK : ML_RAWQ);
            const float w0 = cw[part * 64 + lane], w1 = cw[128 + part * 64 + lane], w2 = cw[256 + part * 64 + lane], w3 = cw[384 + part * 64 + lane];
            const float sc = part ? 0.125f : 1.0f;
            float xv[35];
#pragma unroll
            for (int i = 0; i < 35; ++i) xv[i] = bf2f(*(LAS const unsigned short*)(raw + i * 144 + 2 * lane));
#pragma unroll
            for (int i = 0; i < 16; ++i) {
                const float a0 = w0 * xv[2 * i] + w1 * xv[2 * i + 1] + w2 * xv[2 * i + 2] + w3 * xv[2 * i + 3];
                const float a1 = w0 * xv[2 * i + 1] + w1 * xv[2 * i + 2] + w2 * xv[2 * i + 3] + w3 * xv[2 * i + 4];
                const unsigned pk = cvtpk(a0 * sc * __builtin_amdgcn_rcpf(1.0f + __expf(-a0)), a1 * sc * __builtin_amdgcn_rcpf(1.0f + __expf(-a1)));
                *(LAS unsigned short*)(raw + (2 * i) * 144 + 2 * lane) = (unsigned short)pk; *(LAS unsigned short*)(raw + (2 * i + 1) * 144 + 2 * lane) = (unsigned short)(pk >> 16); }
#pragma unroll
            for (int f = 0; f < 4; ++f) {
                const unsigned long long p0 = *(LAS const unsigned long long*)(raw + r * 144 + (16 * f + 4 * hi) * 2), p1 = *(LAS const unsigned long long*)(raw + r * 144 + (16 * f + 8 + 4 * hi) * 2);
                const v4u fw = {(unsigned)p0, (unsigned)(p0 >> 32), (unsigned)p1, (unsigned)(p1 >> 32)};
                if (part) Kf[f] = __builtin_bit_cast(s16x8, fw); else Qf[f] = __builtin_bit_cast(s16x8, fw);
                if (OUT && part == 0) { const f32x4 n0 = *(LAS const f32x4*)(nl + 16 * f + 4 * hi), n1 = *(LAS const f32x4*)(nl + 16 * f + 8 + 4 * hi);
                    dq += (lo_f(fw.x) * n0[0] + hi_f(fw.x) * n0[1]) + (lo_f(fw.y) * n0[2] + hi_f(fw.y) * n0[3]) + (lo_f(fw.z) * n1[0] + hi_f(fw.z) * n1[1]) + (lo_f(fw.w) * n1[2] + hi_f(fw.w) * n1[3]); } }
        }
        if (OUT) {
            f32x16 Sx;
#pragma unroll
            for (int i = 0; i < 16; ++i) Sx[i] = 0.f;
#pragma unroll
            for (int f = 0; f < 4; ++f) Sx = MFMA32(Kf[f], Qf[f], Sx);
            float P[16]; float den = 0.f;
#pragma unroll
            for (int g4 = 0; g4 < 4; ++g4) { const f32x4 e4 = *(LAS const f32x4*)(eb + 8 * g4 + 4 * hi);
#pragma unroll
                for (int e = 0; e < 4; ++e) { const int sl = 8 * g4 + 4 * hi + e; const float d = (sl <= r) ? __expf(bl + e4[e]) : 0.f; P[4 * g4 + e] = Sx[4 * g4 + e] * d; den += P[4 * g4 + e]; } }
            den = xh_sum(den); dq = xh_sum(dq);
            const float ebt = __expf(bl);
            const float inv = 1.0f / fmaxf(fabsf(den + ebt * dq), 1.0f);
            const s16x8 Pf0 = pack8(P[0], P[1], P[2], P[3], P[4], P[5], P[6], P[7]), Pf1 = pack8(P[8], P[9], P[10], P[11], P[12], P[13], P[14], P[15]);
            unsigned long long ow[8];
#pragma unroll
            for (int vb = 0; vb < 2; ++vb)
#pragma unroll
                for (int g4 = 0; g4 < 4; ++g4) ow[4 * vb + g4] = *(const unsigned long long*)(trow + 3072 + 64 * h + 32 * vb + 8 * g4 + 4 * hi);
            f32x16 H[2]; float ms = 0.f;
#pragma unroll
            for (int vb = 0; vb < 2; ++vb) {
                LAS const unsigned char* vp = wl + ML_V + trP + 64 * vb;
                f32x16 Zi, Zx;
#pragma unroll
                for (int i = 0; i < 16; ++i) { Zi[i] = 0.f; Zx[i] = 0.f; }
                Zi = MFMA32(cat8(tr_read(vp), tr_read(vp + 8 * 144)), Pf0, Zi); Zi = MFMA32(cat8(tr_read(vp + 16 * 144), tr_read(vp + 24 * 144)), Pf1, Zi);
#pragma unroll
                for (int kb = 0; kb < 2; ++kb)
#pragma unroll
                    for (int sp = 0; sp < 2; ++sp) { const f32x16& xx = X[kb][vb];
                        const s16x8 xa = pack8(xx[8 * sp], xx[8 * sp + 1], xx[8 * sp + 2], xx[8 * sp + 3], xx[8 * sp + 4], xx[8 * sp + 5], xx[8 * sp + 6], xx[8 * sp + 7]);
                        Zx = MFMA32(xa, Qf[2 * kb + sp], Zx); }
#pragma unroll
                for (int i = 0; i < 16; ++i) { const float hv = (Zi[i] + ebt * Zx[i]) * inv; H[vb][i] = hv; ms += hv * hv; }
            }
            ms = xh_sum(ms);
            const float rs = rsqrtf(ms * (1.0f / 64.0f) + 1e-6f);
            bf16* yrow = y + ((size_t)b * S + t) * D + 640 + 64 * h;
#pragma unroll
            for (int vb = 0; vb < 2; ++vb)
#pragma unroll
                for (int g4 = 0; g4 < 4; ++g4) { const int v = 32 * vb + 8 * g4 + 4 * hi;
                    const unsigned o0 = (unsigned)ow[4 * vb + g4], o1 = (unsigned)(ow[4 * vb + g4] >> 32);
                    const f32x4 w4 = *(LAS const f32x4*)(nwl + v);
                    const float y0 = H[vb][4 * g4] * rs * w4[0] * sigmoid_f(lo_f(o0)), y1 = H[vb][4 * g4 + 1] * rs * w4[1] * sigmoid_f(hi_f(o0));
                    const float y2 = H[vb][4 * g4 + 2] * rs * w4[2] * sigmoid_f(lo_f(o1)), y3 = H[vb][4 * g4 + 3] * rs * w4[3] * sigmoid_f(hi_f(o1));
                    *(unsigned long long*)(yrow + v) = (unsigned long long)cvtpk(y0, y1) | ((unsigned long long)cvtpk(y2, y3) << 32); }
        }
        { const float wsc = __expf(g + es), eg = __expf(g);
#pragma unroll
          for (int f = 0; f < 4; ++f) { const v4u kw = __builtin_bit_cast(v4u, Kf[f]);
#pragma unroll
              for (int e = 0; e < 2; ++e) { const unsigned k0 = e ? kw.z : kw.x, k1 = e ? kw.w : kw.y; const int ch = 16 * f + 8 * e + 4 * hi;
                  *(LAS unsigned long long*)(wl + ML_WK + r * 144 + ch * 2) = (unsigned long long)cvtpk(lo_f(k0) * wsc, hi_f(k0) * wsc) | ((unsigned long long)cvtpk(lo_f(k1) * wsc, hi_f(k1) * wsc) << 32); } }
#pragma unroll
          for (int kb = 0; kb < 2; ++kb)
#pragma unroll
              for (int vb = 0; vb < 2; ++vb) { X[kb][vb] *= eg;
#pragma unroll
                  for (int sp = 0; sp < 2; ++sp) { LAS const unsigned char* kp = wl + ML_WK + trN + 16 * sp * 144 + 64 * kb; LAS const unsigned char* vp = wl + ML_V + trN + 16 * sp * 144 + 64 * vb;
                      X[kb][vb] = MFMA32(cat8(tr_read(kp), tr_read(kp + 4 * 144)), cat8(tr_read(vp), tr_read(vp + 4 * 144)), X[kb][vb]); } }
          float dn = 0.f;
#pragma unroll 8
          for (int s2 = 0; s2 < 32; ++s2) dn += bf2f(*(LAS const unsigned short*)(wl + ML_WK + s2 * 144 + 2 * lane));
          nk = eg * nk + dn; nl[lane] = nk; }
    }
    if (!OUT) {
        float* sp = scratch + (size_t)(bh * 16 + c) * ML_ITEM_F;
#pragma unroll
        for (int blk = 0; blk < 4; ++blk) {
#pragma unroll
            for (int i = 0; i < 8; ++i) st_wt64(sp + blk * 1024 + lane * 16 + 2 * i, X[blk >> 1][blk & 1][2 * i], X[blk >> 1][blk & 1][2 * i + 1]); }
        st_wt32(sp + 4096 + lane, nk);
        if (lane == 0) st_wt32(sp + 4160, Gsum);
    }
}

struct Args { const float* in[20]; float* out; unsigned char* ws; };
#define GEMM_PHASE(EpiT, SchedT, g, Sc, E) pg8::gemm_phase<EpiT, SchedT, true, true>(L, g, Sc, E)

__global__ void __launch_bounds__(512, 2) mega_fwd(Args a) {
    extern __shared__ __attribute__((aligned(16))) unsigned char lds[];
    LAS unsigned char* L = (LAS unsigned char*)lds;
    const int tid = threadIdx.x, lane = tid & 63, wave = __builtin_amdgcn_readfirstlane(tid >> 6);
    const int G = gridDim.x, bx = blockIdx.x;
    const int gw = bx * 8 + wave, NGW = G * 8;
    unsigned char* ws = a.ws;
    const float* x = a.in[0]; const float* mem = a.in[1];
    float* out = a.out;
    float* ssq = (float*)(ws + WS_SSQP); float* ssqm = (float*)(ws + WS_SSQP + 7 * MiB);
    bf16* ub = (bf16*)(ws + WS_U); bf16* actb = (bf16*)(ws + WS_U); bf16* yb = (bf16*)(ws + WS_Y); bf16* qxb = (bf16*)(ws + WS_QX); bf16* oxb = (bf16*)(ws + WS_OX);
    bf16* hb = (bf16*)(ws + WS_HB); bf16* memb = (bf16*)(ws + WS_MEMB); bf16* kvb = (bf16*)(ws + WS_KV);

    volatile LAS unsigned* bst = (volatile LAS unsigned*)(L + LDS_BARST); if (tid < 2) bst[tid] = 0u;
    __syncthreads();
    (void)xcd_barrier_post((unsigned*)(a.ws + WS_BAR), bst);
    {
        LAS float* tile = (LAS float*)L;
        constexpr int I_IN = 16 * 14, I_OUT = 16 * 4, I_XQ = 16 * 2, I_XKV = 16 * 4, I_XO = 8 * 4, I_GU = 16 * 22, I_DN = 44 * 4;
        constexpr int I_LAYER = I_IN + I_OUT + I_XQ + I_XKV + I_XO + I_GU + I_DN;
        for (int it = bx; it < 2 * I_LAYER; it += G) {
            const int l = it / I_LAYER; int r = it % I_LAYER;
            unsigned char* wl = ws + WS_W + (size_t)l * W_LAYER;
            if (r < I_IN) { conv_block_item(a.in[3] + (size_t)l * 1024 * 3474, nullptr, 3474, 1024, 1, a.in[2] + l * 1024, (bf16*)(wl + OW_IN), tile, r / 14, r % 14, tid); continue; } r -= I_IN;
            if (r < I_OUT) { conv_block_item(a.in[9] + (size_t)l * 1024 * 1024, nullptr, 1024, 1024, 0, nullptr, (bf16*)(wl + OW_OUT), tile, r / 4, r % 4, tid); continue; } r -= I_OUT;
            if (r < I_XQ) { conv_block_item(a.in[12] + (size_t)l * 1024 * 512, nullptr, 512, 1024, 0, a.in[10] + l * 1024, (bf16*)(wl + OW_XQ), tile, r / 2, r % 2, tid); continue; } r -= I_XQ;
            if (r < I_XKV) { conv_block_item(a.in[13] + (size_t)l * 1024 * 1024, nullptr, 1024, 1024, 0, a.in[11] + l * 1024, (bf16*)(wl + OW_XKV), tile, r / 4, r % 4, tid); continue; } r -= I_XKV;
            if (r < I_XO) { conv_block_item(a.in[14] + (size_t)l * 512 * 1024, nullptr, 1024, 512, 0, nullptr, (bf16*)(wl + OW_XO), tile, r / 4, r % 4, tid); continue; } r -= I_XO;
            if (r < I_GU) { conv_block_item(a.in[16] + (size_t)l * 1024 * DFF, a.in[17] + (size_t)l * 1024 * DFF, DFF, 1024, 2, a.in[15] + l * 1024, (bf16*)(wl + OW_GU), tile, r / 22, r % 22, tid); continue; } r -= I_GU;
            conv_block_item(a.in[18] + (size_t)l * DFF * 1024, nullptr, 1024, DFF, 0, nullptr, (bf16*)(wl + OW_DN), tile, r / 4, r % 4, tid);
        }
        for (int m = gw; m < M; m += NGW) row_to_bf16_ssq(x + (size_t)m * D, hb + (size_t)m * D, ssq + (size_t)m * 16, lane);
        for (int m = gw; m < MROWS; m += NGW) row_to_bf16_ssq(mem + (size_t)m * D, memb + (size_t)m * D, ssqm + (size_t)m * 16, lane);
        { float* prm = (float*)(ws + WS_PRM);
          for (int i = bx * 512 + tid; i < 2 * 8192 + 1024; i += G * 512) {
              float v = 0.f;
              if (i >= 2 * 8192) v = a.in[19][i - 2 * 8192];
              else { const int l = i >> 13, o = i & 8191;
                  if (o < 6) v = a.in[4][l * 6 + o]; else if (o >= 8 && o < 14) v = a.in[6][l * 6 + o - 8]; else if (o >= 16 && o < 22) v = a.in[7][l * 6 + o - 16];
                  else if (o >= 64 && o < 448) v = a.in[8][l * 384 + o - 64]; else if (o >= 512 && o < 3584) v = a.in[5][l * 3072 + o - 512]; }
              prm[i] = v; } }
    }
#define XBAR() do { XcdBarrier xb_; xb_.bar = (unsigned*)(ws + WS_BAR); xb_.x = xb_xcc_id(); xb_.st = (volatile LAS unsigned*)(L + LDS_BARST); xcd_barrier(xb_); } while (0)
    { unsigned char* ws = a.ws; XBAR(); }
    for (int ph = 0; ph < 16; ++ph) {
        const int l = ph >> 3, k = ph & 7;
        size_t zoff = 0; asm volatile("" : "+s"(zoff)); unsigned char* ws = a.ws + zoff;
        const unsigned char* wl = ws + WS_W + (size_t)l * W_LAYER;
        float* ssq = (float*)(ws + WS_SSQP); float* ssqm = (float*)(ws + WS_SSQP + 7 * MiB);
        bf16* ub = (bf16*)(ws + WS_U); bf16* actb = (bf16*)(ws + WS_U); bf16* yb = (bf16*)(ws + WS_Y); bf16* qxb = (bf16*)(ws + WS_QX); bf16* oxb = (bf16*)(ws + WS_OX);
        bf16* hb = (bf16*)(ws + WS_HB); bf16* memb = (bf16*)(ws + WS_MEMB); bf16* kvb = (bf16*)(ws + WS_KV);
        int tid_p = threadIdx.x; asm volatile("" : "+v"(tid_p)); const int lane = tid_p & 63, wave = __builtin_amdgcn_readfirstlane(tid_p >> 6), gw = bx * 8 + wave;
        if (k == 0 || k == 3) {
            const int j0 = (ph == 0) ? 0 : 2;
            for (int j = j0; j < 3; ++j) {
                pg8::Gemm g; pg8::EpiScaleBf16 E; int off = 0;
                if (j < 2) { g = pg8::Gemm{memb, (const bf16*)(ws + WS_W + (size_t)j * W_LAYER + OW_XKV), MROWS, 1024, 1024}; E = pg8::EpiScaleBf16{kvb + (size_t)j * MROWS * 1024, 1024, ssqm}; off = 128 + 32 * j; }
                else if (k == 0) { g = pg8::Gemm{hb, (const bf16*)(wl + OW_IN), M, NU, 1024}; E = pg8::EpiScaleBf16{ub, NU, ssq + (size_t)(3 * l) * M * 16}; }
                else { g = pg8::Gemm{hb, (const bf16*)(wl + OW_XQ), M, DX, 1024}; E = pg8::EpiScaleBf16{qxb, DX, ssq + (size_t)(3 * l + 1) * M * 16}; }
                pg8::OffsetOrder Sc; Sc.init(g.M, g.N, G, bx, off);
                GEMM_PHASE(pg8::EpiScaleBf16, pg8::OffsetOrder, g, Sc, E);
            }
        } else if (k == 2 || k == 5 || k == 7) {
            pg8::Gemm g; pg8::EpiResid E;
            if (k == 2) { g = pg8::Gemm{yb, (const bf16*)(wl + OW_OUT), M, 1024, 1024}; E = pg8::EpiResid{hb, ssq + (size_t)(3 * l + 1) * M * 16}; }
            else if (k == 5) { g = pg8::Gemm{oxb, (const bf16*)(wl + OW_XO), M, 1024, DX}; E = pg8::EpiResid{hb, ssq + (size_t)(3 * l + 2) * M * 16}; }
            else { g = pg8::Gemm{actb, (const bf16*)(wl + OW_DN), M, 1024, DFF}; E = pg8::EpiResid{hb, ssq + (size_t)(3 * l + 3) * M * 16}; }
            pg8::StaticOrder Sc; Sc.init(g.M, g.N, G, bx);
            GEMM_PHASE(pg8::EpiResid, pg8::StaticOrder, g, Sc, E);
        } else if (k == 6) {
            pg8::Gemm g{hb, (const bf16*)(wl + OW_GU), M, 2 * DFF, 1024}; pg8::StaticOrder Sc; Sc.init(M, 2 * DFF, G, bx);
            pg8::EpiSwiglu E{actb, DFF, ssq + (size_t)(3 * l + 2) * M * 16};
            GEMM_PHASE(pg8::EpiSwiglu, pg8::StaticOrder, g, Sc, E);
        } else if (k == 1) {
            const float* prm = (const float*)(ws + WS_PRM) + l * 8192;
            float* mscr = out;
            float* fcl = out + 14 * MiB / 4; float* ftot = out + 15 * MiB / 4;
            const int xcd0 = (int)(xb_xcc_id() & 7u); unsigned okmask = 0u;
            for (int qi = 0; qi < 3; ++qi) {
            const int xcd = (qi == 0) ? xcd0 : (qi == 1 ? (bx & 7) : ((xcd0 + 1) & 7));
            if (qi == 1 && xcd == xcd0) continue;
            unsigned* done = (unsigned*)(ws + WS_BAR + 15360) + 16 * (l * 8 + xcd);
            for (int sj = 0; sj < (qi == 2 ? 1 : 2); ++sj) {
            const int sq = (wave + sj) & 7;
            unsigned* ctr = (unsigned*)(ws + WS_BAR + 16384) + 16 * ((l * 8 + xcd) * 8 + sq);
            for (;;) {
                int it = 0; if (lane == 0) it = (int)atomicAdd(ctr, 1u); it = __builtin_amdgcn_readfirstlane(it) * 8 + sq;
                if (it >= 874) break;
                if (it < 138) {
                    if (it >= 48) mlstm_item<false>(ub, yb, mscr, prm + 512, prm + 8, prm + 16, prm + 64, L + wave * ML_WSTRIDE, xcd + 8 * ((it - 48) / 15), (it - 48) % 15, lane);
                    else fox_cumsum_item(ub, prm, fcl, ftot, (xcd + 8 * (it >> 3)) * 8 + (it & 7), lane);
                    asm volatile("s_waitcnt vmcnt(0)" ::: "memory");
                    if (lane == 0) atomicAdd(done + (it >= 48 ? 8 : 0), 1u);
                } else {
                    const bool issb = (it >= 266 && it < 522), isc = (it >= 522 && it < 618), isfox = !isc && !issb;
                    if (isfox && !((okmask >> xcd) & 1u)) { unsigned sp = 0u;
                        while (__hip_atomic_load(done, __ATOMIC_RELAXED, __HIP_MEMORY_SCOPE_AGENT) < 48u) { __builtin_amdgcn_s_sleep(120); if (++sp > (1u << 17)) break; }
                        __builtin_amdgcn_fence(__ATOMIC_ACQUIRE, "agent"); okmask |= 1u << xcd; }
                    if (isc && !((okmask >> (8 + xcd)) & 1u)) { unsigned sp = 0u;
                        while (__hip_atomic_load(done + 8, __ATOMIC_RELAXED, __HIP_MEMORY_SCOPE_AGENT) < 90u) { __builtin_amdgcn_s_sleep(120); if (++sp > (1u << 17)) break; }
                        __builtin_amdgcn_fence(__ATOMIC_ACQUIRE, "agent"); okmask |= 1u << (8 + xcd); }
                    if (isc) { const int ci = it - 522; mlstm_item<true>(ub, yb, mscr, prm + 512, prm + 8, prm + 16, prm + 64, L + wave * ML_WSTRIDE, xcd + 8 * (ci >> 4), 15 - (ci & 15), lane); }
                    else { int aitem; if (issb) { const int ai = it - 266; aitem = (ai >> 2) * 80 + 48 + xcd + 8 * (ai & 3); } else { const int ai = (it < 266) ? it - 138 : it - 490; aitem = (ai / 6) * 80 + xcd + 8 * (ai % 6); }
                        attn_mfma_item(ub, yb, fcl, ftot, L + wave * ML_WSTRIDE, aitem, lane); }
                }
            }
            }
            }
        } else {
            for (int it = gw; it < 2048; it += NGW) xattn_mfma_item(qxb, kvb + (size_t)l * MROWS * 1024, oxb, L + wave * 16384, it, lane);
        }
        XBAR();
    }
    {
        int tid_f = threadIdx.x; asm volatile("" : "+v"(tid_f)); const int lane = tid_f & 63, gw = bx * 8 + __builtin_amdgcn_readfirstlane(tid_f >> 6);
        const float* fw = (const float*)(a.ws + WS_PRM) + 2 * 8192; const float* sq = (const float*)(a.ws + WS_SSQP) + (size_t)6 * M * 16;
        const bf16* hbf = (const bf16*)(a.ws + WS_HB);
        for (int m = gw; m < M; m += NGW) {
            float sm = 0.f; { const f32x4* qp = (const f32x4*)(sq + (size_t)m * 16); const f32x4 q0 = qp[0], q1 = qp[1], q2 = qp[2], q3 = qp[3];
              sm = ((((q0[0] + q0[1]) + (q0[2] + q0[3])) + ((q1[0] + q1[1]) + (q1[2] + q1[3]))) + (((q2[0] + q2[1]) + (q2[2] + q2[3])) + ((q3[0] + q3[1]) + (q3[2] + q3[3])))); }
            const float rs = rsqrtf(sm * (1.0f / 1024.0f) + 1e-6f);
            const unsigned long long* hp = (const unsigned long long*)(hbf + (size_t)m * D) + lane; f32x4* rp = (f32x4*)(out + (size_t)m * D) + lane; const f32x4* wp = (const f32x4*)fw + lane;
#pragma unroll
            for (int j = 0; j < 4; ++j) { const unsigned long long hw = hp[64 * j]; const unsigned h0 = (unsigned)hw, h1 = (unsigned)(hw >> 32); const f32x4 w = wp[64 * j];
                f32x4 v = {lo_f(h0), hi_f(h0), lo_f(h1), hi_f(h1)}; v = v * rs * w; rp[64 * j] = v; }
        }
    }
}

extern "C" void kernel_launch(void* const* d_in, const int* in_sizes, int n_in, void* d_out, int out_size, void* d_ws, size_t ws_size, hipStream_t stream) {
    static int grid = 0;
    if (grid == 0) {
        if (n_in != 20 || out_size != M * D || ws_size < WS_END) { fprintf(stderr, "kernel_launch: unexpected shapes (n_in %d out %d ws %zu)\n", n_in, out_size, ws_size); grid = -1; return; }
        int dev = 0, cus = 0, per_cu = 0;
        hipGetDevice(&dev); hipDeviceGetAttribute(&cus, hipDeviceAttributeMultiprocessorCount, dev);
        if (hipFuncSetAttribute((const void*)mega_fwd, hipFuncAttributeMaxDynamicSharedMemorySize, LDS_BYTES) != hipSuccess) { fprintf(stderr, "kernel_launch: hipFuncSetAttribute failed\n"); grid = -1; return; }
        if (hipOccupancyMaxActiveBlocksPerMultiprocessor(&per_cu, (const void*)mega_fwd, 512, LDS_BYTES) != hipSuccess || per_cu < 1) { fprintf(stderr, "kernel_launch: occupancy query says %d\n", per_cu); (void)hipGetLastError(); per_cu = 1; }
        grid = cus * per_cu;
    }
    if (grid < 0) return;
    Args a{};
    for (int i = 0; i < 20; ++i) a.in[i] = (const float*)d_in[i];
    a.out = (float*)d_out; a.ws = (unsigned char*)d_ws;
    if (hipMemsetAsync((char*)d_ws + WS_BAR, 0, BAR_BYTES, stream) != hipSuccess) { fprintf(stderr, "kernel_launch: memset of the barrier words failed\n"); return; }
    void* args[] = {&a};
    hipError_t e = hipLaunchCooperativeKernel((const void*)mega_fwd, dim3(grid), dim3(512), args, LDS_BYTES, stream);
    if (e != hipSuccess) fprintf(stderr, "kernel_launch: cooperative launch failed: %s (grid %d)\n", hipGetErrorString(e), grid);
}
```
